# Optimizing an MI355X kernel written in HIP

```python
import jax
import jax.numpy as jnp
from jax import lax
import numpy as np


D_MODEL = 1024
BATCH = 4
SEQ = 8192
DEPTH = 2

GRID_W = 64
CTX_LEN = 256

D_A = D_MODEL // 4
CONV_A = 3
H_B = 4
DK_B = D_MODEL // 16
DV_B = D_MODEL // 16
D_B = H_B * DV_B
C_GROUPS = 4
C_GDIM = D_MODEL // 16
D_C = C_GROUPS * C_GDIM
H_D = 4
P_D = D_MODEL // 16
D_D = H_D * P_D
G_D = 2
N_D = D_MODEL // 16
CONV_D = 3
D_XBC = D_D + 2 * G_D * N_D

N_BRANCH = 4
CHUNK = 64
IN_SIZES = (D_A, D_A, D_A, H_B * DK_B, 2 * H_B * DK_B, D_B, D_B, D_C, D_D, D_XBC, 2 * H_D, N_BRANCH * D_MODEL)
N_IN = sum(IN_SIZES)

N_GROUPS = 4
EXPERTS_PER_GROUP = 8
N_EXPERTS = N_GROUPS * EXPERTS_PER_GROUP
TOP_K = 2
D_FF = D_MODEL // 2
MOE_BLOCK = 128

EPS = 1e-6

kernel_name = 'hybrid_prefix_flow_block'


def rms_norm(x, w):
    xf = x.astype(jnp.float32)
    y = xf * lax.rsqrt(jnp.mean(xf * xf, axis=-1, keepdims=True) + EPS)
    return (y * w.astype(jnp.float32)).astype(x.dtype)


def modulate(h, shift, scale):
    return h * (1 + scale) + shift


def depthwise_conv(x, w, b):
    k = w.shape[0]
    y = lax.conv_general_dilated(x, w[:, None, :].astype(x.dtype), window_strides=(1,),
                                 padding=((k // 2, k // 2),), dimension_numbers=('NWC', 'WIO', 'NWC'),
                                 feature_group_count=x.shape[-1])
    return y + b.astype(x.dtype)


def chunk_scan(q, k, v, log_f, s0):
    bsz, nh, t_len, _ = q.shape
    n_chunks = t_len // CHUNK

    def to_chunks(a):
        return jnp.moveaxis(a.reshape(bsz, nh, n_chunks, CHUNK, a.shape[-1]), 2, 0)

    incl = jnp.tril(jnp.ones((CHUNK, CHUNK), dtype=bool))[:, :, None]

    def step(state, inp):
        qc, kc, vc, gc = inp
        cum = jnp.cumsum(gc, axis=-2)
        rel = cum[..., :, None, :] - cum[..., None, :, :]
        decay = jnp.exp(jnp.where(incl, rel, -jnp.inf))
        if gc.shape[-1] == 1:
            scores = jnp.einsum('bhtd,bhsd->bhts', qc, kc) * decay[..., 0]
        else:
            scores = jnp.einsum('bhtd,bhsd,bhtsd->bhts', qc, kc, decay)
        out = (jnp.einsum('bhts,bhse->bhte', scores, vc)
               + jnp.einsum('bhtd,bhde->bhte', qc * jnp.exp(cum), state))
        last = cum[..., -1:, :]
        state = (jnp.exp(last[..., 0, :])[..., None] * state
                 + jnp.einsum('bhsd,bhse->bhde', kc * jnp.exp(last - cum), vc))
        return state, out

    state, outs = lax.scan(step, s0, (to_chunks(q), to_chunks(k), to_chunks(v), to_chunks(log_f)))
    return jnp.moveaxis(outs, 0, 2).reshape(bsz, nh, t_len, v.shape[-1]), state


def to_heads(a, n_heads):
    bsz, t_len, _ = a.shape
    return a.reshape(bsz, t_len, n_heads, -1).transpose(0, 2, 1, 3).astype(jnp.float32)


def flip_t(a):
    return jnp.flip(a, axis=2)


def hgrn_log_forget(f_raw, lb):
    lb = lb.reshape(H_B, 1, DK_B)
    return jnp.logaddexp(jnp.log(lb), jnp.log1p(-lb) + jax.nn.log_sigmoid(f_raw))


def token_mixer(h, lp, lb, init, need_out):
    bsz, t_len, _ = h.shape
    split_at = np.cumsum(IN_SIZES)[:-1].tolist()
    (a_b, a_c, a_x, q_raw, f_raw, i_raw, g_raw, four, z, xbc, dt_raw, gate_raw) = jnp.split(
        h @ lp['w_in'], split_at, axis=-1)
    if init is None:
        zb = jnp.zeros((bsz, H_B, DK_B, DV_B), jnp.float32)
        zd = jnp.zeros((bsz, H_D, N_D, P_D), jnp.float32)
        init = (zb, zb, zd, zd)
    s_hf, s_hb, s_mf, s_mb = init

    y_a = a_b * depthwise_conv(a_c * a_x, lp['conv_a_w'], lp['conv_a_b'])

    q = to_heads(jax.nn.silu(q_raw), H_B)
    v = to_heads(i_raw, H_B)
    ff_raw, fb_raw = jnp.split(f_raw, 2, axis=-1)
    log_ff = hgrn_log_forget(to_heads(ff_raw, H_B), lb[0])
    log_fb = hgrn_log_forget(to_heads(fb_raw, H_B), lb[1])
    o_f, s_hf = chunk_scan(q, -jnp.expm1(log_ff), v, log_ff, s_hf)
    o_b, s_hb = chunk_scan(flip_t(q), flip_t(-jnp.expm1(log_fb)), flip_t(v), flip_t(log_fb), s_hb)
    o = (o_f + flip_t(o_b)).transpose(0, 2, 1, 3)
    y_b = (rms_norm(o, lp['hgrn_norm_w'])
           * jax.nn.silu(g_raw.reshape(bsz, t_len, H_B, DV_B).astype(jnp.float32)))
    y_b = y_b.reshape(bsz, t_len, D_B).astype(h.dtype)

    y_c = jnp.fft.fft2(four.reshape(bsz, t_len, C_GROUPS, C_GDIM).astype(jnp.float32),
                       axes=(1, 3), norm='ortho').real
    y_c = y_c.reshape(bsz, t_len, D_C).astype(h.dtype)

    xbc = jax.nn.silu(depthwise_conv(xbc, lp['ssm_conv_w'], lp['ssm_conv_b']))
    xs, b_in, c_in = jnp.split(xbc, [D_D, D_D + G_D * N_D], axis=-1)
    xh = to_heads(xs, H_D)

    def group_heads(a):
        a = jnp.repeat(a.reshape(bsz, t_len, G_D, N_D), H_D // G_D, axis=2)
        return a.transpose(0, 2, 1, 3).astype(jnp.float32)

    bh, ch = group_heads(b_in), group_heads(c_in)
    dt = jax.nn.softplus(dt_raw.reshape(bsz, t_len, 2, H_D).astype(jnp.float32)
                         + lp['ssm_dt_bias'].astype(jnp.float32)).transpose(2, 0, 3, 1)
    log_a = dt * (-jnp.exp(lp['ssm_A_log'].astype(jnp.float32)))[:, None, :, None]
    y_f, s_mf = chunk_scan(ch, bh * dt[0][..., None], xh, log_a[0][..., None], s_mf)
    y_r, s_mb = chunk_scan(flip_t(ch), flip_t(bh * dt[1][..., None]), flip_t(xh),
                           flip_t(log_a[1][..., None]), s_mb)
    y = y_f + flip_t(y_r) + lp['ssm_D'].astype(jnp.float32)[:, None, None] * xh
    y = (y.transpose(0, 2, 1, 3).reshape(bsz, t_len, G_D, D_D // G_D)
         * jax.nn.silu(z.astype(jnp.float32)).reshape(bsz, t_len, G_D, D_D // G_D))
    y_d = rms_norm(y, lp['ssm_norm_w'].reshape(G_D, D_D // G_D)).reshape(bsz, t_len, D_D).astype(h.dtype)

    states = (s_hf, s_hb, s_mf, s_mb)
    if not need_out:
        return None, states

    gates = jax.nn.sigmoid(gate_raw.reshape(bsz, t_len, N_BRANCH, D_MODEL))
    branches = (y_a, y_b, y_c, y_d)
    merged = gates[:, :, 0] * (branches[0] @ lp['w_branch'][0])
    for kb in range(1, N_BRANCH):
        merged = merged + gates[:, :, kb] * (branches[kb] @ lp['w_branch'][kb])
    return merged @ lp['w_out'], states


def grouped_experts(h, expert_ids, weights, w1, w3, w2):
    n_tok, d = h.shape
    n_assign = expert_ids.shape[0]
    token_ids = jnp.arange(n_assign, dtype=jnp.int32) // (n_assign // n_tok)
    order = jnp.argsort(expert_ids)
    e_sorted = expert_ids[order]
    tok_sorted = token_ids[order]
    counts = jnp.bincount(expert_ids, length=N_EXPERTS)
    starts = jnp.cumsum(counts) - counts
    padded = (counts + MOE_BLOCK - 1) // MOE_BLOCK * MOE_BLOCK
    pad_ends = jnp.cumsum(padded)
    pad_starts = pad_ends - padded
    dest = pad_starts[e_sorted] + (jnp.arange(n_assign, dtype=jnp.int32) - starts[e_sorted])
    n_blocks = -(-n_assign // MOE_BLOCK) + N_EXPERTS
    buf = jnp.zeros((n_blocks * MOE_BLOCK, d), h.dtype).at[dest].set(h[tok_sorted])
    block_start = jnp.arange(n_blocks, dtype=jnp.int32) * MOE_BLOCK
    block_expert = jnp.minimum(jnp.sum(block_start[:, None] >= pad_ends[None, :], axis=-1), N_EXPERTS - 1)

    def expert_block(args):
        xb, e = args
        return (jax.nn.silu(xb @ w1[e]) * (xb @ w3[e])) @ w2[e]

    out = lax.map(expert_block, (buf.reshape(n_blocks, MOE_BLOCK, d), block_expert)).reshape(-1, d)
    y_assign = out[dest].astype(jnp.float32) * weights[order][:, None]
    return jax.ops.segment_sum(y_assign, tok_sorted, num_segments=n_tok).astype(h.dtype)


def hier_moe(h, rg_w, rg_b, re_w, re_b, w1, w3, w2):
    n_tok = h.shape[0]
    hf = h.astype(jnp.float32)
    g_logits = hf @ rg_w.astype(jnp.float32) + rg_b.astype(jnp.float32)
    g_prob = jax.nn.softmax(g_logits, axis=-1)
    g_top = jnp.argmax(g_logits, axis=-1).astype(jnp.int32)
    p_group = jnp.take_along_axis(g_prob, g_top[:, None], axis=-1)
    e_logits = (hf @ re_w.astype(jnp.float32) + re_b.astype(jnp.float32)).reshape(n_tok, N_GROUPS, EXPERTS_PER_GROUP)
    e_in = jnp.take_along_axis(e_logits, g_top[:, None, None], axis=1)[:, 0]
    top_v, top_i = lax.top_k(e_in, TOP_K)
    w = p_group * jax.nn.softmax(top_v, axis=-1)
    expert = g_top[:, None] * EXPERTS_PER_GROUP + top_i.astype(jnp.int32)
    return grouped_experts(h, expert.reshape(-1), w.reshape(-1), w1, w3, w2)


def setup_inputs(seed: int = 0) -> dict:
    key = jax.random.key(seed)
    ks = jax.random.split(key, 32)
    f32 = jnp.float32
    nrm = lambda k, s, sc: jax.random.normal(k, s, f32) * sc
    dt0 = jnp.exp(jax.random.uniform(ks[14], (DEPTH, 2, H_D), f32) * (jnp.log(0.1) - jnp.log(0.001)) + jnp.log(0.001))
    return {
        'x': nrm(ks[0], (BATCH, SEQ, D_MODEL), 1.0),
        'c': nrm(ks[1], (BATCH, D_MODEL), 1.0),
        'ctx': nrm(ks[2], (BATCH, CTX_LEN, D_MODEL), 1.0),
        'c_ctx': nrm(ks[3], (D_MODEL,), 1.0),
        'ada_w': nrm(ks[4], (DEPTH, D_MODEL, 6 * D_MODEL), 0.5 * D_MODEL ** -0.5),
        'ada_b': nrm(ks[5], (DEPTH, 6 * D_MODEL), 0.01),
        'norm_mix_w': 1.0 + nrm(ks[6], (DEPTH, D_MODEL), 0.01),
        'norm_ffn_w': 1.0 + nrm(ks[7], (DEPTH, D_MODEL), 0.01),
        'w_in': nrm(ks[8], (DEPTH, D_MODEL, N_IN), D_MODEL ** -0.5),
        'conv_a_w': nrm(ks[9], (DEPTH, CONV_A, D_A), CONV_A ** -0.5),
        'conv_a_b': nrm(ks[10], (DEPTH, D_A), 0.01),
        'hgrn_lb': nrm(ks[11], (2, DEPTH, H_B * DK_B), 1.0),
        'hgrn_norm_w': 1.0 + nrm(ks[12], (DEPTH, DV_B), 0.01),
        'ssm_conv_w': nrm(ks[13], (DEPTH, CONV_D, D_XBC), CONV_D ** -0.5),
        'ssm_conv_b': nrm(ks[15], (DEPTH, D_XBC), 0.01),
        'ssm_A_log': jnp.log(jax.random.uniform(ks[16], (DEPTH, 2, H_D), f32, 1.0, 16.0)),
        'ssm_dt_bias': dt0 + jnp.log(-jnp.expm1(-dt0)),
        'ssm_D': 1.0 + nrm(ks[17], (DEPTH, H_D), 0.01),
        'ssm_norm_w': 1.0 + nrm(ks[18], (DEPTH, D_D), 0.01),
        'w_branch': nrm(ks[19], (DEPTH, N_BRANCH, D_A, D_MODEL), D_A ** -0.5),
        'w_out': nrm(ks[20], (DEPTH, D_MODEL, D_MODEL), D_MODEL ** -0.5),
        'router_group_w': nrm(ks[21], (DEPTH, D_MODEL, N_GROUPS), D_MODEL ** -0.5),
        'router_group_b': nrm(ks[22], (DEPTH, N_GROUPS), 0.01),
        'router_expert_w': nrm(ks[23], (DEPTH, D_MODEL, N_EXPERTS), D_MODEL ** -0.5),
        'router_expert_b': nrm(ks[24], (DEPTH, N_EXPERTS), 0.01),
        'moe_w1': nrm(ks[25], (DEPTH, N_EXPERTS, D_MODEL, D_FF), D_MODEL ** -0.5),
        'moe_w3': nrm(ks[26], (DEPTH, N_EXPERTS, D_MODEL, D_FF), D_MODEL ** -0.5),
        'moe_w2': nrm(ks[27], (DEPTH, N_EXPERTS, D_FF, D_MODEL), D_FF ** -0.5),
        'final_norm_w': 1.0 + nrm(ks[28], (D_MODEL,), 0.01),
    }


def reference(x, c, ctx, c_ctx, ada_w, ada_b, norm_mix_w, norm_ffn_w, w_in, conv_a_w, conv_a_b,
              hgrn_lb, hgrn_norm_w, ssm_conv_w, ssm_conv_b, ssm_A_log, ssm_dt_bias, ssm_D, ssm_norm_w,
              w_branch, w_out, router_group_w, router_group_b, router_expert_w, router_expert_b,
              moe_w1, moe_w3, moe_w2, final_norm_w):
    lb_all = jnp.cumsum(jax.nn.softmax(hgrn_lb.astype(jnp.float32), axis=1), axis=1)
    lb_all = lb_all - lb_all[:, :1]
    s_c = jax.nn.silu(c)
    s_ctx = jax.nn.silu(c_ctx)
    for l in range(DEPTH):
        last = l == DEPTH - 1
        lp = {'w_in': w_in[l], 'conv_a_w': conv_a_w[l], 'conv_a_b': conv_a_b[l],
              'hgrn_norm_w': hgrn_norm_w[l], 'ssm_conv_w': ssm_conv_w[l], 'ssm_conv_b': ssm_conv_b[l],
              'ssm_A_log': ssm_A_log[l], 'ssm_dt_bias': ssm_dt_bias[l], 'ssm_D': ssm_D[l],
              'ssm_norm_w': ssm_norm_w[l], 'w_branch': w_branch[l], 'w_out': w_out[l]}
        m_l = jnp.split((s_c @ ada_w[l] + ada_b[l])[:, None, :], 6, axis=-1)
        m_c = jnp.split(s_ctx @ ada_w[l] + ada_b[l], 6, axis=-1)

        h_c = modulate(rms_norm(ctx, norm_mix_w[l]), m_c[0], m_c[1])
        mix_c, ctx_states = token_mixer(h_c, lp, lb_all[:, l], None, not last)
        h_l = modulate(rms_norm(x, norm_mix_w[l]), m_l[0], m_l[1])
        mix_l, _ = token_mixer(h_l, lp, lb_all[:, l], ctx_states, True)
        x = x + m_l[2] * mix_l

        moe_args = (router_group_w[l], router_group_b[l], router_expert_w[l], router_expert_b[l],
                    moe_w1[l], moe_w3[l], moe_w2[l])
        f_l = modulate(rms_norm(x, norm_ffn_w[l]), m_l[3], m_l[4]).reshape(-1, D_MODEL)
        if last:
            y_l = hier_moe(f_l, *moe_args)
        else:
            ctx = ctx + m_c[2] * mix_c
            f_c = modulate(rms_norm(ctx, norm_ffn_w[l]), m_c[3], m_c[4]).reshape(-1, D_MODEL)
            y_all = hier_moe(jnp.concatenate([f_l, f_c], axis=0), *moe_args)
            n_lat = f_l.shape[0]
            y_l = y_all[:n_lat]
            ctx = ctx + m_c[5] * y_all[n_lat:].reshape(ctx.shape)
        x = x + m_l[5] * y_l.reshape(x.shape)
    return rms_norm(x, final_norm_w)
```

```cpp
#include <hip/hip_runtime.h>
#include <hip/hip_cooperative_groups.h>
#include <cstdio>
#include <cstdint>
namespace cg = cooperative_groups;

#define GAS __attribute__((address_space(1)))
#define LAS __attribute__((address_space(3)))
typedef unsigned short bf16;
typedef short bf16x8 __attribute__((ext_vector_type(8)));
typedef float f32x4 __attribute__((ext_vector_type(4)));
typedef float f32x2 __attribute__((ext_vector_type(2)));
typedef float f32x16 __attribute__((ext_vector_type(16)));
typedef unsigned u32x4 __attribute__((ext_vector_type(4)));
typedef unsigned u32x2 __attribute__((ext_vector_type(2)));
typedef GAS unsigned gu32;
#define RLX_AGENT __ATOMIC_RELAXED, __HIP_MEMORY_SCOPE_AGENT

#ifndef DBG_VAR
#define DBG_VAR 3
#endif
#ifndef DBG_E4S
#define DBG_E4S 1.0f
#endif
#ifndef DBG_NOCTX
#define DBG_NOCTX 0
#endif
constexpr int D = 1024, NB = 4, SEQ = 8192, CTXL = 256, DEPTH = 2;
constexpr int RPB = CTXL + SEQ;
constexpr int R = NB * RPB;
constexpr int NIN = 7176;
constexpr int NP = 3328;
constexpr int NWIN = 7424;
constexpr int SPB = RPB / 64;
constexpr int NSPAN = NB * SPB;
constexpr float EPS = 1e-6f;
constexpr int C_AB = 0, C_AC = 256, C_AX = 512, C_Q = 768, C_FF = 1024, C_I = 1536, C_G = 1792, C_UR = 2048, C_UI = 2304, C_Z = 2560, C_XBC = 2816;
constexpr int C_XS = C_AC, C_BC = C_UI;
constexpr int NE = 32, DFF = 512;
constexpr int MAXT = 300;

constexpr size_t MiB = 1u << 20;
constexpr size_t WS_CTL = 0;
constexpr size_t WS_SMALL = 1 * MiB;
constexpr size_t WS_WT = 17 * MiB;
constexpr size_t WS_X = 57 * MiB;
constexpr size_t WS_H = 189 * MiB;
constexpr size_t WS_BIG = 255 * MiB;
constexpr size_t WS_END = 585 * MiB;
constexpr size_t SM_PART = WS_SMALL;
constexpr size_t SM_MOD = SM_PART + 2 * 8 * 5 * 6144 * 4;
constexpr size_t SM_M1 = SM_MOD + 2 * 5 * 6144 * 4;
constexpr size_t SM_M2 = SM_M1 + 128 * 128 * 4;
constexpr size_t SM_M3 = SM_M2 + 256 * 128 * 4;
constexpr size_t SM_TW = SM_M3 + 512 * 256 * 4;
constexpr size_t SM_DT = SM_TW + 128 * 64 * 2 * 4;
constexpr size_t SM_TOK = SM_DT + (size_t)R * 8 * 4;
constexpr size_t SM_LIST = SM_TOK + (size_t)R * 8 * 4;
constexpr size_t SM_CY = SM_LIST + (size_t)NE * R * 4;
constexpr size_t SM_DEC = SM_CY + 4 * 256 * 256 * 2;
constexpr size_t SM_END = SM_DEC + 4 * 8 * 132 * 64 * 4;
static_assert(SM_END <= WS_WT, "small region");
constexpr size_t WT_IN = WS_WT;
constexpr size_t WT_BR = WT_IN + (size_t)2 * NWIN * D * 2;
constexpr size_t WT_OUT = WT_BR + (size_t)2 * 4 * D * 256 * 2;
static_assert(WT_OUT + (size_t)2 * D * D * 2 <= WS_X, "wt region");
constexpr size_t BG_PROJ = WS_BIG;
constexpr size_t BG_ST = BG_PROJ + (size_t)R * NP * 2;
constexpr size_t BG_AP = BG_ST + (size_t)NB * 8 * SPB * 4096 * 4;
constexpr size_t BG_MIX_END = BG_AP + (size_t)NB * 64 * 2 * 128 * 256 * 2;
constexpr size_t BG_MERGED = BG_ST;
constexpr size_t BG_GSCR = BG_MERGED + (size_t)R * D * 2;
static_assert(BG_GSCR + 256 * 131072 <= WS_END && BG_MIX_END + (size_t)R * 256 * 2 <= WS_END, "big region");
constexpr size_t BG_W13 = WS_BIG;
constexpr size_t BG_W2 = BG_W13 + (size_t)NE * D * D * 2;
constexpr size_t BG_ACT = BG_W2 + (size_t)NE * D * DFF * 2;
constexpr size_t BG_YO = BG_ACT + (size_t)MAXT * 256 * DFF * 2;
static_assert(BG_YO + (size_t)MAXT * 256 * D * 2 <= WS_END, "moe region");
static_assert(BG_W2 + (size_t)NE * D * DFF * 2 <= BG_MERGED, "moe weights may be converted while merged is live");
constexpr int CW_BAR = 4096;
constexpr int CW_CNT = 16384;

constexpr int RING_BYTES = 131072;
constexpr int MISC_OFF = RING_BYTES + 320;
constexpr int LDS_BYTES = 147456;

__device__ __forceinline__ unsigned f2bf(float f) { unsigned u = __builtin_bit_cast(unsigned, f); return (u + 0x7fffu + ((u >> 16) & 1u)) >> 16; }
__device__ __forceinline__ unsigned pk2(float lo, float hi) { return f2bf(lo) | (f2bf(hi) << 16); }
__device__ __forceinline__ float bf2f(unsigned short h) { return __builtin_bit_cast(float, (unsigned)h << 16); }
__device__ __forceinline__ float bflo(unsigned u) { return __builtin_bit_cast(float, u << 16); }
__device__ __forceinline__ float bfhi(unsigned u) { return __builtin_bit_cast(float, u & 0xffff0000u); }
__device__ __forceinline__ float wave_sum(float v) {
#pragma unroll
    for (int o = 1; o < 64; o <<= 1) v += __shfl_xor(v, o);
    return v;
}
__device__ __forceinline__ float sigmoidf_(float x) { return __builtin_amdgcn_rcpf(1.0f + __expf(-x)); }
__device__ __forceinline__ float siluf_(float x) { return x * __builtin_amdgcn_rcpf(1.0f + __expf(-x)); }
__device__ __forceinline__ float softplusf_(float x) { return x > 20.f ? x : log1pf(__expf(x)); }
#define LDS_WAIT() asm volatile("s_waitcnt lgkmcnt(0)" ::: "memory")
#define VM_WAIT() asm volatile("s_waitcnt vmcnt(0)" ::: "memory")

__device__ __forceinline__ int row_cr(int r) { const int b = r / RPB, s = r - b * RPB; return s < CTXL ? 4 : b; }

#define XB_TMO      128
#define XB_XCNT(j)  (256  + 64 * (j))
#define XB_XSUB(j)  (1280 + 64 * (j))
#define XB_XGEN(j)  (2304 + 64 * (j))
#define XB_TOP      3328
#define XB_TOPGEN   3392
#define XCD_BAR_WORDS 3456
#define XB_SPIN_CAP (1u << 20)
__device__ __forceinline__ unsigned xb_ld(unsigned* p)              { return __hip_atomic_load(p, __ATOMIC_RELAXED, __HIP_MEMORY_SCOPE_AGENT); }
__device__ __forceinline__ unsigned xb_add(unsigned* p, unsigned v) { return __hip_atomic_fetch_add(p, v, __ATOMIC_RELAXED, __HIP_MEMORY_SCOPE_AGENT); }
__device__ __forceinline__ unsigned xb_xcc_id() { return (unsigned)__builtin_amdgcn_s_getreg((3 << 11) | 20) & 0xFu; }
#define XB_SPIN(cond, bar) do { unsigned _sp = 0; while (cond) { __builtin_amdgcn_s_sleep(1); \
    if ((++_sp & 255u) == 0u) { if (xb_ld(&(bar)[XB_TMO])) break; if (_sp > XB_SPIN_CAP) { atomicAdd(&(bar)[XB_TMO], 1u); break; } } } } while (0)
struct XcdBarrier { unsigned* bar; unsigned x; volatile LAS unsigned* st; };
__device__ __forceinline__ XcdBarrier xcd_barrier_post(unsigned* bar, volatile LAS unsigned* st) {
    XcdBarrier b; b.bar = bar; b.x = xb_xcc_id(); b.st = st;
    if (threadIdx.x == 0) (void)xb_add(&bar[XB_XCNT(b.x)], 1u);
    return b;
}
__device__ __forceinline__ void xcd_barrier_complete(unsigned* bar, unsigned x, unsigned& nloc, unsigned& nx) {
    const unsigned G = gridDim.x * gridDim.y * gridDim.z;
    unsigned sum, cnt, mine, sp = 0u;
    for (;;) {
        sum = 0u; cnt = 0u; mine = 0u;
#pragma unroll
        for (unsigned j = 0; j < 16; ++j) { const unsigned c = xb_ld(&bar[XB_XCNT(j)]); sum += c; cnt += (c > 0u) ? 1u : 0u; mine = (j == x) ? c : mine; }
        if (sum == G) break;
        __builtin_amdgcn_s_sleep(1);
        if ((++sp & 255u) == 0u) { if (xb_ld(&bar[XB_TMO])) break; if (sp > XB_SPIN_CAP) { atomicAdd(&bar[XB_TMO], 1u); break; } }
    }
    nloc = mine > 0u ? mine : 1u; nx = cnt > 0u ? cnt : 1u;
}
__device__ __forceinline__ void xcd_barrier(const XcdBarrier& b) {
    asm volatile("s_waitcnt vmcnt(0)" ::: "memory");
    __syncthreads();
    if (threadIdx.x == 0) {
        unsigned* bar = b.bar;
        __builtin_amdgcn_s_waitcnt(0);
        unsigned nloc = b.st[0], nx = b.st[1];
        if (nloc == 0u) { xcd_barrier_complete(bar, b.x, nloc, nx); b.st[0] = nloc; b.st[1] = nx; }
        const unsigned old = xb_add(&bar[XB_XSUB(b.x)], 1u);
        const unsigned gen = old / nloc;
        if (old + 1u == (gen + 1u) * nloc) {
            __builtin_amdgcn_fence(__ATOMIC_RELEASE, "agent");
            asm volatile("s_waitcnt vmcnt(0)" ::: "memory");
            const unsigned og = xb_add(&bar[XB_TOP], 1u);
            const unsigned tg = og / nx;
            if (og + 1u == (tg + 1u) * nx) xb_add(&bar[XB_TOPGEN], 1u);
            else XB_SPIN(xb_ld(&bar[XB_TOPGEN]) == tg, bar);
            __builtin_amdgcn_fence(__ATOMIC_ACQUIRE, "agent");
            xb_add(&bar[XB_XGEN(b.x)], 1u);
            asm volatile("s_waitcnt vmcnt(0)" ::: "memory");
        } else {
            XB_SPIN(xb_ld(&bar[XB_XGEN(b.x)]) == gen, bar);
            __builtin_amdgcn_fence(__ATOMIC_ACQUIRE, "agent");
            asm volatile("s_waitcnt vmcnt(0)" ::: "memory");
        }
    }
    __syncthreads();
}

namespace ge {
constexpr int BM = 256, BK = 64, HALF = 128, HTB = HALF * BK * 2, NXCD = 8, WGM = 8;
__device__ __forceinline__ int lds_byte(int r, int c) { const int st = (r >> 4) * 2 + (c >> 5), rr = r & 15, cc = c & 31, ob = rr * 64 + cc * 2; return st * 1024 + (ob ^ (((ob >> 9) & 1) << 5)); }
__device__ __forceinline__ void stage_rc(int b, int& R_, int& C_) { const int st = b / 1024, sb = b % 1024, swz = sb ^ (((sb >> 9) & 1) << 5); R_ = (st >> 1) * 16 + swz / 64; C_ = (st & 1) * 32 + (swz % 64) / 2; }
__device__ __forceinline__ int perm32(int rho) { const int n = rho >> 4, i = rho & 15; return 8 * (i >> 2) + 4 * n + (i & 3); }

struct Unit { const char* A; const char* B; const int* rows; unsigned lda, ldb; int nt, kind, pm, pn, aux; };

__device__ __forceinline__ bool tile_order(long L, int nM, int nN, int& pm, int& pn) {
    const int nwg = nM * nN; if (L >= nwg) return false;
    int wgid = (int)L; { const int q = nwg / NXCD, r = nwg % NXCD, xcd = wgid % NXCD, off = wgid / NXCD; wgid = (xcd < r ? xcd * (q + 1) : r * (q + 1) + (xcd - r) * q) + off; }
    const int nig = WGM * nN, gid = wgid / nig, fm = gid * WGM, gsz = (nM - fm) < WGM ? (nM - fm) : WGM;
    pm = fm + ((wgid % nig) % gsz); pn = (wgid % nig) / gsz; return true;
}

template <class Epi, class Sched, bool GATHER, bool ALIGN_EPI = true>
__device__ __forceinline__ void gemm_engine(LAS unsigned char* lds, const Sched& S, const Epi& E, const int tid) {
    const int wid = __builtin_amdgcn_readfirstlane(tid >> 6), lane = tid & 63, wr = wid >> 2, wc = wid & 3, fr = lane & 15, fq = lane >> 4;
    unsigned voffA[2][2], voffB[2];
    const size_t kstep = (size_t)(BK * 2);
    const unsigned ldsw = (unsigned)wid * 1024u;
    const int aoff = lds_byte(wr * 64 + fr, fq * 8), boff = lds_byte(wc * 32 + fr, fq * 8);
#define GE_SETV(u) do { _Pragma("unroll") for (int _i = 0; _i < 2; ++_i) { int R_, C_; stage_rc(tid * 16 + _i * 8192, R_, C_); const int Rb_ = Epi::PERM ? ((R_ & ~31) + perm32(R_ & 31)) : R_; \
        if (GATHER) { const int i0_ = R_ < (u).aux ? (u).rows[R_] : 0, i1_ = (HALF + R_) < (u).aux ? (u).rows[HALF + R_] : 0; \
            voffA[0][_i] = (unsigned)i0_ * (u).lda + (unsigned)C_ * 2u; voffA[1][_i] = (unsigned)i1_ * (u).lda + (unsigned)C_ * 2u; } \
        else { voffA[0][_i] = (unsigned)R_ * (u).lda + (unsigned)C_ * 2u; voffA[1][_i] = voffA[0][_i]; } \
        voffB[_i] = (unsigned)Rb_ * (u).ldb + (unsigned)C_ * 2u; } hstepB = (size_t)HALF * (u).ldb; hstepA = GATHER ? (size_t)0 : (size_t)HALF * (u).lda; } while (0)
#define GE_SA(b, h) (((b) * 2 + (h)) * HTB)
#define GE_SB(b, h) ((4 + (b) * 2 + (h)) * HTB)
#define GE_STAGE(bufoff, gbase, voff) do { _Pragma("unroll") for (int _i = 0; _i < 2; ++_i) \
        __builtin_amdgcn_global_load_lds((const unsigned*)((const char*)(gbase) + (voff)[_i]), (LAS unsigned*)(lds + (bufoff) + ldsw + _i * 8192), 16, 0, 0); } while (0)
#define GE_LDA(dst, b, h) do { _Pragma("unroll") for (int m = 0; m < 4; ++m) _Pragma("unroll") for (int k = 0; k < 2; ++k) dst[m][k] = *(const LAS bf16x8*)(lds + GE_SA(b, h) + aoff + m * 2048 + k * 1024); } while (0)
#define GE_LDB(dst, b, h) do { _Pragma("unroll") for (int n = 0; n < 2; ++n) _Pragma("unroll") for (int k = 0; k < 2; ++k) dst[n][k] = *(const LAS bf16x8*)(lds + GE_SB(b, h) + boff + n * 2048 + k * 1024); } while (0)
#define GE_MMA(ai, bj, At, Bt) do { __builtin_amdgcn_s_setprio(1); _Pragma("unroll") for (int m = 0; m < 4; ++m) _Pragma("unroll") for (int n = 0; n < 2; ++n) _Pragma("unroll") for (int k = 0; k < 2; ++k) \
        acc[ai][bj][m][n] = __builtin_amdgcn_mfma_f32_16x16x32_bf16(Bt[n][k], At[m][k], acc[ai][bj][m][n], 0, 0, 0); __builtin_amdgcn_s_setprio(0); } while (0)
#define GE_WAIT_V(n) asm volatile("s_waitcnt vmcnt(" #n ")" ::: "memory")
#define GE_WAIT_L(n) asm volatile("s_waitcnt lgkmcnt(" #n ")" ::: "memory")
#define GE_BAR __builtin_amdgcn_s_barrier()
#define GE_SCHED __builtin_amdgcn_sched_barrier(0)
    Unit cur, nxt; int ui = 0;
    if (!S.next(0, cur)) return;
    f32x4 acc[2][2][4][2];
#pragma unroll
    for (int a = 0; a < 2; ++a)
#pragma unroll
        for (int b = 0; b < 2; ++b)
#pragma unroll
            for (int m = 0; m < 4; ++m)
#pragma unroll
                for (int n = 0; n < 2; ++n) acc[a][b][m][n] = (f32x4){0.f, 0.f, 0.f, 0.f};
    bf16x8 At[4][2], B0[2][2], B1[2][2];
    size_t hstepB, hstepA;
    GE_SETV(cur);
    if (GATHER) { VM_WAIT(); }
    const char* cA = cur.A; const char* cB = cur.B;
    GE_STAGE(GE_SB(0, 0), cB, voffB); GE_STAGE(GE_SB(0, 1), cB + hstepB, voffB); GE_STAGE(GE_SA(0, 0), cA, voffA[0]); GE_STAGE(GE_SA(0, 1), cA + hstepA, voffA[1]);
    if (wr == 1) GE_BAR;
    GE_WAIT_V(2); GE_BAR;
    GE_STAGE(GE_SB(1, 0), cB + kstep, voffB); GE_STAGE(GE_SA(1, 0), cA + kstep, voffA[0]); GE_STAGE(GE_SB(1, 1), cB + hstepB + kstep, voffB);
    GE_WAIT_V(6); GE_BAR;
    for (;;) {
        const bool has_next = S.next(ui + 1, nxt);
        const char* nA = has_next ? nxt.A : cA; const char* nB = has_next ? nxt.B : cB;
        const int nt = cur.nt;
        for (int t = 0; t < nt; t += 2) {
            const bool last = (t == nt - 2);
            const char* a1 = cA + (size_t)(t + 1) * kstep;
            const char* a2 = last ? nA : cA + (size_t)(t + 2) * kstep; const char* b2 = last ? nB : cB + (size_t)(t + 2) * kstep;
            const char* a3 = a2 + kstep; const char* b3 = b2 + kstep;
            GE_LDB(B0, 0, 0); GE_LDB(B1, 0, 1); GE_SCHED; GE_LDA(At, 0, 0); GE_STAGE(GE_SA(1, 1), a1 + hstepA, voffA[1]);
            GE_WAIT_V(8); GE_WAIT_L(0); GE_BAR; GE_MMA(0, 0, At, B0); GE_MMA(0, 1, At, B1); GE_BAR; GE_SCHED;
            if (last && has_next) { GE_SETV(nxt); if (GATHER) { VM_WAIT(); } }
            GE_LDA(At, 0, 1); GE_STAGE(GE_SB(0, 0), b2, voffB); GE_STAGE(GE_SB(0, 1), b2 + hstepB, voffB); GE_STAGE(GE_SA(0, 0), a2, voffA[0]);
            GE_WAIT_V(8); GE_WAIT_L(0); GE_BAR; GE_MMA(1, 0, At, B0); GE_MMA(1, 1, At, B1); GE_BAR; GE_SCHED;
            GE_LDB(B0, 1, 0); GE_LDB(B1, 1, 1); GE_SCHED; GE_LDA(At, 1, 0); GE_STAGE(GE_SA(0, 1), a2 + hstepA, voffA[1]);
            GE_WAIT_V(8); GE_WAIT_L(0); GE_BAR; GE_MMA(0, 0, At, B0); GE_MMA(0, 1, At, B1); GE_BAR; GE_SCHED;
            GE_LDA(At, 1, 1); GE_STAGE(GE_SB(1, 0), b3, voffB); GE_STAGE(GE_SB(1, 1), b3 + hstepB, voffB); GE_STAGE(GE_SA(1, 0), a3, voffA[0]);
            GE_WAIT_V(8); GE_WAIT_L(0); GE_BAR; GE_MMA(1, 0, At, B0); GE_MMA(1, 1, At, B1); GE_BAR; GE_SCHED;
        }
        if (ALIGN_EPI) { if (wr == 0) GE_BAR; }
        { int tid_o = tid, fr_o = fr, fq_o = fq; asm volatile("" : "+v"(tid_o), "+v"(fr_o), "+v"(fq_o)); E(acc, cur, wr, wc, fr_o, fq_o, tid_o); }
        if (!has_next) break;
#pragma unroll
        for (int a = 0; a < 2; ++a)
#pragma unroll
            for (int b = 0; b < 2; ++b)
#pragma unroll
                for (int m = 0; m < 4; ++m)
#pragma unroll
                    for (int n = 0; n < 2; ++n) acc[a][b][m][n] = (f32x4){0.f, 0.f, 0.f, 0.f};
        cur = nxt; cA = nA; cB = nB; ++ui;
        if (ALIGN_EPI) { if (wr == 1) GE_BAR; }
    }
    GE_WAIT_V(0);
    if (!ALIGN_EPI) { if (wr == 0) GE_BAR; }
    GE_BAR;
#undef GE_SETV
#undef GE_SA
#undef GE_SB
#undef GE_STAGE
#undef GE_LDA
#undef GE_LDB
#undef GE_MMA
#undef GE_WAIT_V
#undef GE_WAIT_L
#undef GE_BAR
#undef GE_SCHED
}
__device__ __forceinline__ unsigned cvt_pk_bf16(float lo, float hi) { unsigned r; asm volatile("v_cvt_pk_bf16_f32 %0, %1, %2" : "=v"(r) : "v"(lo), "v"(hi)); return r; }
}

struct Args { const float* in[29]; float* out; unsigned char* ws; int ph_lo, ph_hi, coop, pad; };
typedef __attribute__((address_space(4))) const Args CArgs;
__device__ __forceinline__ CArgs* kargs() { unsigned long long p = (unsigned long long)__builtin_amdgcn_kernarg_segment_ptr(); asm volatile("" : "+s"(p)); return (CArgs*)p; }
#define KA_DECL CArgs* const KA = kargs()
struct Fr {
    LAS unsigned char* lds;
    int tid, lane, wave, G, bid;
};
enum { I_X = 0, I_C, I_CTX, I_CCTX, I_ADAW, I_ADAB, I_NMIX, I_NFFN, I_WIN, I_CAW, I_CAB, I_HLB, I_HNW, I_SCW, I_SCB, I_ALOG, I_DTB, I_SD, I_SNW, I_WBR, I_WOUT, I_RGW, I_RGB, I_REW, I_REB, I_W1, I_W3, I_W2, I_FNW };

#define WSP(T, off) ((T*)(KA->ws + (off)))

__device__ __forceinline__ const float* xrow_ptr(CArgs* KA, int l, int r) {
    if (l > 0) return WSP(const float, WS_X) + (size_t)r * D;
    const int b = r / RPB, s = r - b * RPB;
    return s < CTXL ? KA->in[I_CTX] + ((size_t)b * CTXL + s) * D : KA->in[I_X] + ((size_t)b * SEQ + (s - CTXL)) * D;
}

__device__ __forceinline__ void transpose_item(const float* W, int ldw, int k0, int n0, bf16* WT, int ldt, int drow0, LAS float* scr, int lane) {
#pragma unroll 8
    for (int i = 0; i < 32; ++i) { const int kk = 2 * i + (lane >> 5); scr[kk * 33 + (lane & 31)] = W[(size_t)(k0 + kk) * ldw + n0 + (lane & 31)]; }
    LDS_WAIT(); asm volatile("" ::: "memory");
    const int c = lane & 7;
#pragma unroll
    for (int j = 0; j < 4; ++j) { const int n = (lane >> 3) + 8 * j; const LAS float* s = scr + (8 * c) * 33 + n;
        u32x4 o; o.x = pk2(s[0 * 33], s[1 * 33]); o.y = pk2(s[2 * 33], s[3 * 33]); o.z = pk2(s[4 * 33], s[5 * 33]); o.w = pk2(s[6 * 33], s[7 * 33]);
        *(u32x4*)(WT + (size_t)(drow0 + n) * ldt + k0 + 8 * c) = o; }
    LDS_WAIT(); asm volatile("" ::: "memory");
}
__device__ __forceinline__ void p0_prologue(Fr& F) { KA_DECL;
    LAS float* scr = (LAS float*)(F.lds + F.wave * 16384);
    const int gw = F.bid * 8 + F.wave, NGW = F.G * 8, lane = F.lane;
    LAS float* ctab = scr + 2200; LAS float* stab = scr + 2264;
    { float s, c; sincospif(2.0f * (float)lane / 64.0f, &s, &c); ctab[lane] = c; stab[lane] = s; }
    LDS_WAIT();
    constexpr int I_INN = 16 * 216, I_DFT = 64, I_BR = 512, I_OUT = 512, I_ADA = 96 * 8;
    constexpr int PER_L = I_INN + I_DFT + I_BR + I_OUT + I_ADA;
    for (int it = gw; it < 2 * PER_L; it += NGW) {
        const int l = it / PER_L; int r = it % PER_L;
        const float* win = KA->in[I_WIN] + (size_t)l * D * NIN;
        bf16* wt_in = WSP(bf16, WT_IN) + (size_t)l * NWIN * D;
        if (r < I_INN) {
            const int kb = r / 216, q = r % 216; int dst, src;
            if (q < 64) { dst = 32 * q; src = 32 * q; } else if (q < 72) { dst = 2560 + 32 * (q - 64); src = 2304 + 32 * (q - 64); }
            else if (q < 88) { dst = 2816 + 32 * (q - 72); src = 2560 + 32 * (q - 72); } else { dst = 3328 + 32 * (q - 88); src = 3080 + 32 * (q - 88); }
            transpose_item(win, NIN, 64 * kb, src, wt_in, D, dst, scr, lane); continue; }
        r -= I_INN;
        if (r < I_DFT) {
            const int kb = r >> 2, g = r & 3; const int k = 64 * kb + lane;
            float w[64];
            const f32x4* src = (const f32x4*)(win + (size_t)k * NIN + 2048 + g * 64);
#pragma unroll
            for (int j = 0; j < 16; ++j) { const f32x4 v = src[j]; w[4 * j] = v.x; w[4 * j + 1] = v.y; w[4 * j + 2] = v.z; w[4 * j + 3] = v.w; }
            for (int cp = 0; cp < 64; ++cp) {
                float ur = 0.f, ui = 0.f;
#pragma unroll
                for (int c = 0; c < 64; ++c) { const int m = (c * cp) & 63; ur += w[c] * ctab[m]; ui -= w[c] * stab[m]; }
                wt_in[(size_t)(C_UR + g * 64 + cp) * D + k] = (bf16)f2bf(ur);
                wt_in[(size_t)(C_UI + g * 64 + cp) * D + k] = (bf16)f2bf(ui);
            }
            continue; }
        r -= I_DFT;
        if (r < I_BR) { const int kbr = r >> 7, q = r & 127, kb = q >> 5, nb = q & 31;
            transpose_item(KA->in[I_WBR] + ((size_t)l * 4 + kbr) * 256 * D, D, 64 * kb, 32 * nb, WSP(bf16, WT_BR) + ((size_t)l * 4 + kbr) * D * 256, 256, 32 * nb, scr, lane); continue; }
        r -= I_BR;
        if (r < I_OUT) { const int kb = r >> 5, nb = r & 31;
            transpose_item(KA->in[I_WOUT] + (size_t)l * D * D, D, 64 * kb, 32 * nb, WSP(bf16, WT_OUT) + (size_t)l * D * D, D, 32 * nb, scr, lane); continue; }
        r -= I_OUT;
        {
            const int jb = r >> 3, ks = r & 7, j = jb * 64 + lane;
            const float* aw = KA->in[I_ADAW] + (size_t)l * D * 6144;
            float a0 = 0.f, a1 = 0.f, a2 = 0.f, a3 = 0.f, a4 = 0.f;
#pragma unroll 4
            for (int kk = 0; kk < 128; ++kk) { const int k = ks * 128 + kk; const float wv = aw[(size_t)k * 6144 + j];
                a0 += siluf_(KA->in[I_C][k]) * wv; a1 += siluf_(KA->in[I_C][D + k]) * wv; a2 += siluf_(KA->in[I_C][2 * D + k]) * wv; a3 += siluf_(KA->in[I_C][3 * D + k]) * wv; a4 += siluf_(KA->in[I_CCTX][k]) * wv; }
            float* part = WSP(float, SM_PART) + ((size_t)(l * 8 + ks) * 5) * 6144 + j;
            part[0] = a0; part[6144] = a1; part[2 * 6144] = a2; part[3 * 6144] = a3; part[4 * 6144] = a4;
        }
    }
    const int gt = F.bid * 512 + F.tid, NGT = F.G * 512;
    float* M1 = WSP(float, SM_M1); float* M2 = WSP(float, SM_M2); float* M3 = WSP(float, SM_M3); float* TW = WSP(float, SM_TW);
    for (int e = gt; e < 128 * 128; e += NGT) {
        const int k = e >> 7, m = e & 127, ri = k >> 6, t1 = k & 63, ro = m >> 6, k1 = m & 63; float s, c; sincospif(2.0f * (float)((t1 * k1) & 63) / 64.0f, &s, &c);
        M1[e] = ro == 0 ? (ri == 0 ? c : s) : (ri == 0 ? -s : c); }
    for (int e = gt; e < 256 * 128; e += NGT) {
        const int k = e >> 7, k2 = e & 127, ri = k >> 7, t2 = k & 127; float s, c; sincospif(2.0f * (float)((t2 * k2) & 127) / 128.0f, &s, &c);
        M2[e] = ri == 0 ? c : s; }
    for (int e = gt; e < 512 * 256; e += NGT) {
        const int k = e >> 8, tp = e & 255, ri = k >> 8, t = k & 255; float s, c; sincospif(2.0f * (float)((t * tp) & 255) / 256.0f, &s, &c);
        M3[e] = ri == 0 ? c : s; }
    for (int e = gt; e < 128 * 64; e += NGT) {
        const int t2 = e >> 6, k1 = e & 63; float s, c; sincospif(2.0f * (float)(t2 * k1) / 8192.0f, &s, &c); TW[2 * e] = c; TW[2 * e + 1] = s; }
}
__device__ __forceinline__ void p1_mod(Fr& F) { KA_DECL;
    const int gt = F.bid * 512 + F.tid, NGT = F.G * 512;
    for (int e = gt; e < 2 * 5 * 6144; e += NGT) { const int l = e / (5 * 6144), rem = e % (5 * 6144), cr = rem / 6144, j = rem % 6144;
        float s = KA->in[I_ADAB][l * 6144 + j];
#pragma unroll
        for (int ks = 0; ks < 8; ++ks) s += WSP(const float, SM_PART)[((size_t)(l * 8 + ks) * 5 + cr) * 6144 + j];
        WSP(float, SM_MOD)[e] = s; }
}
__device__ __forceinline__ void moe_convert(Fr& F, int l) { KA_DECL;
    LAS float* scr = (LAS float*)(F.lds + F.wave * 16384);
    const int gw = F.bid * 8 + F.wave, NGW = F.G * 8, lane = F.lane;
    for (int it = gw; it < 3 * 8192; it += NGW) {
        const int which = it >> 13, r = it & 8191, e = r >> 8, q = r & 255;
        if (which < 2) { const int kb = q >> 4, nb = q & 15; const float* W = KA->in[which == 0 ? I_W1 : I_W3] + ((size_t)l * NE + e) * D * DFF;
            transpose_item(W, DFF, 64 * kb, 32 * nb, WSP(bf16, BG_W13) + (size_t)e * D * D, D, (nb >> 2) * 256 + which * 128 + (nb & 3) * 32, scr, lane); }
        else { const int kb = q >> 5, nb = q & 31; const float* W = KA->in[I_W2] + ((size_t)l * NE + e) * DFF * D;
            transpose_item(W, D, 64 * kb, 32 * nb, WSP(bf16, BG_W2) + (size_t)e * D * DFF, DFF, 32 * nb, scr, lane); }
    }
}

__device__ __forceinline__ void pa_hrows(Fr& F, int l) { KA_DECL;
    LAS float* wdt = (LAS float*)F.lds;
    const float* win = KA->in[I_WIN] + (size_t)l * D * NIN;
    for (int e = F.tid; e < D * 8; e += 512) wdt[e] = win[(size_t)(e >> 3) * NIN + 3072 + (e & 7)];
    __syncthreads();
    const int gw = F.bid * 8 + F.wave, NGW = F.G * 8, lane = F.lane;
    const float* nw = KA->in[I_NMIX] + l * D;
    for (int r = gw; r < R; r += NGW) {
        const int cr = row_cr(r);
        const float* mod = WSP(const float, SM_MOD) + ((size_t)l * 5 + cr) * 6144;
        const f32x4* xr = (const f32x4*)xrow_ptr(KA, l, r) + lane;
        f32x4 v[4]; float s = 0.f;
#pragma unroll
        for (int j = 0; j < 4; ++j) { v[j] = xr[64 * j]; s += (v[j].x * v[j].x + v[j].y * v[j].y) + (v[j].z * v[j].z + v[j].w * v[j].w); }
        const float rstd = 1.0f / sqrtf(wave_sum(s) * (1.f / D) + EPS);
        float d8[8] = {0, 0, 0, 0, 0, 0, 0, 0};
        unsigned long long* o8 = (unsigned long long*)(WSP(bf16, WS_H) + (size_t)r * D) + lane;
#pragma unroll
        for (int j = 0; j < 4; ++j) { const int k = 4 * (lane + 64 * j);
            const f32x4 w4 = *(const f32x4*)(nw + k), sh = *(const f32x4*)(mod + k), sc = *(const f32x4*)(mod + 1024 + k);
            f32x4 h = (v[j] * rstd) * w4 * (sc + 1.0f) + sh;
            o8[64 * j] = (unsigned long long)pk2(h.x, h.y) | ((unsigned long long)pk2(h.z, h.w) << 32);
#pragma unroll
            for (int e = 0; e < 4; ++e) { const f32x4 wa = *(const LAS f32x4*)(wdt + (k + e) * 8), wb = *(const LAS f32x4*)(wdt + (k + e) * 8 + 4); const float hv = h[e];
                d8[0] += hv * wa.x; d8[1] += hv * wa.y; d8[2] += hv * wa.z; d8[3] += hv * wa.w; d8[4] += hv * wb.x; d8[5] += hv * wb.y; d8[6] += hv * wb.z; d8[7] += hv * wb.w; } }
#pragma unroll
        for (int e = 0; e < 8; ++e) d8[e] = wave_sum(d8[e]);
        if (lane == 0) { float* dt = WSP(float, SM_DT) + (size_t)r * 8; *(f32x4*)dt = (f32x4){d8[0], d8[1], d8[2], d8[3]}; *(f32x4*)(dt + 4) = (f32x4){d8[4], d8[5], d8[6], d8[7]}; }
    }
    __syncthreads();
}

__device__ __forceinline__ void nbr_valid(int r, bool& vp, bool& vn) { const int s = r % RPB; vp = (s != 0) && (s != CTXL); vn = (s != CTXL - 1) && (s != RPB - 1); }

__device__ __forceinline__ void conv_a_pass(Fr& F, int l) { KA_DECL;
    const int gt = F.bid * 512 + F.tid, NGT = F.G * 512;
    bf16* P = WSP(bf16, BG_PROJ);
    const float* cw = KA->in[I_CAW] + l * 3 * 256; const float* cb = KA->in[I_CAB] + l * 256;
    for (int e = gt; e < R * 32; e += NGT) {
        const int r = e >> 5, c0 = (e & 31) * 8; bool vp, vn; nbr_valid(r, vp, vn);
        bf16* row = P + (size_t)r * NP;
        const u32x4 zc = {0, 0, 0, 0};
        const u32x4 ac0 = *(const u32x4*)(row + C_AC + c0), ax0 = *(const u32x4*)(row + C_AX + c0), ab = *(const u32x4*)(row + C_AB + c0);
        const u32x4 acp = vp ? *(const u32x4*)(row - NP + C_AC + c0) : zc, axp = vp ? *(const u32x4*)(row - NP + C_AX + c0) : zc;
        const u32x4 acn = vn ? *(const u32x4*)(row + NP + C_AC + c0) : zc, axn = vn ? *(const u32x4*)(row + NP + C_AX + c0) : zc;
        u32x4 o;
#pragma unroll
        for (int q = 0; q < 4; ++q) { float y[2];
#pragma unroll
            for (int hh = 0; hh < 2; ++hh) { const int c = c0 + 2 * q + hh;
                const float up = hh ? bfhi(acp[q]) * bfhi(axp[q]) : bflo(acp[q]) * bflo(axp[q]);
                const float u0 = hh ? bfhi(ac0[q]) * bfhi(ax0[q]) : bflo(ac0[q]) * bflo(ax0[q]);
                const float un = hh ? bfhi(acn[q]) * bfhi(axn[q]) : bflo(acn[q]) * bflo(axn[q]);
                const float b_ = hh ? bfhi(ab[q]) : bflo(ab[q]);
                y[hh] = b_ * (cb[c] + cw[c] * up + cw[256 + c] * u0 + cw[512 + c] * un); }
            o[q] = pk2(y[0], y[1]); }
        *(u32x4*)(row + C_AB + c0) = o;
    }
}
__device__ __forceinline__ void conv_xbc_pass(Fr& F, int l) { KA_DECL;
    const int gt = F.bid * 512 + F.tid, NGT = F.G * 512;
    bf16* P = WSP(bf16, BG_PROJ);
    const float* cw = KA->in[I_SCW] + l * 3 * 512; const float* cb = KA->in[I_SCB] + l * 512;
    for (int e = gt; e < R * 64; e += NGT) {
        const int r = e >> 6, c0 = (e & 63) * 8; bool vp, vn; nbr_valid(r, vp, vn);
        bf16* row = P + (size_t)r * NP;
        const u32x4 zc = {0, 0, 0, 0};
        const u32x4 x0 = *(const u32x4*)(row + C_XBC + c0);
        const u32x4 xp = vp ? *(const u32x4*)(row - NP + C_XBC + c0) : zc, xn = vn ? *(const u32x4*)(row + NP + C_XBC + c0) : zc;
        u32x4 o;
#pragma unroll
        for (int q = 0; q < 4; ++q) { float y[2];
#pragma unroll
            for (int hh = 0; hh < 2; ++hh) { const int c = c0 + 2 * q + hh;
                const float a = hh ? bfhi(xp[q]) : bflo(xp[q]), b_ = hh ? bfhi(x0[q]) : bflo(x0[q]), n_ = hh ? bfhi(xn[q]) : bflo(xn[q]);
                y[hh] = siluf_(cb[c] + cw[c] * a + cw[512 + c] * b_ + cw[1024 + c] * n_); }
            o[q] = pk2(y[0], y[1]); }
        *(u32x4*)(row + (c0 < 256 ? C_XS + c0 : C_BC + (c0 - 256))) = o;
    }
}

template <int MIX  , bool OUT>
__device__ __forceinline__ void span_task(Fr& F, int l, int span) { KA_DECL;
    const int b = span / SPB, sp = span - b * SPB, row0 = b * RPB + sp * 64;
    const int w = F.wave, h = w >> 1, dir = w & 1, lane = F.lane, g = h >> 1;
    bf16* P = WSP(bf16, BG_PROJ) + (size_t)row0 * NP;
    const float* DT = WSP(const float, SM_DT) + (size_t)row0 * 8 + dir * 4 + h;
    float* STp = WSP(float, BG_ST) + ((size_t)((b * 8 + w) * SPB + sp)) * 4096 + lane;
    LAS float* E = (LAS float*)F.lds;
    LAS float* SSQ = (LAS float*)(F.lds + 65536);
    float S[64];
    if (OUT) {
#pragma unroll
        for (int k = 0; k < 64; ++k) S[k] = STp[k * 64];
    } else {
#pragma unroll
        for (int k = 0; k < 64; ++k) S[k] = 0.f;
    }
    float lb = 0.f, dtb = 0.f, Aexp = 0.f, Dh = 0.f;
    if (MIX == 0) { if (l > 0) { const float a0 = KA->in[I_HLB][(dir * DEPTH + 0) * 256 + h * 64 + lane], a1 = KA->in[I_HLB][(dir * DEPTH + l) * 256 + h * 64 + lane]; lb = 1.0f / (1.0f + __expf(a0 - a1)); } }
    else { dtb = KA->in[I_DTB][(l * 2 + dir) * 4 + h]; Aexp = __expf(KA->in[I_ALOG][(l * 2 + dir) * 4 + h]); Dh = KA->in[I_SD][l * 4 + h]; }
    const float oml = 1.0f - lb;
    float dec = 1.0f;
    const int c1 = MIX == 0 ? C_FF + dir * 256 + h * 64 + lane : C_XS + h * 64 + lane;
    const int c2 = MIX == 0 ? C_I + h * 64 + lane : C_BC + g * 64 + lane;
    const int c3 = MIX == 0 ? C_Q + h * 64 + lane : C_BC + 128 + g * 64 + lane;
    const int c4 = C_Z + h * 64 + lane;
    constexpr int BS = (MIX == 1 && OUT) ? 4 : 8;
    unsigned short n1[BS], n2[BS], n3[BS], n4[BS]; float ndt[BS];
    unsigned short r1[BS], r2[BS], r3[BS], r4[BS]; float rdt[BS];
#pragma unroll
    for (int s_ = 0; s_ < BS; ++s_) { n1[s_] = 0; n2[s_] = 0; n3[s_] = 0; n4[s_] = 0; ndt[s_] = 0.f; }
    const int tstep = dir ? -1 : 1, t0 = dir ? 63 : 0;
#define SP_LOAD(blk) do { const bf16* rb_ = P + (long)(t0 + (blk) * BS * tstep) * NP; const float* db_ = DT + (long)(t0 + (blk) * BS * tstep) * 8; asm volatile("" : "+v"(rb_), "+v"(db_)); \
        _Pragma("unroll") for (int s_ = 0; s_ < BS; ++s_) { const bf16* rp_ = rb_ + (long)(s_ * tstep) * NP; \
        n1[s_] = rp_[c1]; n2[s_] = rp_[c2]; if (OUT || MIX == 1) n3[s_] = rp_[c3]; if (MIX == 1) { ndt[s_] = db_[(long)(s_ * tstep) * 8]; if (OUT) n4[s_] = rp_[c4]; } } } while (0)
    SP_LOAD(0);
    for (int blk = 0; blk < 64 / BS; ++blk) {
#pragma unroll
        for (int s_ = 0; s_ < BS; ++s_) { r1[s_] = n1[s_]; r2[s_] = n2[s_]; r3[s_] = n3[s_]; r4[s_] = n4[s_]; rdt[s_] = ndt[s_]; }
        if (blk < 64 / BS - 1) SP_LOAD(blk + 1);
        if (OUT && blk == 32 / BS) __syncthreads();
#pragma unroll
        for (int s = 0; s < BS; ++s) {
            const int i = blk * BS + s; const int tt = dir ? 63 - i : i;
            float o = 0.f, xv = 0.f;
            if (MIX == 0) {
                const float fr_ = bf2f(r1[s]), vv = bf2f(r2[s]);
                const float sg = sigmoidf_(fr_), fg = lb + oml * sg;
                float qq = 0.f; if (OUT) { const float qr = bf2f(r3[s]); qq = siluf_(qr); }
                dec *= fg;
                int fgi = __builtin_bit_cast(int, fg), qqi = __builtin_bit_cast(int, qq);
#pragma unroll
                for (int k = 0; k < 64; ++k) { const float f_ = __builtin_bit_cast(float, __builtin_amdgcn_readlane(fgi, k));
                    S[k] = vv + f_ * (S[k] - vv);
                    if (OUT) { const float q_ = __builtin_bit_cast(float, __builtin_amdgcn_readlane(qqi, k)); o += q_ * S[k]; }
                    if ((k & 7) == 7) asm volatile("" : "+v"(fgi), "+v"(qqi), "+v"(S[k - 7]), "+v"(S[k - 6]), "+v"(S[k - 5]), "+v"(S[k - 4]), "+v"(S[k - 3]), "+v"(S[k - 2]), "+v"(S[k - 1]), "+v"(S[k])); }
            } else {
                xv = bf2f(r1[s]); const float Bv = bf2f(r2[s]), Cv = bf2f(r3[s]);
                const float dt = softplusf_(rdt[s] + dtb), a = __expf(-dt * Aexp), bdt = Bv * dt;
                dec *= a;
                int bdi = __builtin_bit_cast(int, bdt), cvi = __builtin_bit_cast(int, Cv);
#pragma unroll
                for (int k = 0; k < 64; ++k) { const float b_ = __builtin_bit_cast(float, __builtin_amdgcn_readlane(bdi, k));
                    S[k] = a * S[k] + b_ * xv;
                    if (OUT) { const float c_ = __builtin_bit_cast(float, __builtin_amdgcn_readlane(cvi, k)); o += c_ * S[k]; }
                    if ((k & 7) == 7) asm volatile("" : "+v"(bdi), "+v"(cvi), "+v"(S[k - 7]), "+v"(S[k - 6]), "+v"(S[k - 5]), "+v"(S[k - 4]), "+v"(S[k - 3]), "+v"(S[k - 2]), "+v"(S[k - 1]), "+v"(S[k])); }
            }
            if (OUT) {
                if (i < 32) E[(w * 32 + i) * 64 + lane] = o;
                else { LAS float* slot = E + ((w ^ 1) * 32 + (63 - i)) * 64 + lane;
                    float tot = o + *slot;
                    if (MIX == 1) { const float z = bf2f(r4[s]); tot = (tot + Dh * xv) * siluf_(z); }
                    const float q2 = wave_sum(tot * tot);
                    if (lane == 0) SSQ[h * 64 + tt] = q2;
                    *slot = tot; }
            }
        }
    }
#undef SP_LOAD
    if (!OUT) {
#pragma unroll
        for (int k = 0; k < 64; ++k) STp[k * 64] = S[k];
        WSP(float, SM_DEC)[((size_t)((b * 8 + w) * SPB + sp)) * 64 + lane] = dec;
    } else {
        __syncthreads();
        const float* nwp = MIX == 0 ? KA->in[I_HNW] + l * 64 : KA->in[I_SNW] + l * 256;
#pragma unroll 4
        for (int it = 0; it < 32; ++it) { const int e = it * 512 + F.tid, tt = e >> 8, ch = e & 255, hh = ch >> 6, dv = ch & 63;
            const float v = tt < 32 ? E[((2 * hh) * 32 + tt) * 64 + dv] : E[((2 * hh + 1) * 32 + (63 - tt)) * 64 + dv];
            float y;
            if (MIX == 0) { const float rs = 1.0f / sqrtf(SSQ[hh * 64 + tt] * (1.f / 64.f) + EPS); const float gr = bf2f(P[(size_t)tt * NP + C_G + ch]); y = v * rs * nwp[dv] * siluf_(gr); }
            else { const int g2 = hh >> 1; const float rs = 1.0f / sqrtf((SSQ[(2 * g2) * 64 + tt] + SSQ[(2 * g2 + 1) * 64 + tt]) * (1.f / 128.f) + EPS); y = v * rs * nwp[ch]; }
            P[(size_t)tt * NP + (MIX == 0 ? C_Q : C_Z) + ch] = (bf16)f2bf(y); }
        __syncthreads();
    }
}
__device__ __forceinline__ void state_scan(Fr& F) { KA_DECL;
    for (int e = F.bid * 512 + F.tid; e < NB * 8 * 4096; e += F.G * 512) {
    const int bh = e >> 12, idx = e & 4095, dk = idx >> 6, dir = bh & 1;
    float* ST = WSP(float, BG_ST) + (size_t)bh * SPB * 4096 + idx; const float* DC = WSP(const float, SM_DEC) + (size_t)bh * SPB * 64 + dk;
    float st = 0.f;
    for (int p0 = 0; p0 < SPB; p0 += 12) {
        float loc[12], d[12]; int spx[12];
#pragma unroll
        for (int j = 0; j < 12; ++j) { const int p = p0 + j; spx[j] = dir ? (p < 4 ? 3 - p : 135 - p) : p; loc[j] = ST[(size_t)spx[j] * 4096]; d[j] = DC[spx[j] * 64]; }
#pragma unroll
        for (int j = 0; j < 12; ++j) { if (DBG_NOCTX && (p0 + j) == 4) st = 0.f; ST[(size_t)spx[j] * 4096] = st; st = d[j] * st + loc[j]; }
    }
    }
}

__device__ __forceinline__ void fft_stage_a(Fr& F, int unit) { KA_DECL;
    const int b = unit >> 7, t2 = unit & 127, lane = F.lane, w = F.wave, ch = 32 * w + (lane & 31), kh = lane >> 5;
    const bf16* U = WSP(const bf16, BG_PROJ) + ((size_t)b * RPB + CTXL + t2) * NP + C_UR + ch;
    const float* M1 = WSP(const float, SM_M1) + (lane & 31);
    f32x16 acc[4];
#pragma unroll
    for (int m = 0; m < 4; ++m)
#pragma unroll
        for (int q = 0; q < 16; ++q) acc[m][q] = 0.f;
#pragma unroll 4
    for (int k0 = 0; k0 < 128; k0 += 2) { const int k = k0 + kh, ri = k >> 6, t1 = k & 63;
        const float bv = bf2f(U[(size_t)(128 * t1) * NP + ri * 256]);
#pragma unroll
        for (int m = 0; m < 4; ++m) acc[m] = __builtin_amdgcn_mfma_f32_32x32x2f32(M1[k * 128 + 32 * m], bv, acc[m], 0, 0, 0); }
    bf16* AP = WSP(bf16, BG_AP) + (size_t)b * 64 * 2 * 128 * 256;
    const float* TW = WSP(const float, SM_TW) + (size_t)t2 * 128;
#pragma unroll
    for (int m = 0; m < 2; ++m)
#pragma unroll
        for (int q = 0; q < 16; ++q) { const int k1 = 32 * m + (q & 3) + 8 * (q >> 2) + 4 * kh; const float c = TW[2 * k1], s = TW[2 * k1 + 1];
            const float ar = acc[m][q], ai = acc[m + 2][q];
            bf16* dst = AP + ((size_t)(k1 * 2) * 128 + t2) * 256 + ch;
            dst[0] = (bf16)f2bf(ar * c + ai * s); dst[128 * 256] = (bf16)f2bf(ai * c - ar * s); }
}
__device__ __forceinline__ void fft_stage_b(Fr& F, int unit) { KA_DECL;
    const int b = unit >> 6, k1 = unit & 63, lane = F.lane, w = F.wave, ch = 32 * w + (lane & 31), kh = lane >> 5;
    const bf16* AP = WSP(const bf16, BG_AP) + ((size_t)(b * 64 + k1) * 2) * 128 * 256 + ch;
    const float* M2 = WSP(const float, SM_M2) + (lane & 31);
    f32x16 acc[4];
#pragma unroll
    for (int m = 0; m < 4; ++m)
#pragma unroll
        for (int q = 0; q < 16; ++q) acc[m][q] = 0.f;
#pragma unroll 4
    for (int k0 = 0; k0 < 256; k0 += 2) { const int k = k0 + kh;
        const float bv = bf2f(AP[(size_t)k * 256]);
#pragma unroll
        for (int m = 0; m < 4; ++m) acc[m] = __builtin_amdgcn_mfma_f32_32x32x2f32(M2[k * 128 + 32 * m], bv, acc[m], 0, 0, 0); }
    bf16* P = WSP(bf16, BG_PROJ) + ((size_t)b * RPB + CTXL + k1) * NP + C_UR + ch;
    const float scale = 0.001381067932f;
#pragma unroll
    for (int m = 0; m < 4; ++m)
#pragma unroll
        for (int q = 0; q < 16; ++q) { const int k2 = 32 * m + (q & 3) + 8 * (q >> 2) + 4 * kh; P[(size_t)(64 * k2) * NP] = (bf16)f2bf(acc[m][q] * scale); }
}
__device__ __forceinline__ void fft_ctx(Fr& F, int unit) { KA_DECL;
    const int b = unit >> 2, mq = unit & 3, lane = F.lane, w = F.wave, ch = 32 * w + (lane & 31), kh = lane >> 5;
    const bf16* U = WSP(const bf16, BG_PROJ) + ((size_t)b * RPB) * NP + C_UR + ch;
    const float* M3 = WSP(const float, SM_M3) + 64 * mq + (lane & 31);
    f32x16 acc[2];
#pragma unroll
    for (int m = 0; m < 2; ++m)
#pragma unroll
        for (int q = 0; q < 16; ++q) acc[m][q] = 0.f;
#pragma unroll 4
    for (int k0 = 0; k0 < 512; k0 += 2) { const int k = k0 + kh, ri = k >> 8, t = k & 255;
        const float bv = bf2f(U[(size_t)t * NP + ri * 256]);
#pragma unroll
        for (int m = 0; m < 2; ++m) acc[m] = __builtin_amdgcn_mfma_f32_32x32x2f32(M3[k * 256 + 32 * m], bv, acc[m], 0, 0, 0); }
    bf16* CY = WSP(bf16, SM_CY) + (size_t)b * 256 * 256 + ch;
#pragma unroll
    for (int m = 0; m < 2; ++m)
#pragma unroll
        for (int q = 0; q < 16; ++q) { const int tp = 64 * mq + 32 * m + (q & 3) + 8 * (q >> 2) + 4 * kh; CY[(size_t)tp * 256] = (bf16)f2bf(acc[m][q] * (1.0f / 128.0f)); }
}
__device__ __forceinline__ void ctx_y_copy(Fr& F) { KA_DECL;
    const int gt = F.bid * 512 + F.tid, NGT = F.G * 512;
    for (int e = gt; e < NB * 256 * 32; e += NGT) { const int b = e >> 13, t = (e >> 5) & 255, c0 = (e & 31) * 8;
        *(u32x4*)(WSP(bf16, BG_PROJ) + ((size_t)b * RPB + t) * NP + C_UR + c0) = *(const u32x4*)(WSP(const bf16, SM_CY) + ((size_t)b * 256 + t) * 256 + c0); }
}

struct SchedGrid {
    const char* A; const char* B; unsigned lda, ldb; int nt, nM, nN, G, c; bool skip_ctx;
    __device__ __forceinline__ bool next(int i, ge::Unit& u) const {
        int pm, pn; if (!ge::tile_order((long)i * G + c, nM, nN, pm, pn)) return false;
        if (skip_ctx) pm = (pm >> 5) * 33 + 1 + (pm & 31);
        u.A = A + (size_t)pm * 256 * lda; u.B = B + (size_t)pn * 256 * ldb; u.rows = nullptr; u.lda = lda; u.ldb = ldb; u.nt = nt; u.kind = 0; u.pm = pm; u.pn = pn; u.aux = 256; return true; }
};
struct EpiStore {
    static constexpr bool PERM = true;
    bf16* O; int ldc;
    __device__ __forceinline__ void operator()(const f32x4 (&acc)[2][2][4][2], const ge::Unit& u, int wr, int wc, int fr, int fq, int tid) const {
        const int row0 = u.pm * 256 + wr * 64 + fr, col0 = u.pn * 256 + wc * 32 + 8 * fq;
#pragma unroll
        for (int ai = 0; ai < 2; ++ai)
#pragma unroll
            for (int m = 0; m < 4; ++m) { bf16* rowp = O + (size_t)(row0 + ai * 128 + m * 16) * ldc + col0;
#pragma unroll
                for (int bj = 0; bj < 2; ++bj) { const f32x4 v0 = acc[ai][bj][m][0], v1 = acc[ai][bj][m][1]; u32x4 w;
                    w.x = ge::cvt_pk_bf16(v0[0], v0[1]); w.y = ge::cvt_pk_bf16(v0[2], v0[3]); w.z = ge::cvt_pk_bf16(v1[0], v1[1]); w.w = ge::cvt_pk_bf16(v1[2], v1[3]);
                    *(u32x4*)(rowp + bj * 128) = w; } }
    }
};
struct SchedD1 {
    const char* H; const char* P; const char* Wg; const char* Wb; int nM, G, c; bool skip_ctx;
    __device__ __forceinline__ bool next(int i, ge::Unit& u) const {
        const int ti = i >> 3, sub = i & 7, k = sub >> 1; int pm, pn; if (!ge::tile_order((long)ti * G + c, nM, 4, pm, pn)) return false;
        if (skip_ctx) pm = (pm >> 5) * 33 + 1 + (pm & 31);
        u.rows = nullptr; u.pm = pm; u.pn = pn; u.aux = 256;
        if (!(sub & 1)) { u.A = H + (size_t)pm * 256 * 2048; u.lda = 2048; u.B = Wg + ((size_t)k * 1024 + pn * 256) * 2048; u.ldb = 2048; u.nt = 16; u.kind = 0; }
        else { const int colk = k == 0 ? C_AB : (k == 1 ? C_Q : (k == 2 ? C_UR : C_Z));
            u.A = P + (size_t)pm * 256 * (NP * 2) + colk * 2; u.lda = NP * 2; u.B = Wb + ((size_t)k * 1024 + pn * 256) * 512; u.ldb = 512; u.nt = 4; u.kind = 1 + k; }
        return true; }
};
#ifndef DBG_L
#define DBG_L 1
#endif
#ifndef MOE_SCALE
#define MOE_SCALE 2.0f
#endif
#ifndef DBG_D1
#define DBG_D1 0
#endif
#ifndef BRMASK
#define BRMASK 15
#endif
struct EpiD1 {
    static constexpr bool PERM = true;
    bf16* M; unsigned char* scr;
    __device__ __forceinline__ void operator()(const f32x4 (&acc)[2][2][4][2], const ge::Unit& u, int wr, int wc, int fr, int fq, int tid) const {
        const int row0 = u.pm * 256 + wr * 64 + fr, col0 = u.pn * 256 + wc * 32 + 8 * fq;
#pragma unroll
        for (int ai = 0; ai < 2; ++ai)
#pragma unroll
            for (int m = 0; m < 4; ++m)
#pragma unroll
                for (int bj = 0; bj < 2; ++bj) { const int piece = (ai * 4 + m) * 2 + bj; u32x4* sp = (u32x4*)(scr + (size_t)tid * 256) + piece;
                    const f32x4 v0 = acc[ai][bj][m][0], v1 = acc[ai][bj][m][1];
                    if (u.kind == 0) { u32x4 w;
                        w.x = ge::cvt_pk_bf16(sigmoidf_(v0[0]), sigmoidf_(v0[1])); w.y = ge::cvt_pk_bf16(sigmoidf_(v0[2]), sigmoidf_(v0[3]));
                        w.z = ge::cvt_pk_bf16(sigmoidf_(v1[0]), sigmoidf_(v1[1])); w.w = ge::cvt_pk_bf16(sigmoidf_(v1[2]), sigmoidf_(v1[3])); *sp = w; }
                    else { const u32x4 g = *sp; u32x4* mp = (u32x4*)(M + (size_t)(row0 + ai * 128 + m * 16) * D + col0 + bj * 128);
                        const float bm = ((BRMASK >> (u.kind - 1)) & 1) ? 1.f : 0.f;
                        if (DBG_D1 == 1 && u.kind == 1) { *mp = g; continue; } if (DBG_D1 == 2 && u.kind == 1) { u32x4 w_; w_.x = ge::cvt_pk_bf16(v0[0], v0[1]); w_.y = ge::cvt_pk_bf16(v0[2], v0[3]); w_.z = ge::cvt_pk_bf16(v1[0], v1[1]); w_.w = ge::cvt_pk_bf16(v1[2], v1[3]); *mp = w_; continue; } if (DBG_D1 && u.kind > 1) continue;
                        float o[8] = {bm * bflo(g.x) * v0[0], bm * bfhi(g.x) * v0[1], bm * bflo(g.y) * v0[2], bm * bfhi(g.y) * v0[3], bm * bflo(g.z) * v1[0], bm * bfhi(g.z) * v1[1], bm * bflo(g.w) * v1[2], bm * bfhi(g.w) * v1[3]};
                        if (u.kind > 1) { const u32x4 p = *mp; o[0] += bflo(p.x); o[1] += bfhi(p.x); o[2] += bflo(p.y); o[3] += bfhi(p.y); o[4] += bflo(p.z); o[5] += bfhi(p.z); o[6] += bflo(p.w); o[7] += bfhi(p.w); }
                        u32x4 w; w.x = ge::cvt_pk_bf16(o[0], o[1]); w.y = ge::cvt_pk_bf16(o[2], o[3]); w.z = ge::cvt_pk_bf16(o[4], o[5]); w.w = ge::cvt_pk_bf16(o[6], o[7]); *mp = w; }
                    if (bj) asm volatile("" ::: "memory"); }
    }
};
struct EpiResid {
    static constexpr bool PERM = false;
    const float* in_x; const float* in_ctx; float* X; const float* mod; int l;
    __device__ __forceinline__ void operator()(const f32x4 (&acc)[2][2][4][2], const ge::Unit& u, int wr, int wc, int fr, int fq, int tid) const {
        const int b = u.pm / 33, j = u.pm - b * 33;
        const float* src = l > 0 ? (const float*)X + (size_t)u.pm * 256 * D : (j == 0 ? in_ctx + (size_t)b * CTXL * D : in_x + ((size_t)b * SEQ + (size_t)(j - 1) * 256) * D);
        const float* gv = mod + (size_t)(j == 0 ? 4 : b) * 6144 + 2048;
        float* dst = X + (size_t)u.pm * 256 * D;
        const int col0 = u.pn * 256 + wc * 32 + 4 * fq;
#pragma unroll
        for (int ai = 0; ai < 2; ++ai)
#pragma unroll
            for (int m = 0; m < 4; ++m) { const size_t ro = (size_t)(ai * 128 + wr * 64 + m * 16 + fr) * D;
#pragma unroll
                for (int bj = 0; bj < 2; ++bj)
#pragma unroll
                    for (int n = 0; n < 2; ++n) { const int col = col0 + bj * 128 + n * 16;
                        const f32x4 xo = *(const f32x4*)(src + ro + col), gg = *(const f32x4*)(gv + col);
                        *(f32x4*)(dst + ro + col) = xo + gg * acc[ai][bj][m][n]; } }
    }
};
__device__ __forceinline__ void moe_prefix(Fr& F, int l) { KA_DECL;
    LAS int* ts = (LAS int*)(F.lds + RING_BYTES); LAS int* cn = (LAS int*)(F.lds + RING_BYTES + 160);
    __syncthreads();
    if (F.tid == 0) { int acc = 0; const unsigned* cnt = WSP(const unsigned, WS_CTL) + CW_CNT + l * 32;
        for (int e = 0; e < NE; ++e) { const int c = (int)__hip_atomic_load(cnt + e, RLX_AGENT); ts[e] = acc; cn[e] = c; acc += (c + 255) >> 8; }
        ts[NE] = acc; }
    __syncthreads();
}
struct SchedMoE {
    const LAS int* ts; const LAS int* cn; int stage; const char* A; const char* W; const int* list; int G, vc;
    __device__ __forceinline__ bool next(int i, ge::Unit& u) const {
        const int L = i * G + vc, T = L >> 2, pn = L & 3; if (T >= ts[NE] || T >= MAXT) return false;
        int e = 0; while (ts[e + 1] <= T) ++e;
        const int t = T - ts[e];
        u.pm = T; u.pn = pn; u.kind = 0;
        if (stage == 1) { u.A = A; u.rows = list + (size_t)e * R + t * 256; u.aux = min(256, cn[e] - t * 256); u.lda = 2048; u.B = W + (size_t)e * (D * D * 2) + (size_t)pn * 256 * 2048; u.ldb = 2048; u.nt = 16; }
        else { u.A = A + (size_t)T * 256 * 1024; u.rows = nullptr; u.aux = 256; u.lda = 1024; u.B = W + (size_t)e * (D * DFF * 2) + (size_t)pn * 256 * 1024; u.ldb = 1024; u.nt = 8; }
        return true; }
};
struct EpiAct {
    static constexpr bool PERM = true;
    bf16* O;
    __device__ __forceinline__ void operator()(const f32x4 (&acc)[2][2][4][2], const ge::Unit& u, int wr, int wc, int fr, int fq, int tid) const {
        const int row0 = u.pm * 256 + wr * 64 + fr, col0 = u.pn * 128 + wc * 32 + 8 * fq;
#pragma unroll
        for (int ai = 0; ai < 2; ++ai)
#pragma unroll
            for (int m = 0; m < 4; ++m) { const f32x4 a0 = acc[ai][0][m][0], a1 = acc[ai][0][m][1], b0 = acc[ai][1][m][0], b1 = acc[ai][1][m][1]; u32x4 w;
                w.x = ge::cvt_pk_bf16(siluf_(a0[0]) * b0[0], siluf_(a0[1]) * b0[1]); w.y = ge::cvt_pk_bf16(siluf_(a0[2]) * b0[2], siluf_(a0[3]) * b0[3]);
                w.z = ge::cvt_pk_bf16(siluf_(a1[0]) * b1[0], siluf_(a1[1]) * b1[1]); w.w = ge::cvt_pk_bf16(siluf_(a1[2]) * b1[2], siluf_(a1[3]) * b1[3]);
                *(u32x4*)(O + (size_t)(row0 + ai * 128 + m * 16) * DFF + col0) = w; }
    }
};

__device__ __forceinline__ int act_row(int l, int q) { return l == 0 ? q : (q >> 13) * RPB + CTXL + (q & 8191); }
__device__ __forceinline__ void pe1_router(Fr& F, int l) { KA_DECL;
    const int nrows = l == 0 ? R : NB * SEQ;
    const int gw = F.bid * 8 + F.wave, NGW = F.G * 8, lane = F.lane;
    const float* nw = KA->in[I_NFFN] + l * D;
    const float* rgw = KA->in[I_RGW] + (size_t)l * D * 4; const float* rew = KA->in[I_REW] + (size_t)l * D * 32;
    const float* rgb = KA->in[I_RGB] + l * 4; const float* reb = KA->in[I_REB] + l * 32;
    unsigned* cnt = WSP(unsigned, WS_CTL) + CW_CNT + l * 32;
    for (int q = gw; q < nrows; q += NGW) {
        float a[36];
#pragma unroll
        for (int j = 0; j < 36; ++j) a[j] = 0.f;
        f32x4 f[4];
        const int r = act_row(l, q);
        {   const float* mod = WSP(const float, SM_MOD) + ((size_t)l * 5 + row_cr(r)) * 6144;
            const f32x4* xr = (const f32x4*)(WSP(const float, WS_X) + (size_t)r * D) + lane; float s = 0.f;
#pragma unroll
            for (int j = 0; j < 4; ++j) { f[j] = xr[64 * j]; const f32x4 v = f[j]; s += (v.x * v.x + v.y * v.y) + (v.z * v.z + v.w * v.w); }
            const float rstd = 1.0f / sqrtf(wave_sum(s) * (1.f / D) + EPS);
            unsigned long long* o8 = (unsigned long long*)(WSP(bf16, WS_H) + (size_t)r * D) + lane;
#pragma unroll
            for (int j = 0; j < 4; ++j) { const int k = 4 * (lane + 64 * j);
                const f32x4 w4 = *(const f32x4*)(nw + k), sh = *(const f32x4*)(mod + 3072 + k), sc = *(const f32x4*)(mod + 4096 + k);
                const f32x4 h = (f[j] * rstd) * w4 * (sc + 1.0f) + sh; f[j] = h;
                o8[64 * j] = (unsigned long long)pk2(h.x, h.y) | ((unsigned long long)pk2(h.z, h.w) << 32); } }
#pragma unroll
        for (int j = 0; j < 4; ++j)
#pragma unroll
            for (int e = 0; e < 4; ++e) { const int k = 4 * (lane + 64 * j) + e;
                const f32x4 wg = *(const f32x4*)(rgw + (size_t)k * 4); const f32x4* wep = (const f32x4*)(rew + (size_t)k * 32);
                const float fv = f[j][e];
#pragma unroll
                for (int t = 0; t < 4; ++t) a[t] += fv * wg[t];
#pragma unroll
                for (int t = 0; t < 8; ++t) { const f32x4 we = wep[t]; a[4 + 4 * t] += fv * we.x; a[5 + 4 * t] += fv * we.y; a[6 + 4 * t] += fv * we.z; a[7 + 4 * t] += fv * we.w; }
                asm volatile("" ::: "memory"); }
        {
#pragma unroll
            for (int j = 0; j < 36; ++j) a[j] = wave_sum(a[j]) + (j < 4 ? rgb[j] : reb[j - 4]);
            int gt = 0; float gm = a[0];
#pragma unroll
            for (int j = 1; j < 4; ++j) if (a[j] > gm) { gm = a[j]; gt = j; }
            float gs = 0.f;
#pragma unroll
            for (int j = 0; j < 4; ++j) gs += __expf(a[j] - gm);
            const float pg = 1.0f / gs;
            float el[8];
#pragma unroll
            for (int i = 0; i < 8; ++i) el[i] = gt == 0 ? a[4 + i] : (gt == 1 ? a[12 + i] : (gt == 2 ? a[20 + i] : a[28 + i]));
            int i1 = 0; float m1 = el[0];
#pragma unroll
            for (int i = 1; i < 8; ++i) if (el[i] > m1) { m1 = el[i]; i1 = i; }
            int i2 = -1; float m2 = -3.0e38f;
#pragma unroll
            for (int i = 0; i < 8; ++i) if (i != i1 && el[i] > m2) { m2 = el[i]; i2 = i; }
            const float e2 = __expf(m2 - m1), den = 1.0f / (1.0f + e2);
            const float w1 = pg * den, w2 = pg * e2 * den;
            if (lane == 0) { const int x1 = gt * 8 + i1, x2 = gt * 8 + i2;
                const unsigned k1 = __hip_atomic_fetch_add(cnt + x1, 1u, RLX_AGENT), k2 = __hip_atomic_fetch_add(cnt + x2, 1u, RLX_AGENT);
                int* lst = WSP(int, SM_LIST); lst[(size_t)x1 * R + k1] = r; lst[(size_t)x2 * R + k2] = r;
                u32x4* tk = (u32x4*)(WSP(unsigned, SM_TOK) + (size_t)r * 8);
                tk[0] = (u32x4){(unsigned)x1, (unsigned)x2, k1, k2}; tk[1] = (u32x4){__builtin_bit_cast(unsigned, w1), __builtin_bit_cast(unsigned, w2), 0u, 0u}; }
        }
    }
}
__device__ __forceinline__ void pe4_combine(Fr& F, int l) { KA_DECL;
    const LAS int* ts = (const LAS int*)(F.lds + RING_BYTES);
    const int nrows = l == 0 ? R : NB * SEQ;
    const int gw = F.bid * 8 + F.wave, NGW = F.G * 8, lane = F.lane;
    const bf16* YO = WSP(const bf16, BG_YO);
    for (int q = gw; q < nrows; q += NGW) { const int r = act_row(l, q);
        const unsigned* tkp = WSP(const unsigned, SM_TOK) + (size_t)r * 8;
        const unsigned te1 = tkp[0], te2 = tkp[1], tr1 = tkp[2], tr2 = tkp[3];
        const size_t s1 = (size_t)ts[te1] * 256 + tr1, s2 = (size_t)ts[te2] * 256 + tr2;
        const float w1 = __builtin_bit_cast(float, tkp[4]), w2 = __builtin_bit_cast(float, tkp[5]);
        const float* mod = WSP(const float, SM_MOD) + ((size_t)l * 5 + row_cr(r)) * 6144 + 5120;
        f32x4* xr = (f32x4*)(WSP(float, WS_X) + (size_t)r * D) + lane;
        const u32x2* y1 = (const u32x2*)(YO + s1 * D) + lane; const u32x2* y2 = (const u32x2*)(YO + s2 * D) + lane;
        f32x4 xn[4]; float ss = 0.f;
#pragma unroll
        for (int j = 0; j < 4; ++j) { const int k = 4 * (lane + 64 * j); const f32x4 x = xr[64 * j], gg = *(const f32x4*)(mod + k); const u32x2 a = y1[64 * j], b = y2[64 * j];
            const f32x4 ya = {bflo(a.x), bfhi(a.x), bflo(a.y), bfhi(a.y)}, yb = {bflo(b.x), bfhi(b.x), bflo(b.y), bfhi(b.y)};
            xn[j] = x + gg * (ya * w1 + yb * w2) * DBG_E4S; const f32x4 v = xn[j]; ss += (v.x * v.x + v.y * v.y) + (v.z * v.z + v.w * v.w); }
        if (l == DEPTH - 1) { const float rstd = 1.0f / sqrtf(wave_sum(ss) * (1.f / D) + EPS);
            const int b = r / RPB, s = r - b * RPB; f32x4* orow = (f32x4*)(KA->out + ((size_t)b * SEQ + (s - CTXL)) * D) + lane;
#pragma unroll
            for (int j = 0; j < 4; ++j) { const int k = 4 * (lane + 64 * j); orow[64 * j] = xn[j] * rstd * *(const f32x4*)(KA->in[I_FNW] + k); } }
        else {
#pragma unroll
            for (int j = 0; j < 4; ++j) xr[64 * j] = xn[j]; }
    }
}

constexpr int PH_PER_L = 14, N_PHASES = 2 + DEPTH * PH_PER_L;
#define PON(x) (PHSEL < 0 || PHSEL == (x))

template <bool COOP, int PHSEL>
__global__ void __launch_bounds__(512, 2) mk(Args a) {
    extern __shared__ __attribute__((aligned(16))) unsigned char lds_raw[];
    Fr F;
    F.lds = (LAS unsigned char*)lds_raw;
    F.tid = threadIdx.x; F.lane = F.tid & 63; F.wave = __builtin_amdgcn_readfirstlane(F.tid >> 6); F.G = gridDim.x; F.bid = blockIdx.x;
    for (int u = F.tid; u < (LDS_BYTES - RING_BYTES) / 4; u += 512) ((LAS unsigned*)(F.lds + RING_BYTES))[u] = 0u;
    __syncthreads();
    XcdBarrier bar; bar.bar = nullptr; bar.x = 0; bar.st = nullptr;
    if (COOP) { KA_DECL; bar = xcd_barrier_post(WSP(unsigned, WS_CTL) + CW_BAR, (volatile LAS unsigned*)(F.lds + MISC_OFF) + 8); }

    for (int ph = a.ph_lo; ph < a.ph_hi; ++ph) {
        {
            int tid_ = threadIdx.x, bid_ = blockIdx.x, g_ = gridDim.x; asm volatile("" : "+v"(tid_)); asm volatile("" : "+s"(bid_), "+s"(g_));
            F.tid = tid_; F.lane = tid_ & 63; F.wave = __builtin_amdgcn_readfirstlane(tid_ >> 6); F.bid = bid_; F.G = g_; }
        const int vc = (F.G % 8 == 0) ? (F.bid % 8) * (F.G / 8) + F.bid / 8 : F.bid;
        if (ph == 0) { if (PON(100)) p0_prologue(F); }
        else if (ph == 1) { if (PON(101)) p1_mod(F); }
        else {
            const int l = (ph - 2) / PH_PER_L, p = (ph - 2) % PH_PER_L; const bool last = (l == DEPTH - 1);
            KA_DECL;
            const char* wt_in = (const char*)(WSP(bf16, WT_IN) + (size_t)l * NWIN * D);
            if (p == 0) { if (PON(0)) pa_hrows(F, l); }
            else if (p == 1) { if (PON(1)) {
                SchedGrid S{(const char*)WSP(bf16, WS_H), wt_in, 2048u, 2048u, 16, R / 256, NP / 256, F.G, F.bid, false};
                EpiStore E{WSP(bf16, BG_PROJ), NP};
                ge::gemm_engine<EpiStore, SchedGrid, false>(F.lds, S, E, F.tid);
            } }
            else if (p == 2) { if (PON(2)) {
                const int ntask = NSPAN + 512 + (last ? 0 : 16);
                for (int t = F.bid; t < ntask; t += F.G) {
                    if (t < NSPAN) span_task<0, false>(F, l, t); else if (t < NSPAN + 512) fft_stage_a(F, t - NSPAN); else fft_ctx(F, t - NSPAN - 512); }
                conv_a_pass(F, l);
            } }
            else if (p == 3 || p == 6) { if (PON(3)) state_scan(F); }
            else if (p == 4) { if (PON(4)) {
                for (int t = F.bid; t < NSPAN; t += F.G) { if (last && (t % SPB) < 4) continue; span_task<0, true>(F, l, t); }
                conv_xbc_pass(F, l);
            } }
            else if (p == 5) { if (PON(5)) { for (int t = F.bid; t < NSPAN; t += F.G) span_task<1, false>(F, l, t); } }
            else if (p == 7) { if (PON(7)) {
                const int ntask = NSPAN + 256;
                for (int t = F.bid; t < ntask; t += F.G) {
                    if (t < NSPAN) { if (last && (t % SPB) < 4) continue; span_task<1, true>(F, l, t); } else fft_stage_b(F, t - NSPAN); }
                if (!last) ctx_y_copy(F);
            } }
            else if (p == 8) { if (PON(8)) {
                SchedD1 S{(const char*)WSP(bf16, WS_H), (const char*)WSP(bf16, BG_PROJ), wt_in + (size_t)NP * 2048, (const char*)(WSP(bf16, WT_BR) + (size_t)l * 4 * D * 256), last ? 128 : 132, F.G, F.bid, last};
                EpiD1 E{WSP(bf16, BG_MERGED), KA->ws + BG_GSCR + (size_t)F.bid * 131072};
                ge::gemm_engine<EpiD1, SchedD1, false>(F.lds, S, E, F.tid);
            } }
            else if (p == 9) { if (PON(9)) {
                SchedGrid S{(const char*)WSP(bf16, BG_MERGED), (const char*)(WSP(bf16, WT_OUT) + (size_t)l * D * D), 2048u, 2048u, 16, last ? 128 : 132, 4, F.G, F.bid, last};
                EpiResid E{KA->in[I_X], KA->in[I_CTX], WSP(float, WS_X), WSP(const float, SM_MOD) + (size_t)l * 5 * 6144, l};
                ge::gemm_engine<EpiResid, SchedGrid, false>(F.lds, S, E, F.tid);
            } }
            else if (p == 10) { if (PON(10)) { pe1_router(F, l); moe_convert(F, l); } }
            else if (p == 11) { if (PON(11)) {
                moe_prefix(F, l);
                SchedMoE S{(const LAS int*)(F.lds + RING_BYTES), (const LAS int*)(F.lds + RING_BYTES + 160), 1, (const char*)WSP(bf16, WS_H), (const char*)WSP(bf16, BG_W13), WSP(const int, SM_LIST), F.G, vc};
                EpiAct E{WSP(bf16, BG_ACT)};
                ge::gemm_engine<EpiAct, SchedMoE, true>(F.lds, S, E, F.tid);
            } }
            else if (p == 12) { if (PON(12)) {
                moe_prefix(F, l);
                SchedMoE S{(const LAS int*)(F.lds + RING_BYTES), (const LAS int*)(F.lds + RING_BYTES + 160), 2, (const char*)WSP(bf16, BG_ACT), (const char*)WSP(bf16, BG_W2), nullptr, F.G, vc};
                EpiStore E{WSP(bf16, BG_YO), D};
                ge::gemm_engine<EpiStore, SchedMoE, false>(F.lds, S, E, F.tid);
            } }
            else { if (PON(13)) { moe_prefix(F, l); pe4_combine(F, l); } }
        }
        if (ph + 1 < a.ph_hi) {
            if (COOP) { if (ph == 0) cg::this_grid().sync(); else { KA_DECL; bar.bar = WSP(unsigned, WS_CTL) + CW_BAR; xcd_barrier(bar); } }
        }
    }
}

#ifndef DBG_STOP
#define DBG_STOP 0
#endif
#ifndef DBG_K
#define DBG_K 30.f
#endif
__global__ void __launch_bounds__(256) dbg_gemm(const bf16* A, int lda, const bf16* Bt, int ldb, int K, const bf16* C, int ldc, int c0, float* out) {
    const int q = blockIdx.x, r = (q >> 13) * RPB + CTXL + (q & 8191);
    __shared__ float arow[1024];
    for (int k = threadIdx.x; k < K; k += 256) arow[k] = bf2f(A[(size_t)r * lda + k]);
    __syncthreads();
    for (int c = threadIdx.x; c < 1024; c += 256) { const bf16* b = Bt + (size_t)(c0 + c) * ldb; float s = 0.f;
        for (int k = 0; k < K; k += 8) { const u32x4 w = *(const u32x4*)(b + k);
            s += arow[k] * bflo(w.x) + arow[k + 1] * bfhi(w.x) + arow[k + 2] * bflo(w.y) + arow[k + 3] * bfhi(w.y) + arow[k + 4] * bflo(w.z) + arow[k + 5] * bfhi(w.z) + arow[k + 6] * bflo(w.w) + arow[k + 7] * bfhi(w.w); }
        out[(size_t)q * D + c] = DBG_K * (bf2f(C[(size_t)r * ldc + c0 + c]) - s); }
}
__global__ void __launch_bounds__(256) dbg_merged(const bf16* H, const bf16* P, const bf16* Wg, const bf16* Wb, const bf16* M, float* out) {
    const int q = blockIdx.x, r = (q >> 13) * RPB + CTXL + (q & 8191);
    __shared__ float hrow[1024]; __shared__ float yrow[1024];
    for (int k = threadIdx.x; k < 1024; k += 256) { hrow[k] = bf2f(H[(size_t)r * D + k]); const int br = k >> 8, kk = k & 255; const int colk = br == 0 ? C_AB : (br == 1 ? C_Q : (br == 2 ? C_UR : C_Z)); yrow[k] = bf2f(P[(size_t)r * NP + colk + kk]); }
    __syncthreads();
    for (int c = threadIdx.x; c < 1024; c += 256) { float tot = 0.f;
        for (int br = 0; br < 4; ++br) { if (!((BRMASK >> br) & 1)) continue; const bf16* wg = Wg + (size_t)(br * 1024 + c) * D; float g = 0.f; for (int k = 0; k < 1024; ++k) g += hrow[k] * bf2f(wg[k]);
            const bf16* wb = Wb + ((size_t)br * 1024 + c) * 256; float p = 0.f; for (int k = 0; k < 256; ++k) p += yrow[br * 256 + k] * bf2f(wb[k]);
            tot += DBG_D1 == 1 ? 1.f / (1.f + expf(-g)) : (DBG_D1 == 2 ? p : p / (1.f + expf(-g))); }
        out[(size_t)q * D + c] = DBG_K * (bf2f(M[(size_t)r * D + c]) - tot); }
}
__global__ void __launch_bounds__(256) dbg_d2(const bf16* M, const bf16* Wo, const float* X, const float* xin, const float* mod, float* out) {
    const int q = blockIdx.x, b = q >> 13, r = b * RPB + CTXL + (q & 8191);
    __shared__ float mrow[1024];
    for (int k = threadIdx.x; k < 1024; k += 256) mrow[k] = bf2f(M[(size_t)r * D + k]);
    __syncthreads();
    for (int c = threadIdx.x; c < 1024; c += 256) { const bf16* w = Wo + (size_t)c * D; float s = 0.f; for (int k = 0; k < 1024; ++k) s += mrow[k] * bf2f(w[k]);
        out[(size_t)q * D + c] = DBG_K * (X[(size_t)r * D + c] - (xin[(size_t)q * D + c] + mod[(size_t)b * 6144 + 2048 + c] * s)); }
}
__global__ void __launch_bounds__(256) dbg_moe(const bf16* F, const unsigned* TOK, const unsigned* CNT, const bf16* YO, const float* W1, const float* W3, const float* W2, float* out) {
    const int q = blockIdx.x, r = (q >> 13) * RPB + CTXL + (q & 8191), tid = threadIdx.x;
    __shared__ float frow[1024]; __shared__ float act[512]; __shared__ int ts[33];
    if (tid == 0) { int a = 0; for (int e = 0; e < 32; ++e) { ts[e] = a; a += ((int)CNT[e] + 255) >> 8; } ts[32] = a; }
    for (int k = tid; k < 1024; k += 256) frow[k] = bf2f(F[(size_t)r * D + k]);
    __syncthreads();
    const unsigned* tk = TOK + (size_t)r * 8; const int ex[2] = {(int)tk[0], (int)tk[1]}; const unsigned rk[2] = {tk[2], tk[3]}; const float ww[2] = {__builtin_bit_cast(float, tk[4]), __builtin_bit_cast(float, tk[5])};
    float y[4] = {0, 0, 0, 0}, mine[4] = {0, 0, 0, 0};
    for (int s = 0; s < 2; ++s) { const int e = ex[s];
        const float* w1 = W1 + (size_t)e * D * DFF; const float* w3 = W3 + (size_t)e * D * DFF; const float* w2 = W2 + (size_t)e * DFF * D;
        for (int j = tid; j < 512; j += 256) { float a = 0.f, b = 0.f; for (int k = 0; k < 1024; ++k) { a += frow[k] * w1[(size_t)k * DFF + j]; b += frow[k] * w3[(size_t)k * DFF + j]; } act[j] = a / (1.f + expf(-a)) * b; }
        __syncthreads();
        const size_t slot = (size_t)ts[e] * 256 + rk[s];
        for (int i = 0; i < 4; ++i) { const int c = tid + 256 * i; float o = 0.f; for (int j = 0; j < 512; ++j) o += act[j] * w2[(size_t)j * D + c]; y[i] += ww[s] * o; mine[i] += ww[s] * bf2f(YO[slot * D + c]); }
        __syncthreads(); }
    for (int i = 0; i < 4; ++i) out[(size_t)q * D + tid + 256 * i] = DBG_K * (mine[i] - y[i]);
}
__global__ void __launch_bounds__(256) dbg_router(const float* X, const float* mod, const float* nw, const float* rgw, const float* rgb, const float* rew, const float* reb, const unsigned* TOK, float* out) {
    const int q = blockIdx.x, b = q >> 13, r = b * RPB + CTXL + (q & 8191), tid = threadIdx.x;
    __shared__ float f[1024]; __shared__ float red[256]; __shared__ float lg[36];
    float ss = 0.f; for (int k = tid; k < 1024; k += 256) { const float v = X[(size_t)r * D + k]; ss += v * v; }
    red[tid] = ss; __syncthreads(); for (int s = 128; s > 0; s >>= 1) { if (tid < s) red[tid] += red[tid + s]; __syncthreads(); }
    const float rstd = 1.0f / sqrtf(red[0] / 1024.f + EPS);
    for (int k = tid; k < 1024; k += 256) f[k] = X[(size_t)r * D + k] * rstd * nw[k] * (1.f + mod[(size_t)b * 6144 + 4096 + k]) + mod[(size_t)b * 6144 + 3072 + k];
    __syncthreads();
    if (tid < 36) { float s = 0.f; if (tid < 4) { for (int k = 0; k < 1024; ++k) s += f[k] * rgw[k * 4 + tid]; s += rgb[tid]; } else { for (int k = 0; k < 1024; ++k) s += f[k] * rew[k * 32 + tid - 4]; s += reb[tid - 4]; } lg[tid] = s; }
    __syncthreads();
    for (int c = tid; c < 1024; c += 256) out[(size_t)q * D + c] = 0.f;
    __syncthreads();
    if (tid == 0) { int gt = 0; for (int j = 1; j < 4; ++j) if (lg[j] > lg[gt]) gt = j; float gs = 0.f; for (int j = 0; j < 4; ++j) gs += expf(lg[j] - lg[gt]); const float pg = 1.f / gs;
        const float* el = lg + 4 + gt * 8; int i1 = 0; for (int i = 1; i < 8; ++i) if (el[i] > el[i1]) i1 = i; int i2 = -1; for (int i = 0; i < 8; ++i) if (i != i1 && (i2 < 0 || el[i] > el[i2])) i2 = i;
        const float e2 = expf(el[i2] - el[i1]), w1 = pg / (1.f + e2), w2 = pg * e2 / (1.f + e2);
        const unsigned* tk = TOK + (size_t)r * 8;
        out[(size_t)q * D + 0] = 1000.f * ((float)tk[0] - (float)(gt * 8 + i1)); out[(size_t)q * D + 1] = 1000.f * ((float)tk[1] - (float)(gt * 8 + i2));
        out[(size_t)q * D + 2] = 1000.f * (__builtin_bit_cast(float, tk[4]) - w1); out[(size_t)q * D + 3] = 1000.f * (__builtin_bit_cast(float, tk[5]) - w2); }
}
__device__ __forceinline__ float dbg_conv_silu(const bf16* P, int r, int c, const float* cw, const float* cb) {
    bool vp, vn; nbr_valid(r, vp, vn); const bf16* row = P + (size_t)r * NP + C_XBC + c;
    const float a = vp ? bf2f(row[-NP]) : 0.f, b = bf2f(row[0]), n = vn ? bf2f(row[NP]) : 0.f; const float v = cb[c] + cw[c] * a + cw[512 + c] * b + cw[1024 + c] * n; return v / (1.f + expf(-v)); }
__global__ void __launch_bounds__(64) dbg_naive_scan(const bf16* P, const float* DT, float* XO, const float* scw, const float* scb, const float* alog, const float* dtb, const float* sd, const float* hlb, int mix) {
    const int b = blockIdx.x >> 3, h = (blockIdx.x >> 1) & 3, dir = blockIdx.x & 1, lane = threadIdx.x, g = h >> 1;
    __shared__ float Ssh[64][64];
#define S_(k) Ssh[k][lane]
    for (int k = 0; k < 64; ++k) S_(k) = 0.f;
    const float A = expf(alog[dir * 4 + h]), bias = dtb[dir * 4 + h], Dh = sd[h];
    __shared__ float lbs[64]; lbs[lane] = DBG_L ? 1.f / (1.f + expf(hlb[(dir * DEPTH + 0) * 256 + h * 64 + lane] - hlb[(dir * DEPTH + DBG_L) * 256 + h * 64 + lane])) : 0.f; __syncthreads();
    for (int p = 0; p < RPB; ++p) {
        int s; if (!dir) s = p; else s = p < CTXL ? CTXL - 1 - p : RPB - 1 - (p - CTXL);
        const int r = b * RPB + s; const bf16* row = P + (size_t)r * NP; float o = 0.f;
        if (mix == 0) { const float vv = bf2f(row[C_I + h * 64 + lane]);
            for (int k = 0; k < 64; ++k) { const float fr = bf2f(row[C_FF + dir * 256 + h * 64 + k]), qr = bf2f(row[C_Q + h * 64 + k]); const float f = lbs[k] + (1.f - lbs[k]) / (1.f + expf(-fr)), q = qr / (1.f + expf(-qr));
                S_(k) = f * S_(k) + (1.f - f) * vv; o += q * S_(k); }
            if (s >= CTXL) XO[((size_t)b * SEQ + (s - CTXL)) * D + (dir ? 0 : 256) + h * 64 + lane] = o;
        } else { const float xv = dbg_conv_silu(P, r, h * 64 + lane, scw, scb); const float dtr = DT[(size_t)r * 8 + dir * 4 + h] + bias; const float dt = dtr > 20.f ? dtr : log1pf(expf(dtr)); const float a = expf(-dt * A);
            for (int k = 0; k < 64; ++k) { const float Bv = dbg_conv_silu(P, r, 256 + g * 64 + k, scw, scb), Cv = dbg_conv_silu(P, r, 384 + g * 64 + k, scw, scb);
                S_(k) = a * S_(k) + Bv * dt * xv; o += Cv * S_(k); }
            if (s >= CTXL) XO[((size_t)b * SEQ + (s - CTXL)) * D + (dir ? 512 : 768) + h * 64 + lane] = dir ? o : o + Dh * xv;
        }
    }
}
__global__ void __launch_bounds__(256) dbg_scan_cmp(const bf16* P, const float* XO, const bf16* GZ, const float* hnw, const float* snw, float* out) {
    const int q = blockIdx.x, r = (q >> 13) * RPB + CTXL + (q & 8191), c = threadIdx.x; __shared__ float red[256];
    {   const float o = XO[(size_t)q * D + 256 + c] + XO[(size_t)q * D + c]; red[c] = o * o; __syncthreads();
        for (int s = 32; s > 0; s >>= 1) { if ((c & 63) < s) red[c] += red[c + s]; __syncthreads(); }
        const float rs = 1.f / sqrtf(red[c & ~63] / 64.f + EPS); const float gr = bf2f(P[(size_t)r * NP + C_G + c]); const float y = o * rs * hnw[c & 63] * gr / (1.f + expf(-gr));
        out[(size_t)q * D + 256 + c] = DBG_K * (bf2f(P[(size_t)r * NP + C_Q + c]) - y); __syncthreads(); }
    {   const float zr = bf2f(GZ[(size_t)r * 256 + c]); const float v = (XO[(size_t)q * D + 768 + c] + XO[(size_t)q * D + 512 + c]) * zr / (1.f + expf(-zr)); red[c] = v * v; __syncthreads();
        for (int s = 64; s > 0; s >>= 1) { if ((c & 127) < s) red[c] += red[c + s]; __syncthreads(); }
        const float rs = 1.f / sqrtf(red[c & ~127] / 128.f + EPS); const float y = v * rs * snw[c];
        out[(size_t)q * D + 768 + c] = DBG_K * (bf2f(P[(size_t)r * NP + C_Z + c]) - y); }
    out[(size_t)q * D + c] = 0.f; out[(size_t)q * D + 512 + c] = 0.f;
}
__global__ void dbg_save_gz(const bf16* P, bf16* GZ) {
    const int r = blockIdx.x, c = threadIdx.x; GZ[(size_t)r * 256 + c] = P[(size_t)r * NP + C_Z + c];
}
__global__ void __launch_bounds__(256) dbg_four(const bf16* H, const float* win, const bf16* P, float* out) {
    const int q = blockIdx.x, r = (q >> 13) * RPB + CTXL + (q & 8191), c = threadIdx.x; __shared__ float hrow[1024]; __shared__ float four[256];
    for (int k = c; k < 1024; k += 256) hrow[k] = bf2f(H[(size_t)r * D + k]);
    __syncthreads();
    { float s = 0.f; for (int k = 0; k < 1024; ++k) s += hrow[k] * win[(size_t)k * NIN + 2048 + c]; four[c] = s; }
    __syncthreads();
    const int g = c >> 6, cp = c & 63; float ur = 0.f, ui = 0.f;
    for (int i = 0; i < 64; ++i) { float sn, cs; sincospif(2.0f * (float)((i * cp) & 63) / 64.0f, &sn, &cs); ur += four[g * 64 + i] * cs; ui -= four[g * 64 + i] * sn; }
    out[(size_t)q * D + c] = DBG_K * (bf2f(P[(size_t)r * NP + C_UR + c]) - ur); out[(size_t)q * D + 256 + c] = DBG_K * (bf2f(P[(size_t)r * NP + C_UI + c]) - ui);
    out[(size_t)q * D + 512 + c] = 0.f; out[(size_t)q * D + 768 + c] = 0.f;
}
__global__ void dbg_save_u(const bf16* P, bf16* U) { const int r = blockIdx.x, c = threadIdx.x; U[(size_t)r * 512 + c] = P[(size_t)r * NP + C_UR + c]; U[(size_t)r * 512 + 256 + c] = P[(size_t)r * NP + C_UI + c]; }
__global__ void __launch_bounds__(256) dbg_dft(const bf16* U, const bf16* P, float* out) {
    const int q = blockIdx.x, b = q >> 13, tp = q & 8191, ch = threadIdx.x; __shared__ float ct[8192]; __shared__ float st[8192];
    for (int i = ch; i < 8192; i += 256) { float sn, cs; sincospif(2.0f * (float)i / 8192.0f, &sn, &cs); ct[i] = cs; st[i] = sn; }
    __syncthreads();
    float acc = 0.f; const bf16* u = U + ((size_t)b * RPB + CTXL) * 512 + ch;
    for (int t = 0; t < 8192; ++t) { const int idx = (t * tp) & 8191; acc += bf2f(u[(size_t)t * 512]) * ct[idx] + bf2f(u[(size_t)t * 512 + 256]) * st[idx]; }
    const int r = b * RPB + CTXL + tp;
    out[(size_t)q * D + 512 + ch] = DBG_K * (bf2f(P[(size_t)r * NP + C_UR + ch]) - acc * 0.001381067932f);
    out[(size_t)q * D + ch] = 0.f; out[(size_t)q * D + 256 + ch] = 0.f; out[(size_t)q * D + 768 + ch] = 0.f;
}
__global__ void dbg_mod(const float* c, const float* cctx, const float* adaw, const float* adab, float* MN) {
    const int j = blockIdx.x * 256 + threadIdx.x, cr = blockIdx.y; if (j >= 6144) return; const float* cv = cr < 4 ? c + cr * D : cctx; float s = adab[j];
    for (int k = 0; k < 1024; ++k) { const float x = cv[k]; s += x / (1.f + expf(-x)) * adaw[(size_t)k * 6144 + j]; } MN[cr * 6144 + j] = s; }
__global__ void __launch_bounds__(256) dbg_h(const float* xin, const float* MN, const float* nw, const float* win, const bf16* H, const float* DT, float* out) {
    const int q = blockIdx.x, b = q >> 13, r = b * RPB + CTXL + (q & 8191), tid = threadIdx.x; __shared__ float red[256]; __shared__ float hrow[1024];
    float ss = 0.f; for (int k = tid; k < 1024; k += 256) { const float v = xin[(size_t)q * D + k]; ss += v * v; } red[tid] = ss; __syncthreads();
    for (int s = 128; s > 0; s >>= 1) { if (tid < s) red[tid] += red[tid + s]; __syncthreads(); }
    const float rstd = 1.f / sqrtf(red[0] / 1024.f + EPS);
    for (int k = tid; k < 1024; k += 256) { const float h = xin[(size_t)q * D + k] * rstd * nw[k] * (1.f + MN[b * 6144 + 1024 + k]) + MN[b * 6144 + k]; hrow[k] = h; out[(size_t)q * D + k] = DBG_K * (bf2f(H[(size_t)r * D + k]) - h); }
    __syncthreads();
    if (tid < 8) { float s = 0.f; for (int k = 0; k < 1024; ++k) s += hrow[k] * win[(size_t)k * NIN + 3072 + tid]; out[(size_t)q * D + tid] = 100.f * DBG_K * (DT[(size_t)r * 8 + tid] - s); }
}
__global__ void __launch_bounds__(256) dbg_wt(const float* win, const float* wbr, const float* wout, const bf16* WTI, const bf16* WTB, const bf16* WTO, float* out) {
    const int q = blockIdx.x, tid = threadIdx.x;
    for (int k = tid; k < 1024; k += 256) { float d = 0.f;
        if (q < 7424) { int src = -1; if (q < 2048) src = q; else if (q >= 2560 && q < 2816) src = 2304 + (q - 2560); else if (q >= 2816 && q < 3328) src = 2560 + (q - 2816); else if (q >= 3328) src = 3080 + (q - 3328);
            if (src >= 0) d = bf2f(WTI[(size_t)q * D + k]) - win[(size_t)k * NIN + src]; }
        else if (q >= 8192 && q < 12288) { const int n = q - 8192, br = n >> 10, nn = n & 1023; if (k < 256) d = bf2f(WTB[((size_t)br * 1024 + nn) * 256 + k]) - wbr[((size_t)br * 256 + k) * D + nn]; }
        else if (q >= 12288 && q < 13312) { const int n = q - 12288; d = bf2f(WTO[(size_t)n * D + k]) - wout[(size_t)k * D + n]; }
        out[(size_t)q * D + k] = 1000.f * d; }
}
__global__ void dbg_save_a(const bf16* P, bf16* S) { const int r = blockIdx.x, c = threadIdx.x; for (int j = 0; j < 3; ++j) S[(size_t)r * 768 + j * 256 + c] = P[(size_t)r * NP + j * 256 + c]; }
__global__ void __launch_bounds__(256) dbg_conva(const bf16* S, const bf16* P, const float* cw, const float* cb, float* out) {
    const int q = blockIdx.x, r = (q >> 13) * RPB + CTXL + (q & 8191), t = q & 8191, c = threadIdx.x;
    const bf16* s0 = S + (size_t)r * 768; const float u0 = bf2f(s0[256 + c]) * bf2f(s0[512 + c]);
    const float up = t > 0 ? bf2f(s0[-768 + 256 + c]) * bf2f(s0[-768 + 512 + c]) : 0.f, un = t < 8191 ? bf2f(s0[768 + 256 + c]) * bf2f(s0[768 + 512 + c]) : 0.f;
    const float y = bf2f(s0[c]) * (cb[c] + cw[c] * up + cw[256 + c] * u0 + cw[512 + c] * un);
    out[(size_t)q * D + c] = DBG_K * (bf2f(P[(size_t)r * NP + C_AB + c]) - y); out[(size_t)q * D + 256 + c] = 0.f; out[(size_t)q * D + 512 + c] = 0.f; out[(size_t)q * D + 768 + c] = 0.f;
}
__global__ void __launch_bounds__(256) dbg_final(const float* X, const float* mod, const unsigned* TOK, const unsigned* CNT, const bf16* YO, const float* fnw, float* out) {
    const int q = blockIdx.x, b = q >> 13, r = b * RPB + CTXL + (q & 8191), tid = threadIdx.x; __shared__ int ts[33]; __shared__ float red[256];
    if (tid == 0) { int a = 0; for (int e = 0; e < 32; ++e) { ts[e] = a; a += ((int)CNT[e - (DBG_VAR == 3 ? 32 : 0)] + 255) >> 8; } ts[32] = a; }
    __syncthreads();
    const unsigned* tk = TOK + (size_t)r * 8; const size_t s1 = (size_t)ts[tk[0]] * 256 + tk[2], s2 = (size_t)ts[tk[1]] * 256 + tk[3]; float w1 = __builtin_bit_cast(float, tk[4]), w2 = __builtin_bit_cast(float, tk[5]); if (DBG_VAR == 1) { const float t_ = w1; w1 = w2; w2 = t_; } if (DBG_VAR == 2) mod -= 5 * 6144;
    float xn[4]; float ss = 0.f;
    for (int i = 0; i < 4; ++i) { const int c = tid + 256 * i; xn[i] = X[(size_t)r * D + c] + DBG_E4S * mod[(size_t)b * 6144 + 5120 + c] * (w1 * bf2f(YO[s1 * D + c]) + w2 * bf2f(YO[s2 * D + c])); ss += xn[i] * xn[i]; }
    red[tid] = ss; __syncthreads(); for (int s = 128; s > 0; s >>= 1) { if (tid < s) red[tid] += red[tid + s]; __syncthreads(); }
    const float rstd = 1.f / sqrtf(red[0] / 1024.f + EPS);
    for (int i = 0; i < 4; ++i) { const int c = tid + 256 * i; out[(size_t)q * D + c] = DBG_K * (out[(size_t)q * D + c] - xn[i] * rstd * fnw[c]) + 1e-3f; }
}
#ifndef DBG_MODE
#define DBG_MODE -12
#define DBG_C0 2304
#endif
__global__ void __launch_bounds__(512) dbg_dump(Args a) {
    const int gw = blockIdx.x * 8 + (threadIdx.x >> 6), lane = threadIdx.x & 63;
    for (int q = gw; q < NB * SEQ; q += gridDim.x * 8) { const int r = (q >> 13) * RPB + CTXL + (q & 8191);
        float* orow = a.out + (size_t)q * D;
        if (DBG_MODE == 1) {
            const f32x4* xr = (DBG_STOP <= 2 ? (const f32x4*)(a.in[I_X] + (size_t)q * D) : (const f32x4*)((const float*)(a.ws + WS_X) + (size_t)r * D)) + lane; f32x4 v[4]; float ss = 0.f;
            for (int j = 0; j < 4; ++j) { v[j] = xr[64 * j]; ss += v[j].x * v[j].x + v[j].y * v[j].y + v[j].z * v[j].z + v[j].w * v[j].w; }
            const float rstd = 1.0f / sqrtf(wave_sum(ss) * (1.f / D) + EPS);
            for (int j = 0; j < 4; ++j) ((f32x4*)orow)[lane + 64 * j] = v[j] * rstd * ((const f32x4*)a.in[I_FNW])[lane + 64 * j];
        } else if (DBG_MODE == 2) {
            const bf16* m = (const bf16*)(a.ws + BG_MERGED) + (size_t)r * D; for (int j = 0; j < 16; ++j) orow[lane + 64 * j] = bf2f(m[lane + 64 * j]);
        } else if (DBG_MODE == 3) {
            const bf16* p = (const bf16*)(a.ws + BG_PROJ) + (size_t)r * NP;
            for (int j = 0; j < 4; ++j) { orow[lane + 64 * j] = bf2f(p[C_AB + lane + 64 * j]); orow[256 + lane + 64 * j] = bf2f(p[C_Q + lane + 64 * j]); orow[512 + lane + 64 * j] = bf2f(p[C_UR + lane + 64 * j]); orow[768 + lane + 64 * j] = bf2f(p[C_Z + lane + 64 * j]); }
        } else if (DBG_MODE == 4) {
            const bf16* m = (const bf16*)(a.ws + WS_H) + (size_t)r * D; for (int j = 0; j < 16; ++j) orow[lane + 64 * j] = bf2f(m[lane + 64 * j]);
        } else {
            const bf16* p = (const bf16*)(a.ws + BG_PROJ) + (size_t)r * NP + DBG_MODE; for (int j = 0; j < 16; ++j) orow[lane + 64 * j] = bf2f(p[lane + 64 * j]);
        }
    }
}
template <int PHSEL> static void launch_phase(const Args& a, int grid, hipStream_t stream) {
    static bool attr = false;
    if (!attr) { (void)hipFuncSetAttribute((const void*)mk<false, PHSEL>, hipFuncAttributeMaxDynamicSharedMemorySize, LDS_BYTES); attr = true; }
    hipLaunchKernelGGL((mk<false, PHSEL>), dim3(grid), dim3(512), LDS_BYTES, stream, a);
}
extern "C" void kernel_launch(void* const* d_in, const int* in_sizes, int n_in, void* d_out, int out_size, void* d_ws, size_t ws_size, hipStream_t stream) {
    static int grid = 0;
    if (grid == 0) {
        if (n_in != 29 || ws_size < WS_END || out_size != NB * SEQ * D) { fprintf(stderr, "kernel_launch: unexpected shapes (n_in %d, ws %zu, out %d)\n", n_in, ws_size, out_size); grid = -1; }
        else {
            int dev = 0, cus = 0; (void)hipGetDevice(&dev); (void)hipDeviceGetAttribute(&cus, hipDeviceAttributeMultiprocessorCount, dev);
            grid = cus;
            if (grid != 256) { fprintf(stderr, "kernel_launch: %d CUs: expected 256\n", cus); if (grid <= 0 || grid % 8) grid = -1; }
        }
    }
    if (grid < 0) { (void)hipMemsetAsync(d_out, 0, (size_t)out_size * 4, stream); return; }
    (void)hipMemsetAsync((char*)d_ws + WS_CTL, 0, 1 * MiB, stream);
    Args a{};
    for (int i = 0; i < 29; ++i) a.in[i] = (const float*)d_in[i];
    a.out = (float*)d_out; a.ws = (unsigned char*)d_ws; a.coop = 0; a.pad = 0;
    for (int ph = 0; ph < (DBG_STOP ? DBG_STOP : N_PHASES); ++ph) {
        a.ph_lo = ph; a.ph_hi = ph + 1;
        if (DBG_STOP && DBG_MODE == -8 && ph == 4) hipLaunchKernelGGL(dbg_save_u, dim3(R), dim3(256), 0, stream, (const bf16*)((char*)d_ws + BG_PROJ), (bf16*)((char*)d_ws + WS_X));
        if (DBG_STOP && DBG_MODE == -11 && ph == 4) hipLaunchKernelGGL(dbg_save_a, dim3(R), dim3(256), 0, stream, (const bf16*)((char*)d_ws + BG_PROJ), (bf16*)((char*)d_ws + WS_X));
        if (DBG_STOP && DBG_MODE == -6 && ph == 4 + DBG_L * PH_PER_L) {
            hipLaunchKernelGGL(dbg_save_gz, dim3(R), dim3(256), 0, stream, (const bf16*)((char*)d_ws + BG_PROJ), (bf16*)((char*)d_ws + BG_MIX_END));
            for (int mix = 0; mix < 2; ++mix) hipLaunchKernelGGL(dbg_naive_scan, dim3(32), dim3(64), 0, stream, (const bf16*)((char*)d_ws + BG_PROJ), (const float*)((char*)d_ws + SM_DT), (float*)d_out, (const float*)d_in[13] + DBG_L * 3 * 512, (const float*)d_in[14] + DBG_L * 512, (const float*)d_in[15] + DBG_L * 8, (const float*)d_in[16] + DBG_L * 8, (const float*)d_in[17] + DBG_L * 4, (const float*)d_in[11], mix);
        }
        if (ph == 0) launch_phase<100>(a, grid, stream);
        else if (ph == 1) launch_phase<101>(a, grid, stream);
        else switch ((ph - 2) % PH_PER_L) {
            case 0: launch_phase<0>(a, grid, stream); break;
            case 1: launch_phase<1>(a, grid, stream); break;
            case 2: launch_phase<2>(a, grid, stream); break;
            case 3: case 6: launch_phase<3>(a, grid, stream); break;
            case 4: launch_phase<4>(a, grid, stream); break;
            case 5: launch_phase<5>(a, grid, stream); break;
            case 7: launch_phase<7>(a, grid, stream); break;
            case 8: launch_phase<8>(a, grid, stream); break;
            case 9: launch_phase<9>(a, grid, stream); break;
            case 10: launch_phase<10>(a, grid, stream); break;
            case 11: launch_phase<11>(a, grid, stream); break;
            case 12: launch_phase<12>(a, grid, stream); break;
            default: launch_phase<13>(a, grid, stream); break;
        }
    }
    if (DBG_STOP && DBG_MODE == -1) hipLaunchKernelGGL(dbg_gemm, dim3(NB * SEQ), dim3(256), 0, stream, (const bf16*)((char*)d_ws + WS_H), D, (const bf16*)((char*)d_ws + WT_IN), D, D, (const bf16*)((char*)d_ws + BG_PROJ), NP, DBG_C0, (float*)d_out);
    else if (DBG_STOP && DBG_MODE == -2) hipLaunchKernelGGL(dbg_merged, dim3(NB * SEQ), dim3(256), 0, stream, (const bf16*)((char*)d_ws + WS_H), (const bf16*)((char*)d_ws + BG_PROJ), (const bf16*)((char*)d_ws + WT_IN) + (size_t)DBG_L * NWIN * D + (size_t)NP * D, (const bf16*)((char*)d_ws + WT_BR) + (size_t)DBG_L * 4 * D * 256, (const bf16*)((char*)d_ws + BG_MERGED), (float*)d_out);
    else if (DBG_STOP && DBG_MODE == -4) hipLaunchKernelGGL(dbg_moe, dim3(NB * SEQ), dim3(256), 0, stream, (const bf16*)((char*)d_ws + WS_H), (const unsigned*)((char*)d_ws + SM_TOK), (const unsigned*)((char*)d_ws + WS_CTL) + CW_CNT + DBG_L * 32, (const bf16*)((char*)d_ws + BG_YO), (const float*)d_in[25] + (size_t)DBG_L * NE * D * DFF, (const float*)d_in[26] + (size_t)DBG_L * NE * D * DFF, (const float*)d_in[27] + (size_t)DBG_L * NE * D * DFF, (float*)d_out);
    else if (DBG_STOP && DBG_MODE == -5) hipLaunchKernelGGL(dbg_router, dim3(NB * SEQ), dim3(256), 0, stream, (const float*)((char*)d_ws + WS_X), (const float*)((char*)d_ws + SM_MOD) + DBG_L * 5 * 6144, (const float*)d_in[7] + DBG_L * D, (const float*)d_in[21] + DBG_L * D * 4, (const float*)d_in[22] + DBG_L * 4, (const float*)d_in[23] + DBG_L * D * 32, (const float*)d_in[24] + DBG_L * 32, (const unsigned*)((char*)d_ws + SM_TOK), (float*)d_out);
    else if (DBG_STOP && DBG_MODE == -6) hipLaunchKernelGGL(dbg_scan_cmp, dim3(NB * SEQ), dim3(256), 0, stream, (const bf16*)((char*)d_ws + BG_PROJ), (const float*)d_out, (const bf16*)((char*)d_ws + BG_MIX_END), (const float*)d_in[12] + DBG_L * 64, (const float*)d_in[18] + DBG_L * 256, (float*)d_out);
    else if (DBG_STOP && DBG_MODE == -7) hipLaunchKernelGGL(dbg_four, dim3(NB * SEQ), dim3(256), 0, stream, (const bf16*)((char*)d_ws + WS_H), (const float*)d_in[8], (const bf16*)((char*)d_ws + BG_PROJ), (float*)d_out);
    else if (DBG_STOP && DBG_MODE == -8) hipLaunchKernelGGL(dbg_dft, dim3(NB * SEQ), dim3(256), 0, stream, (const bf16*)((char*)d_ws + WS_X), (const bf16*)((char*)d_ws + BG_PROJ), (float*)d_out);
    else if (DBG_STOP && DBG_MODE == -9) { float* MN = (float*)((char*)d_ws + BG_MIX_END);
        hipLaunchKernelGGL(dbg_mod, dim3(24, 5), dim3(256), 0, stream, (const float*)d_in[1], (const float*)d_in[3], (const float*)d_in[4], (const float*)d_in[5], MN);
        hipLaunchKernelGGL(dbg_h, dim3(NB * SEQ), dim3(256), 0, stream, (const float*)d_in[0], MN, (const float*)d_in[6], (const float*)d_in[8], (const bf16*)((char*)d_ws + WS_H), (const float*)((char*)d_ws + SM_DT), (float*)d_out); }
    else if (DBG_STOP && DBG_MODE == -10) hipLaunchKernelGGL(dbg_wt, dim3(NB * SEQ), dim3(256), 0, stream, (const float*)d_in[8] + (size_t)DBG_L * D * NIN, (const float*)d_in[19] + (size_t)DBG_L * 4 * 256 * D, (const float*)d_in[20] + (size_t)DBG_L * D * D,
        (const bf16*)((char*)d_ws + WT_IN) + (size_t)DBG_L * NWIN * D, (const bf16*)((char*)d_ws + WT_BR) + (size_t)DBG_L * 4 * D * 256, (const bf16*)((char*)d_ws + WT_OUT) + (size_t)DBG_L * D * D, (float*)d_out);
    else if (DBG_STOP && DBG_MODE == -11) hipLaunchKernelGGL(dbg_conva, dim3(NB * SEQ), dim3(256), 0, stream, (const bf16*)((char*)d_ws + WS_X), (const bf16*)((char*)d_ws + BG_PROJ), (const float*)d_in[9], (const float*)d_in[10], (float*)d_out);
    else if (DBG_STOP && DBG_MODE == -12) hipLaunchKernelGGL(dbg_final, dim3(NB * SEQ), dim3(256), 0, stream, (const float*)((char*)d_ws + WS_X), (const float*)((char*)d_ws + SM_MOD) + 5 * 6144, (const unsigned*)((char*)d_ws + SM_TOK), (const unsigned*)((char*)d_ws + WS_CTL) + CW_CNT + 32, (const bf16*)((char*)d_ws + BG_YO), (const float*)d_in[28], (float*)d_out);
    else if (DBG_STOP && DBG_MODE == -3) hipLaunchKernelGGL(dbg_d2, dim3(NB * SEQ), dim3(256), 0, stream, (const bf16*)((char*)d_ws + BG_MERGED), (const bf16*)((char*)d_ws + WT_OUT), (const float*)((char*)d_ws + WS_X), (const float*)d_in[0], (const float*)((char*)d_ws + SM_MOD), (float*)d_out);
    else if (DBG_STOP) hipLaunchKernelGGL(dbg_dump, dim3(256), dim3(512), 0, stream, a);
}
```

```cpp
#include <hip/hip_runtime.h>
#include <hip/hip_cooperative_groups.h>
#include <cstdio>
#include <cstdint>
namespace cg = cooperative_groups;

#define GAS __attribute__((address_space(1)))
#define LAS __attribute__((address_space(3)))
typedef unsigned short bf16;
typedef short bf16x8 __attribute__((ext_vector_type(8)));
typedef float f32x4 __attribute__((ext_vector_type(4)));
typedef float f32x2 __attribute__((ext_vector_type(2)));
typedef float f32x16 __attribute__((ext_vector_type(16)));
typedef unsigned u32x4 __attribute__((ext_vector_type(4)));
typedef unsigned u32x2 __attribute__((ext_vector_type(2)));
typedef GAS unsigned gu32;
#define RLX_AGENT __ATOMIC_RELAXED, __HIP_MEMORY_SCOPE_AGENT

#ifndef DBG_VAR
#define DBG_VAR 3
#endif
#ifndef DBG_E4S
#define DBG_E4S 1.0f
#endif
#ifndef PROBE_RT
#define PROBE_RT 0
#endif
#ifndef PROBE_P4
#define PROBE_P4 0
#endif
#ifndef PROBE_P2
#define PROBE_P2 0
#endif
#ifndef PROBE_P0
#define PROBE_P0 0
#endif
#ifndef PROBE_NOCONV
#define PROBE_NOCONV 0
#endif
#ifndef DBG_NOCTX
#define DBG_NOCTX 0
#endif
constexpr int D = 1024, NB = 4, SEQ = 8192, CTXL = 256, DEPTH = 2;
constexpr int RPB = CTXL + SEQ;
constexpr int R = NB * RPB;
constexpr int NIN = 7176;
constexpr int NP = 3328;
constexpr int NWIN = 7424;
constexpr int SPB = RPB / 64;
constexpr int NSPAN = NB * SPB;
constexpr float EPS = 1e-6f;
constexpr int C_AB = 0, C_AC = 256, C_AX = 512, C_Q = 768, C_FF = 1024, C_I = 1536, C_G = 1792, C_UR = 2048, C_UI = 2304, C_Z = 2560, C_XBC = 2816;
constexpr int C_XS = C_AC, C_BC = C_UI;
constexpr int NE = 32, DFF = 512;
constexpr int MAXT = 300;

constexpr size_t MiB = 1u << 20;
constexpr size_t WS_CTL = 0;
constexpr size_t WS_SMALL = 1 * MiB;
constexpr size_t WS_WT = 17 * MiB;
constexpr size_t WS_X = 57 * MiB;
constexpr size_t WS_H = 189 * MiB;
constexpr size_t WS_BIG = 255 * MiB;
constexpr size_t WS_END = 617 * MiB;
constexpr size_t SM_PART = WS_SMALL;
constexpr size_t SM_MOD = SM_PART + 2 * 8 * 5 * 6144 * 4;
constexpr size_t SM_M1 = SM_MOD + 2 * 5 * 6144 * 4;
constexpr size_t SM_M2 = SM_M1 + 128 * 128 * 4;
constexpr size_t SM_M3 = SM_M2 + 256 * 128 * 4;
constexpr size_t SM_TW = SM_M3 + 512 * 256 * 4;
constexpr size_t SM_DT = SM_TW + 128 * 64 * 2 * 4;
constexpr size_t SM_TOK = SM_DT + (size_t)R * 8 * 4;
constexpr size_t SM_LIST = SM_TOK + (size_t)R * 8 * 4;
constexpr size_t SM_CY = SM_LIST + (size_t)NE * R * 4;
constexpr size_t SM_DEC = SM_CY + 4 * 256 * 256 * 2;
constexpr size_t SM_WF = SM_DEC + 4 * 8 * 132 * 64 * 4;
constexpr size_t SM_RC = SM_WF + 5 * 1024 * 64 * 4;
constexpr size_t SM_M1B = SM_RC + 5 * 64 * 4;
constexpr size_t SM_M2B = SM_M1B + 128 * 128 * 2;
constexpr size_t SM_DEC2 = SM_M2B + 128 * 256 * 2;
constexpr size_t SM_END = SM_DEC2 + 4 * 8 * 132 * 64 * 4;
static_assert(SM_END <= WS_WT, "small region");
constexpr size_t WT_IN = WS_WT;
constexpr size_t WT_BR = WT_IN + (size_t)2 * NWIN * D * 2;
constexpr size_t WT_OUT = WT_BR + (size_t)2 * 4 * D * 256 * 2;
static_assert(WT_OUT + (size_t)2 * D * D * 2 <= WS_X, "wt region");
constexpr size_t BG_PROJ = WS_BIG;
constexpr size_t BG_ST = BG_PROJ + (size_t)R * NP * 2;
constexpr size_t BG_ST2 = BG_ST + (size_t)NB * 8 * SPB * 4096 * 2;
constexpr size_t BG_AP = BG_ST + (size_t)NB * 8 * SPB * 4096 * 4;
constexpr size_t BG_MIX_END = BG_AP + (size_t)NB * 64 * 2 * 128 * 256 * 2;
constexpr size_t BG_MERGED = BG_ST;
constexpr size_t BG_GSCR = BG_MERGED + (size_t)R * D * 2;
constexpr size_t BG_MSCR = BG_GSCR + 256 * 131072;
static_assert(BG_MSCR + 256 * 131072 <= WS_END && BG_MIX_END + (size_t)R * 256 * 2 <= WS_END, "big region");
constexpr size_t BG_MF = 600 * MiB;
static_assert(BG_MSCR + 256 * 131072 <= BG_MF && BG_MF + (size_t)4 * NB * CTXL * D * 4 <= WS_END, "ctx branch slabs");
constexpr size_t BG_W13 = WS_BIG;
constexpr size_t BG_W2 = BG_W13 + (size_t)NE * D * D * 2;
constexpr size_t BG_ACT = BG_W2 + (size_t)NE * D * DFF * 2;
constexpr size_t BG_YO = BG_ACT + (size_t)MAXT * 256 * DFF * 2;
static_assert(BG_YO + (size_t)MAXT * 256 * D * 2 <= BG_MF, "moe region");
static_assert(BG_W2 + (size_t)NE * D * DFF * 2 <= BG_MERGED, "moe weights may be converted while merged is live");
constexpr int CW_BAR = 4096;
constexpr int CW_WQ = 32768;
constexpr int CW_CNT = 16384;

constexpr int RING_BYTES = 131072;
constexpr int CTRL_OFF = 139264;
constexpr int MISC_OFF = CTRL_OFF + 320;
constexpr int LDS_BYTES = 147456;

__device__ __forceinline__ unsigned f2bf(float f) { unsigned u = __builtin_bit_cast(unsigned, f); return (u + 0x7fffu + ((u >> 16) & 1u)) >> 16; }
__device__ __forceinline__ unsigned pk2(float lo, float hi) { return f2bf(lo) | (f2bf(hi) << 16); }
__device__ __forceinline__ float bf2f(unsigned short h) { return __builtin_bit_cast(float, (unsigned)h << 16); }
__device__ __forceinline__ float bflo(unsigned u) { return __builtin_bit_cast(float, u << 16); }
__device__ __forceinline__ float bfhi(unsigned u) { return __builtin_bit_cast(float, u & 0xffff0000u); }
__device__ __forceinline__ float wave_sum(float v) {
#pragma unroll
    for (int o = 1; o < 64; o <<= 1) v += __shfl_xor(v, o);
    return v;
}
__device__ __forceinline__ float sigmoidf_(float x) { return __builtin_amdgcn_rcpf(1.0f + __expf(-x)); }
__device__ __forceinline__ float siluf_(float x) { return x * __builtin_amdgcn_rcpf(1.0f + __expf(-x)); }
__device__ __forceinline__ float softplusf_(float x) { return x > 20.f ? x : log1pf(__expf(x)); }
#define LDS_WAIT() asm volatile("s_waitcnt lgkmcnt(0)" ::: "memory")
#define VM_WAIT() asm volatile("s_waitcnt vmcnt(0)" ::: "memory")

__device__ __forceinline__ int row_cr(int r) { const int b = r / RPB, s = r - b * RPB; return s < CTXL ? 4 : b; }

#define XB_TMO      128
#define XB_XCNT(j)  (256  + 64 * (j))
#define XB_XSUB(j)  (1280 + 64 * (j))
#define XB_XGEN(j)  (2304 + 64 * (j))
#define XB_TOP      3328
#define XB_TOPGEN   3392
#define XCD_BAR_WORDS 3456
#define XB_SPIN_CAP (1u << 20)
__device__ __forceinline__ unsigned xb_ld(unsigned* p)              { return __hip_atomic_load(p, __ATOMIC_RELAXED, __HIP_MEMORY_SCOPE_AGENT); }
__device__ __forceinline__ unsigned xb_add(unsigned* p, unsigned v) { return __hip_atomic_fetch_add(p, v, __ATOMIC_RELAXED, __HIP_MEMORY_SCOPE_AGENT); }
__device__ __forceinline__ unsigned xb_xcc_id() { return (unsigned)__builtin_amdgcn_s_getreg((3 << 11) | 20) & 0xFu; }
#define XB_SPIN(cond, bar) do { unsigned _sp = 0; while (cond) { __builtin_amdgcn_s_sleep(1); \
    if ((++_sp & 255u) == 0u) { if (xb_ld(&(bar)[XB_TMO])) break; if (_sp > XB_SPIN_CAP) { atomicAdd(&(bar)[XB_TMO], 1u); break; } } } } while (0)
struct XcdBarrier { unsigned* bar; unsigned x; volatile LAS unsigned* st; };
__device__ __forceinline__ XcdBarrier xcd_barrier_post(unsigned* bar, volatile LAS unsigned* st) {
    XcdBarrier b; b.bar = bar; b.x = xb_xcc_id(); b.st = st;
    if (threadIdx.x == 0) (void)xb_add(&bar[XB_XCNT(b.x)], 1u);
    return b;
}
__device__ __forceinline__ void xcd_barrier_complete(unsigned* bar, unsigned x, unsigned& nloc, unsigned& nx) {
    const unsigned G = gridDim.x * gridDim.y * gridDim.z;
    unsigned sum, cnt, mine, sp = 0u;
    for (;;) {
        sum = 0u; cnt = 0u; mine = 0u;
#pragma unroll
        for (unsigned j = 0; j < 16; ++j) { const unsigned c = xb_ld(&bar[XB_XCNT(j)]); sum += c; cnt += (c > 0u) ? 1u : 0u; mine = (j == x) ? c : mine; }
        if (sum == G) break;
        __builtin_amdgcn_s_sleep(1);
        if ((++sp & 255u) == 0u) { if (xb_ld(&bar[XB_TMO])) break; if (sp > XB_SPIN_CAP) { atomicAdd(&bar[XB_TMO], 1u); break; } }
    }
    nloc = mine > 0u ? mine : 1u; nx = cnt > 0u ? cnt : 1u;
}
__device__ __forceinline__ void xcd_barrier(const XcdBarrier& b, const int tid) {
    asm volatile("s_waitcnt vmcnt(0)" ::: "memory");
    __syncthreads();
    if (tid == 0) {
        unsigned* bar = b.bar;
        __builtin_amdgcn_s_waitcnt(0);
        unsigned nloc = b.st[0], nx = b.st[1];
        if (nloc == 0u) { xcd_barrier_complete(bar, b.x, nloc, nx); b.st[0] = nloc; b.st[1] = nx; }
        const unsigned old = xb_add(&bar[XB_XSUB(b.x)], 1u);
        const unsigned gen = old / nloc;
        if (old + 1u == (gen + 1u) * nloc) {
            __builtin_amdgcn_fence(__ATOMIC_RELEASE, "agent");
            asm volatile("s_waitcnt vmcnt(0)" ::: "memory");
            const unsigned og = xb_add(&bar[XB_TOP], 1u);
            const unsigned tg = og / nx;
            if (og + 1u == (tg + 1u) * nx) xb_add(&bar[XB_TOPGEN], 1u);
            else XB_SPIN(xb_ld(&bar[XB_TOPGEN]) == tg, bar);
            __builtin_amdgcn_fence(__ATOMIC_ACQUIRE, "agent");
            xb_add(&bar[XB_XGEN(b.x)], 1u);
            asm volatile("s_waitcnt vmcnt(0)" ::: "memory");
        } else {
            XB_SPIN(xb_ld(&bar[XB_XGEN(b.x)]) == gen, bar);
            __builtin_amdgcn_fence(__ATOMIC_ACQUIRE, "agent");
            asm volatile("s_waitcnt vmcnt(0)" ::: "memory");
        }
    }
    __syncthreads();
}

namespace ge {
constexpr int BM = 256, BK = 64, HALF = 128, HTB = HALF * BK * 2, NXCD = 8, WGM = 8;
__device__ __forceinline__ int lds_byte(int r, int c) { const int st = (r >> 4) * 2 + (c >> 5), rr = r & 15, cc = c & 31, ob = rr * 64 + cc * 2; return st * 1024 + (ob ^ (((ob >> 9) & 1) << 5)); }
__device__ __forceinline__ void stage_rc(int b, int& R_, int& C_) { const int st = b / 1024, sb = b % 1024, swz = sb ^ (((sb >> 9) & 1) << 5); R_ = (st >> 1) * 16 + swz / 64; C_ = (st & 1) * 32 + (swz % 64) / 2; }
__device__ __forceinline__ int perm32(int rho) { const int n = rho >> 4, i = rho & 15; return 8 * (i >> 2) + 4 * n + (i & 3); }

struct Unit { const char* A; const char* B; const int* rows; unsigned lda, ldb; int nt, kind, pm, pn, aux; };

__device__ __forceinline__ bool tile_order(long L, int nM, int nN, int& pm, int& pn) {
    const int nwg = nM * nN; if (L >= nwg) return false;
    int wgid = (int)L; { const int q = nwg / NXCD, r = nwg % NXCD, xcd = wgid % NXCD, off = wgid / NXCD; wgid = (xcd < r ? xcd * (q + 1) : r * (q + 1) + (xcd - r) * q) + off; }
    const int nig = WGM * nN, gid = wgid / nig, fm = gid * WGM, gsz = (nM - fm) < WGM ? (nM - fm) : WGM;
    pm = fm + ((wgid % nig) % gsz); pn = (wgid % nig) / gsz; return true;
}

template <class Epi, class Sched, bool GATHER, bool ALIGN_EPI = true>
__device__ __forceinline__ void gemm_engine(LAS unsigned char* lds, const Sched& S, const Epi& E, const int tid) {
    const int wid = __builtin_amdgcn_readfirstlane(tid >> 6), lane = tid & 63, wr = wid >> 2, wc = wid & 3, fr = lane & 15, fq = lane >> 4;
    unsigned voffA[2][2], voffB[2];
    const size_t kstep = (size_t)(BK * 2);
    const unsigned ldsw = (unsigned)wid * 1024u;
    const int aoff = lds_byte(wr * 64 + fr, fq * 8), boff = lds_byte(wc * 32 + fr, fq * 8);
#define GE_SETV(u) do { int t_ = tid; asm volatile("" : "+v"(t_)); _Pragma("unroll") for (int _i = 0; _i < 2; ++_i) { int R_, C_; stage_rc(t_ * 16 + _i * 8192, R_, C_); const int Rb_ = Epi::PERM ? ((R_ & ~31) + perm32(R_ & 31)) : R_; \
        if (GATHER) { const int i0_ = R_ < (u).aux ? (u).rows[R_] : 0, i1_ = (HALF + R_) < (u).aux ? (u).rows[HALF + R_] : 0; \
            voffA[0][_i] = (unsigned)i0_ * (u).lda + (unsigned)C_ * 2u; voffA[1][_i] = (unsigned)i1_ * (u).lda + (unsigned)C_ * 2u; } \
        else { voffA[0][_i] = (unsigned)R_ * (u).lda + (unsigned)C_ * 2u; voffA[1][_i] = voffA[0][_i]; } \
        voffB[_i] = (unsigned)Rb_ * (u).ldb + (unsigned)C_ * 2u; } hstepB = (size_t)HALF * (u).ldb; hstepA = GATHER ? (size_t)0 : (size_t)HALF * (u).lda; } while (0)
#define GE_SA(b, h) (((b) * 2 + (h)) * HTB)
#define GE_SB(b, h) ((4 + (b) * 2 + (h)) * HTB)
#define GE_STAGE(bufoff, gbase, voff) do { _Pragma("unroll") for (int _i = 0; _i < 2; ++_i) \
        __builtin_amdgcn_global_load_lds((const unsigned*)((const char*)(gbase) + (voff)[_i]), (LAS unsigned*)(lds + (bufoff) + ldsw + _i * 8192), 16, 0, 0); } while (0)
#define GE_LDA(dst, b, h) do { _Pragma("unroll") for (int m = 0; m < 4; ++m) _Pragma("unroll") for (int k = 0; k < 2; ++k) dst[m][k] = *(const LAS bf16x8*)(lds + GE_SA(b, h) + aoff + m * 2048 + k * 1024); } while (0)
#define GE_LDB(dst, b, h) do { _Pragma("unroll") for (int n = 0; n < 2; ++n) _Pragma("unroll") for (int k = 0; k < 2; ++k) dst[n][k] = *(const LAS bf16x8*)(lds + GE_SB(b, h) + boff + n * 2048 + k * 1024); } while (0)
#define GE_MMA(ai, bj, At, Bt) do { __builtin_amdgcn_s_setprio(1); _Pragma("unroll") for (int m = 0; m < 4; ++m) _Pragma("unroll") for (int n = 0; n < 2; ++n) _Pragma("unroll") for (int k = 0; k < 2; ++k) \
        acc[ai][bj][m][n] = __builtin_amdgcn_mfma_f32_16x16x32_bf16(Bt[n][k], At[m][k], acc[ai][bj][m][n], 0, 0, 0); __builtin_amdgcn_s_setprio(0); } while (0)
#define GE_WAIT_V(n) asm volatile("s_waitcnt vmcnt(" #n ")" ::: "memory")
#define GE_WAIT_L(n) asm volatile("s_waitcnt lgkmcnt(" #n ")" ::: "memory")
#define GE_BAR __builtin_amdgcn_s_barrier()
#define GE_SCHED __builtin_amdgcn_sched_barrier(0)
    Unit cur, nxt; int ui = 0;
    if (!S.next(0, cur)) return;
    f32x4 acc[2][2][4][2];
#pragma unroll
    for (int a = 0; a < 2; ++a)
#pragma unroll
        for (int b = 0; b < 2; ++b)
#pragma unroll
            for (int m = 0; m < 4; ++m)
#pragma unroll
                for (int n = 0; n < 2; ++n) acc[a][b][m][n] = (f32x4){0.f, 0.f, 0.f, 0.f};
    bf16x8 At[4][2], B0[2][2], B1[2][2];
    size_t hstepB, hstepA;
    GE_SETV(cur);
    if (GATHER) { VM_WAIT(); }
    const char* cA = cur.A; const char* cB = cur.B;
    GE_STAGE(GE_SB(0, 0), cB, voffB); GE_STAGE(GE_SB(0, 1), cB + hstepB, voffB); GE_STAGE(GE_SA(0, 0), cA, voffA[0]); GE_STAGE(GE_SA(0, 1), cA + hstepA, voffA[1]);
    if (wr == 1) GE_BAR;
    GE_WAIT_V(2); GE_BAR;
    GE_STAGE(GE_SB(1, 0), cB + kstep, voffB); GE_STAGE(GE_SA(1, 0), cA + kstep, voffA[0]); GE_STAGE(GE_SB(1, 1), cB + hstepB + kstep, voffB);
    GE_WAIT_V(6); GE_BAR;
    for (;;) {
        const bool has_next = S.next(ui + 1, nxt);
        const char* nA = has_next ? nxt.A : cA; const char* nB = has_next ? nxt.B : cB;
        const int nt = cur.nt;
        for (int t = 0; t < nt; t += 2) {
            const bool last = (t == nt - 2);
            const char* a1 = cA + (size_t)(t + 1) * kstep;
            const char* a2 = last ? nA : cA + (size_t)(t + 2) * kstep; const char* b2 = last ? nB : cB + (size_t)(t + 2) * kstep;
            const char* a3 = a2 + kstep; const char* b3 = b2 + kstep;
            GE_LDB(B0, 0, 0); GE_LDB(B1, 0, 1); GE_SCHED; GE_LDA(At, 0, 0); GE_STAGE(GE_SA(1, 1), a1 + hstepA, voffA[1]);
            GE_WAIT_V(8); GE_WAIT_L(0); GE_BAR; GE_MMA(0, 0, At, B0); GE_MMA(0, 1, At, B1); GE_BAR; GE_SCHED;
            if (last && has_next) { GE_SETV(nxt); if (GATHER) { VM_WAIT(); } }
            GE_LDA(At, 0, 1); GE_STAGE(GE_SB(0, 0), b2, voffB); GE_STAGE(GE_SB(0, 1), b2 + hstepB, voffB); GE_STAGE(GE_SA(0, 0), a2, voffA[0]);
            GE_WAIT_V(8); GE_WAIT_L(0); GE_BAR; GE_MMA(1, 0, At, B0); GE_MMA(1, 1, At, B1); GE_BAR; GE_SCHED;
            GE_LDB(B0, 1, 0); GE_LDB(B1, 1, 1); GE_SCHED; GE_LDA(At, 1, 0); GE_STAGE(GE_SA(0, 1), a2 + hstepA, voffA[1]);
            GE_WAIT_V(8); GE_WAIT_L(0); GE_BAR; GE_MMA(0, 0, At, B0); GE_MMA(0, 1, At, B1); GE_BAR; GE_SCHED;
            GE_LDA(At, 1, 1); GE_STAGE(GE_SB(1, 0), b3, voffB); GE_STAGE(GE_SB(1, 1), b3 + hstepB, voffB); GE_STAGE(GE_SA(1, 0), a3, voffA[0]);
            GE_WAIT_V(8); GE_WAIT_L(0); GE_BAR; GE_MMA(1, 0, At, B0); GE_MMA(1, 1, At, B1); GE_BAR; GE_SCHED;
        }
        if (ALIGN_EPI) { if (wr == 0) GE_BAR; }
        { int tid_o = tid, fr_o = fr, fq_o = fq; asm volatile("" : "+v"(tid_o), "+v"(fr_o), "+v"(fq_o)); E(acc, cur, wr, wc, fr_o, fq_o, tid_o); }
        if (!has_next) break;
        if (Epi::DRAIN) GE_WAIT_V(0);
#pragma unroll
        for (int a = 0; a < 2; ++a)
#pragma unroll
            for (int b = 0; b < 2; ++b)
#pragma unroll
                for (int m = 0; m < 4; ++m)
#pragma unroll
                    for (int n = 0; n < 2; ++n) acc[a][b][m][n] = (f32x4){0.f, 0.f, 0.f, 0.f};
        cur = nxt; cA = nA; cB = nB; ++ui;
        if (ALIGN_EPI) { if (wr == 1) GE_BAR; }
    }
    GE_WAIT_V(0);
    if (!ALIGN_EPI) { if (wr == 0) GE_BAR; }
    GE_BAR;
#undef GE_SETV
#undef GE_SA
#undef GE_SB
#undef GE_STAGE
#undef GE_LDA
#undef GE_LDB
#undef GE_MMA
#undef GE_WAIT_V
#undef GE_WAIT_L
#undef GE_BAR
#undef GE_SCHED
}
typedef float cvt_f32x2 __attribute__((ext_vector_type(2)));
typedef __bf16 cvt_bf16x2 __attribute__((ext_vector_type(2)));
__device__ __forceinline__ unsigned cvt_pk_bf16(float lo, float hi) { const cvt_f32x2 v = {lo, hi}; return __builtin_bit_cast(unsigned, __builtin_convertvector(v, cvt_bf16x2)); }
}

struct Args { const float* in[29]; float* out; unsigned char* ws; int ph_lo, ph_hi, coop, pad; };
typedef __attribute__((address_space(4))) const Args CArgs;
__device__ __forceinline__ CArgs* kargs() { unsigned long long p = (unsigned long long)__builtin_amdgcn_kernarg_segment_ptr(); asm volatile("" : "+s"(p)); return (CArgs*)p; }
#define KA_DECL CArgs* const KA = kargs()
struct Fr {
    LAS unsigned char* lds;
    int tid, lane, wave, G, bid;
};
enum { I_X = 0, I_C, I_CTX, I_CCTX, I_ADAW, I_ADAB, I_NMIX, I_NFFN, I_WIN, I_CAW, I_CAB, I_HLB, I_HNW, I_SCW, I_SCB, I_ALOG, I_DTB, I_SD, I_SNW, I_WBR, I_WOUT, I_RGW, I_RGB, I_REW, I_REB, I_W1, I_W3, I_W2, I_FNW };

#define WSP(T, off) ((T*)(KA->ws + (off)))

__device__ __forceinline__ const float* xrow_ptr(CArgs* KA, int l, int r) {
    if (l > 0) return WSP(const float, WS_X) + (size_t)r * D;
    const int b = r / RPB, s = r - b * RPB;
    return s < CTXL ? KA->in[I_CTX] + ((size_t)b * CTXL + s) * D : KA->in[I_X] + ((size_t)b * SEQ + (s - CTXL)) * D;
}

__device__ __forceinline__ void transpose_item(const float* W, int ldw, int k0, int n0, bf16* WT, int ldt, int drow0, LAS float* scr, int lane) {
#pragma unroll 8
    for (int i = 0; i < 32; ++i) { const int kk = 2 * i + (lane >> 5); scr[kk * 33 + (lane & 31)] = W[(size_t)(k0 + kk) * ldw + n0 + (lane & 31)]; }
    LDS_WAIT(); asm volatile("" ::: "memory");
    const int c = lane & 7;
#pragma unroll
    for (int j = 0; j < 4; ++j) { const int n = (lane >> 3) + 8 * j; const LAS float* s = scr + (8 * c) * 33 + n;
        u32x4 o; o.x = pk2(s[0 * 33], s[1 * 33]); o.y = pk2(s[2 * 33], s[3 * 33]); o.z = pk2(s[4 * 33], s[5 * 33]); o.w = pk2(s[6 * 33], s[7 * 33]);
        *(u32x4*)(WT + (size_t)(drow0 + n) * ldt + k0 + 8 * c) = o; }
    LDS_WAIT(); asm volatile("" ::: "memory");
}
__device__ __forceinline__ void transpose_item64(const float* W, int ldw, int k0, int n0, bf16* WT, int ldt, int drow0, LAS unsigned char* scr, int lane) {
    f32x4 v[16];
#pragma unroll
    for (int i = 0; i < 16; ++i) v[i] = *(const f32x4*)(W + (size_t)(k0 + 4 * i + (lane >> 4)) * ldw + n0 + 4 * (lane & 15));
    LAS bf16* img = (LAS bf16*)scr;
#pragma unroll
    for (int i = 0; i < 16; ++i) { const int kk = 4 * i + (lane >> 4), n = 4 * (lane & 15);
        img[(n + 0) * 72 + kk] = (bf16)f2bf(v[i].x); img[(n + 1) * 72 + kk] = (bf16)f2bf(v[i].y); img[(n + 2) * 72 + kk] = (bf16)f2bf(v[i].z); img[(n + 3) * 72 + kk] = (bf16)f2bf(v[i].w); }
    LDS_WAIT(); asm volatile("" ::: "memory");
#pragma unroll
    for (int j = 0; j < 8; ++j) { const int n = 8 * j + (lane >> 3), c = lane & 7;
        *(u32x4*)(WT + (size_t)(drow0 + n) * ldt + k0 + 8 * c) = *(const LAS u32x4*)(img + n * 72 + 8 * c); }
    LDS_WAIT(); asm volatile("" ::: "memory");
}
constexpr int PRO_L1_ITEMS = 16 * 108 + 512 + 256 + 256, PRO_L1_TICKETS = PRO_L1_ITEMS / 8;
__device__ __forceinline__ void p0_prologue(Fr& F, int ticket) { KA_DECL;
    LAS float* scr = (LAS float*)(F.lds + F.wave * 16384);
    const int gw = F.bid * 8 + F.wave, NGW = F.G * 8, lane = F.lane;
    LAS float* ctab = scr + 2400; LAS float* stab = scr + 2464;
    { float s, c; sincospif(2.0f * (float)lane / 64.0f, &s, &c); ctab[lane] = c; stab[lane] = s; }
    LDS_WAIT();
    constexpr int I_INN = 16 * 108, I_DFT = 512, I_BR = 256, I_OUT = 256, I_ADA = 96 * 8;
    constexpr int PER_L = I_INN + I_DFT + I_BR + I_OUT + I_ADA;
    static_assert(PRO_L1_ITEMS == I_INN + I_DFT + I_BR + I_OUT && PRO_L1_ITEMS % 8 == 0, "layer-1 conversion items");
    const int it_lo = ticket < 0 ? gw : PER_L + I_ADA + 8 * ticket + F.wave, it_hi = ticket < 0 ? 2 * PER_L : it_lo + 1, it_st = ticket < 0 ? NGW : 1;
    for (int it = it_lo; it < it_hi; it += it_st) {
        const int l = it / PER_L; int r = it % PER_L;
        if (l == 1) r = (r + PER_L - I_ADA) % PER_L;
        if (ticket < 0 && l == 1 && r < PRO_L1_ITEMS) continue;
        const float* win = KA->in[I_WIN] + (size_t)l * D * NIN;
        bf16* wt_in = WSP(bf16, WT_IN) + (size_t)l * NWIN * D;
        if (PROBE_P0 && PROBE_P0 != 1 && r < I_INN + I_DFT + I_BR + I_OUT && !(r >= I_INN && r < I_INN + I_DFT)) continue;
        if (PROBE_P0 && PROBE_P0 != 2 && r >= I_INN && r < I_INN + I_DFT) continue;
        if (PROBE_P0 && PROBE_P0 != 3 && r >= I_INN + I_DFT + I_BR + I_OUT) continue;
        if (r < I_INN) {
            const int kb = r / 108, q = r % 108; int dst, src;
            if (q < 32) { dst = 64 * q; src = 64 * q; } else if (q < 36) { dst = 2560 + 64 * (q - 32); src = 2304 + 64 * (q - 32); }
            else if (q < 44) { dst = 2816 + 64 * (q - 36); src = 2560 + 64 * (q - 36); } else { dst = 3328 + 64 * (q - 44); src = 3080 + 64 * (q - 44); }
            transpose_item64(win, NIN, 64 * kb, src, wt_in, D, dst, F.lds + F.wave * 16384, lane); continue; }
        r -= I_INN;
        if (r < I_DFT) {
            const int kb = r >> 5, g = (r >> 3) & 3, cpb = r & 7; const int k = 64 * kb + lane;
            float w[64];
            const f32x4* src = (const f32x4*)(win + (size_t)k * NIN + 2048 + g * 64);
#pragma unroll
            for (int j = 0; j < 16; ++j) { const f32x4 v = src[j]; w[4 * j] = v.x; w[4 * j + 1] = v.y; w[4 * j + 2] = v.z; w[4 * j + 3] = v.w; }
            for (int cp = 8 * cpb; cp < 8 * cpb + 8; ++cp) {
                float ur = 0.f, ui = 0.f;
#pragma unroll
                for (int c = 0; c < 64; ++c) { const int m = (c * cp) & 63; ur += w[c] * ctab[m]; ui -= w[c] * stab[m]; }
                wt_in[(size_t)(C_UR + g * 64 + cp) * D + k] = (bf16)f2bf(ur);
                wt_in[(size_t)(C_UI + g * 64 + cp) * D + k] = (bf16)f2bf(ui);
            }
            continue; }
        r -= I_DFT;
        if (r < I_BR) { const int kbr = r >> 6, q = r & 63, kb = q >> 4, nb = q & 15;
            transpose_item64(KA->in[I_WBR] + ((size_t)l * 4 + kbr) * 256 * D, D, 64 * kb, 64 * nb, WSP(bf16, WT_BR) + ((size_t)l * 4 + kbr) * D * 256, 256, 64 * nb, F.lds + F.wave * 16384, lane); continue; }
        r -= I_BR;
        if (r < I_OUT) { const int kb = r >> 4, nb = r & 15;
            transpose_item64(KA->in[I_WOUT] + (size_t)l * D * D, D, 64 * kb, 64 * nb, WSP(bf16, WT_OUT) + (size_t)l * D * D, D, 64 * nb, F.lds + F.wave * 16384, lane); continue; }
        r -= I_OUT;
        {
            const int jb = r >> 3, ks = r & 7, j = jb * 64 + lane;
            const float* aw = KA->in[I_ADAW] + (size_t)l * D * 6144;
            LAS float* sv = scr + 2560;
#pragma unroll
            for (int q = 0; q < 10; ++q) { const int e = q * 64 + lane, cr = e >> 7, kk = e & 127; const float cv = cr < 4 ? KA->in[I_C][cr * D + ks * 128 + kk] : KA->in[I_CCTX][ks * 128 + kk]; sv[e] = siluf_(cv); }
            LDS_WAIT(); asm volatile("" ::: "memory");
            float a0 = 0.f, a1 = 0.f, a2 = 0.f, a3 = 0.f, a4 = 0.f;
#pragma unroll 8
            for (int kk = 0; kk < 128; ++kk) { const float wv = aw[(size_t)(ks * 128 + kk) * 6144 + j];
                a0 += sv[kk] * wv; a1 += sv[128 + kk] * wv; a2 += sv[256 + kk] * wv; a3 += sv[384 + kk] * wv; a4 += sv[512 + kk] * wv; }
            float* part = WSP(float, SM_PART) + ((size_t)(l * 8 + ks) * 5) * 6144 + j;
            part[0] = a0; part[6144] = a1; part[2 * 6144] = a2; part[3 * 6144] = a3; part[4 * 6144] = a4;
            LDS_WAIT(); asm volatile("" ::: "memory");
        }
    }
    if (ticket >= 0) return;
    if (PROBE_P0 && PROBE_P0 != 4) return;
    const int gt = F.bid * 512 + F.tid, NGT = F.G * 512;
    float* M1 = WSP(float, SM_M1); float* M2 = WSP(float, SM_M2); float* M3 = WSP(float, SM_M3); float* TW = WSP(float, SM_TW);
    for (int e = gt; e < 128 * 128; e += NGT) {
        const int k = e >> 7, m = e & 127, ri = k >> 6, t1 = k & 63, ro = m >> 6, k1 = m & 63; float s, c; sincospif(2.0f * (float)((t1 * k1) & 63) / 64.0f, &s, &c);
        M1[e] = ro == 0 ? (ri == 0 ? c : s) : (ri == 0 ? -s : c); }
    for (int e = gt; e < 256 * 128; e += NGT) {
        const int k = e >> 7, k2 = e & 127, ri = k >> 7, t2 = k & 127; float s, c; sincospif(2.0f * (float)((t2 * k2) & 127) / 128.0f, &s, &c);
        M2[e] = ri == 0 ? c : s; }
    for (int e = gt; e < 128 * 128; e += NGT) {
        const int m = e >> 7, k = e & 127, ri = k >> 6, t1 = k & 63, ro = m >> 6, k1 = m & 63; float s, c; sincospif(2.0f * (float)((t1 * k1) & 63) / 64.0f, &s, &c);
        WSP(bf16, SM_M1B)[e] = (bf16)f2bf(ro == 0 ? (ri == 0 ? c : s) : (ri == 0 ? -s : c)); }
    for (int e = gt; e < 128 * 256; e += NGT) {
        const int k2 = e >> 8, k = e & 255, ri = k >> 7, t2 = k & 127; float s, c; sincospif(2.0f * (float)((t2 * k2) & 127) / 128.0f, &s, &c);
        WSP(bf16, SM_M2B)[e] = (bf16)f2bf(ri == 0 ? c : s); }
    for (int e = gt; e < 512 * 256; e += NGT) {
        const int k = e >> 8, tp = e & 255, ri = k >> 8, t = k & 255; float s, c; sincospif(2.0f * (float)((t * tp) & 255) / 256.0f, &s, &c);
        M3[e] = ri == 0 ? c : s; }
    for (int e = gt; e < 128 * 64; e += NGT) {
        const int t2 = e >> 6, k1 = e & 63; float s, c; sincospif(2.0f * (float)(t2 * k1) / 8192.0f, &s, &c); TW[2 * e] = c; TW[2 * e + 1] = s; }
}
__device__ __forceinline__ void p1_mod(Fr& F) { KA_DECL;
    const int gt = F.bid * 512 + F.tid, NGT = F.G * 512;
    for (int e = gt; e < 2 * 5 * 6144; e += NGT) { const int l = e / (5 * 6144), rem = e % (5 * 6144), cr = rem / 6144, j = rem % 6144;
        float s = KA->in[I_ADAB][l * 6144 + j];
#pragma unroll
        for (int ks = 0; ks < 8; ++ks) s += WSP(const float, SM_PART)[((size_t)(l * 8 + ks) * 5 + cr) * 6144 + j];
        WSP(float, SM_MOD)[e] = s; }
}
__device__ __forceinline__ void moe_convert_item(Fr& F, int l, int it) { KA_DECL;
    LAS unsigned char* scr = F.lds + F.wave * 16384; const int lane = F.lane;
    {   const int which = it >> 12, r = it & 4095, e = r >> 7, q = r & 127;
        if (which < 2) { const int kb = q >> 3, nb = q & 7; const float* W = KA->in[which == 0 ? I_W1 : I_W3] + ((size_t)l * NE + e) * D * DFF;
            transpose_item64(W, DFF, 64 * kb, 64 * nb, WSP(bf16, BG_W13) + (size_t)e * D * D, D, (nb >> 1) * 256 + which * 128 + (nb & 1) * 64, scr, lane); }
        else { const int kb = q >> 4, nb = q & 15; const float* W = KA->in[I_W2] + ((size_t)l * NE + e) * DFF * D;
            transpose_item64(W, D, 64 * kb, 64 * nb, WSP(bf16, BG_W2) + (size_t)e * D * DFF, DFF, 64 * nb, scr, lane); }
    }
}

__device__ __forceinline__ void pa_hrows(Fr& F, int l) { KA_DECL;
    LAS float* wdt = (LAS float*)F.lds;
    const float* win = KA->in[I_WIN] + (size_t)l * D * NIN;
    for (int e = F.tid; e < D * 8; e += 512) wdt[e] = win[(size_t)(e >> 3) * NIN + 3072 + (e & 7)];
    __syncthreads();
    const int gw = F.bid * 8 + F.wave, NGW = F.G * 8, lane = F.lane;
    const float* nw = KA->in[I_NMIX] + l * D;
    f32x4 nw4[4];
#pragma unroll
    for (int j = 0; j < 4; ++j) nw4[j] = *(const f32x4*)(nw + 4 * (lane + 64 * j));
    f32x4 p1[4], p2[4];
#pragma unroll
    for (int j = 0; j < 4; ++j) { p1[j] = (f32x4){0.f, 0.f, 0.f, 0.f}; p2[j] = p1[j]; }
#define PA_LOAD(dst, rr) do { const GAS f32x4* xr_ = (const GAS f32x4*)xrow_ptr(KA, l, (rr)) + lane; _Pragma("unroll") for (int j_ = 0; j_ < 4; ++j_) dst[j_] = xr_[64 * j_]; } while (0)
    if (gw < R) PA_LOAD(p1, gw);
    if (gw + NGW < R) PA_LOAD(p2, gw + NGW);
    for (int r = gw; r < R; r += NGW) {
        const int cr = row_cr(r);
        const float* mod = WSP(const float, SM_MOD) + ((size_t)l * 5 + cr) * 6144;
        f32x4 v[4]; float s = 0.f;
#pragma unroll
        for (int j = 0; j < 4; ++j) { v[j] = p1[j]; p1[j] = p2[j]; }
        if (r + 2 * NGW < R) PA_LOAD(p2, r + 2 * NGW);
#pragma unroll
        for (int j = 0; j < 4; ++j) s += (v[j].x * v[j].x + v[j].y * v[j].y) + (v[j].z * v[j].z + v[j].w * v[j].w);
        f32x4 sh4[4], sc4[4];
#pragma unroll
        for (int j = 0; j < 4; ++j) { const int k = 4 * (lane + 64 * j); sh4[j] = *(const GAS f32x4*)((const GAS float*)mod + k); sc4[j] = *(const GAS f32x4*)((const GAS float*)mod + 1024 + k); }
        const float rstd = 1.0f / sqrtf(wave_sum(s) * (1.f / D) + EPS);
        float d8[8] = {0, 0, 0, 0, 0, 0, 0, 0};
        unsigned long long* o8 = (unsigned long long*)(WSP(bf16, WS_H) + (size_t)r * D) + lane;
#pragma unroll
        for (int j = 0; j < 4; ++j) { const int k = 4 * (lane + 64 * j);
            const f32x4 w4 = nw4[j], sh = sh4[j], sc = sc4[j];
            f32x4 h = (v[j] * rstd) * w4 * (sc + 1.0f) + sh;
            o8[64 * j] = (unsigned long long)pk2(h.x, h.y) | ((unsigned long long)pk2(h.z, h.w) << 32);
#pragma unroll
            for (int e = 0; e < 4; ++e) { const f32x4 wa = *(const LAS f32x4*)(wdt + (k + e) * 8), wb = *(const LAS f32x4*)(wdt + (k + e) * 8 + 4); const float hv = h[e];
                d8[0] += hv * wa.x; d8[1] += hv * wa.y; d8[2] += hv * wa.z; d8[3] += hv * wa.w; d8[4] += hv * wb.x; d8[5] += hv * wb.y; d8[6] += hv * wb.z; d8[7] += hv * wb.w; } }
#pragma unroll
        for (int e = 0; e < 8; ++e) d8[e] = wave_sum(d8[e]);
        if (lane == 0) { float* dt = WSP(float, SM_DT) + (size_t)r * 8; *(f32x4*)dt = (f32x4){d8[0], d8[1], d8[2], d8[3]}; *(f32x4*)(dt + 4) = (f32x4){d8[4], d8[5], d8[6], d8[7]}; }
    }
    __syncthreads();
}

__device__ __forceinline__ void nbr_valid(int r, bool& vp, bool& vn) { const int s = r % RPB; vp = (s != 0) && (s != CTXL); vn = (s != CTXL - 1) && (s != RPB - 1); }

__device__ __forceinline__ void conv_a_pass(Fr& F, int l) { KA_DECL;
    const int gt = F.bid * 512 + F.tid, NGT = F.G * 512;
    bf16* P = WSP(bf16, BG_PROJ);
    const float* cw = KA->in[I_CAW] + l * 3 * 256; const float* cb = KA->in[I_CAB] + l * 256;
    for (int e = gt; e < R * 32; e += NGT) {
        const int r = e >> 5, c0 = (e & 31) * 8; bool vp, vn; nbr_valid(r, vp, vn);
        bf16* row = P + (size_t)r * NP;
        const u32x4 zc = {0, 0, 0, 0};
        const u32x4 ac0 = *(const u32x4*)(row + C_AC + c0), ax0 = *(const u32x4*)(row + C_AX + c0), ab = *(const u32x4*)(row + C_AB + c0);
        const u32x4 acp = vp ? *(const u32x4*)(row - NP + C_AC + c0) : zc, axp = vp ? *(const u32x4*)(row - NP + C_AX + c0) : zc;
        const u32x4 acn = vn ? *(const u32x4*)(row + NP + C_AC + c0) : zc, axn = vn ? *(const u32x4*)(row + NP + C_AX + c0) : zc;
        u32x4 o;
#pragma unroll
        for (int q = 0; q < 4; ++q) { float y[2];
#pragma unroll
            for (int hh = 0; hh < 2; ++hh) { const int c = c0 + 2 * q + hh;
                const float up = hh ? bfhi(acp[q]) * bfhi(axp[q]) : bflo(acp[q]) * bflo(axp[q]);
                const float u0 = hh ? bfhi(ac0[q]) * bfhi(ax0[q]) : bflo(ac0[q]) * bflo(ax0[q]);
                const float un = hh ? bfhi(acn[q]) * bfhi(axn[q]) : bflo(acn[q]) * bflo(axn[q]);
                const float b_ = hh ? bfhi(ab[q]) : bflo(ab[q]);
                y[hh] = b_ * (cb[c] + cw[c] * up + cw[256 + c] * u0 + cw[512 + c] * un); }
            o[q] = pk2(y[0], y[1]); }
        *(u32x4*)(row + C_AB + c0) = o;
    }
}
__device__ __forceinline__ void conv_xbc_pass(Fr& F, int l) { KA_DECL;
    const int gt = F.bid * 512 + F.tid, NGT = F.G * 512;
    bf16* P = WSP(bf16, BG_PROJ);
    const float* cw = KA->in[I_SCW] + l * 3 * 512; const float* cb = KA->in[I_SCB] + l * 512;
    for (int e = gt; e < R * 64; e += NGT) {
        const int r = e >> 6, c0 = (e & 63) * 8; bool vp, vn; nbr_valid(r, vp, vn);
        bf16* row = P + (size_t)r * NP;
        const u32x4 zc = {0, 0, 0, 0};
        const u32x4 x0 = *(const u32x4*)(row + C_XBC + c0);
        const u32x4 xp = vp ? *(const u32x4*)(row - NP + C_XBC + c0) : zc, xn = vn ? *(const u32x4*)(row + NP + C_XBC + c0) : zc;
        u32x4 o;
#pragma unroll
        for (int q = 0; q < 4; ++q) { float y[2];
#pragma unroll
            for (int hh = 0; hh < 2; ++hh) { const int c = c0 + 2 * q + hh;
                const float a = hh ? bfhi(xp[q]) : bflo(xp[q]), b_ = hh ? bfhi(x0[q]) : bflo(x0[q]), n_ = hh ? bfhi(xn[q]) : bflo(xn[q]);
                y[hh] = siluf_(cb[c] + cw[c] * a + cw[512 + c] * b_ + cw[1024 + c] * n_); }
            o[q] = pk2(y[0], y[1]); }
        *(u32x4*)(row + (c0 < 256 ? C_XS + c0 : C_BC + (c0 - 256))) = o;
    }
    for (int e = gt; e < R * 8; e += NGT) { float* p = WSP(float, SM_DT) + e; const float x = *p + KA->in[I_DTB][l * 8 + (e & 7)]; *p = x > 15.f ? x : __logf(1.0f + __expf(x)); }
}

template <class Fn>
__device__ __forceinline__ void dyn_tickets_n(Fr& F, unsigned* cnt, int nt, int maxn, Fn fn) {
    volatile LAS int* tk = (volatile LAS int*)(F.lds + MISC_OFF + 512);
    int t_ = F.tid; asm volatile("" : "+v"(t_));
    for (int n = 0; n < maxn; ++n) {
        __syncthreads();
        if (t_ == 0) tk[0] = (int)__hip_atomic_fetch_add(cnt, 1u, __ATOMIC_RELAXED, __HIP_MEMORY_SCOPE_AGENT);
        __syncthreads();
        const int c = __builtin_amdgcn_readfirstlane(tk[0]);
        if (c >= nt) break;
        fn(c);
    }
    __syncthreads();
}
template <class Fn>
__device__ __forceinline__ void dyn_tickets(Fr& F, unsigned* cnt, int nt, Fn fn) {
    volatile LAS int* tk = (volatile LAS int*)(F.lds + MISC_OFF + 512);
    int t_ = F.tid; asm volatile("" : "+v"(t_));
    if (t_ == 0) tk[0] = (int)__hip_atomic_fetch_add(cnt, 1u, __ATOMIC_RELAXED, __HIP_MEMORY_SCOPE_AGENT);
    __syncthreads();
    int c = __builtin_amdgcn_readfirstlane(tk[0]), it = 0;
    while (c < nt) {
        unsigned nxt = 0u; if (t_ == 0) nxt = __hip_atomic_fetch_add(cnt, 1u, __ATOMIC_RELAXED, __HIP_MEMORY_SCOPE_AGENT);
        fn(c);
        ++it; if (t_ == 0) tk[it & 1] = (int)nxt;
        __syncthreads();
        c = __builtin_amdgcn_readfirstlane(tk[it & 1]);
    }
}
__device__ __forceinline__ void moe_convert_tickets(Fr& F, int l, int w2) { KA_DECL;
    unsigned* wq = WSP(unsigned, WS_CTL) + CW_WQ + (8 + l * 2 + w2) * 64;
    __syncthreads();
    dyn_tickets(F, wq, w2 ? 512 : 1024, [&](int c) { moe_convert_item(F, l, (w2 ? 8192 : 0) + 8 * c + F.wave); });
}
__device__ __forceinline__ void conv_a_chunk(Fr& F, int l, int c) { KA_DECL;
    int t_ = F.tid; asm volatile("" : "+v"(t_));
    const int r0 = 64 * c + 4 * (t_ >> 5), c0 = (t_ & 31) * 8, s0 = r0 % RPB;
    const bool vp = (s0 != 0) && (s0 != CTXL), vn = (s0 + 4 != CTXL) && (s0 + 4 != RPB);
    GAS bf16* row = (GAS bf16*)(WSP(bf16, BG_PROJ) + (size_t)r0 * NP + c0);
    const float* cw = KA->in[I_CAW] + l * 3 * 256 + c0; const float* cb = KA->in[I_CAB] + l * 256 + c0;
    const u32x4 zc = {0, 0, 0, 0};
    u32x4 ac[6], ax[6], ab[4];
    ac[0] = vp ? *(const GAS u32x4*)(row - NP + C_AC) : zc; ax[0] = vp ? *(const GAS u32x4*)(row - NP + C_AX) : zc;
#pragma unroll
    for (int i = 0; i < 4; ++i) { ac[i + 1] = *(const GAS u32x4*)(row + (size_t)i * NP + C_AC); ax[i + 1] = *(const GAS u32x4*)(row + (size_t)i * NP + C_AX); ab[i] = *(const GAS u32x4*)(row + (size_t)i * NP + C_AB); }
    ac[5] = vn ? *(const GAS u32x4*)(row + (size_t)4 * NP + C_AC) : zc; ax[5] = vn ? *(const GAS u32x4*)(row + (size_t)4 * NP + C_AX) : zc;
    float wb[8], w0[8], w1[8], w2[8];
#pragma unroll
    for (int j = 0; j < 8; j += 4) { const f32x4 a = *(const f32x4*)(cb + j), b = *(const f32x4*)(cw + j), d = *(const f32x4*)(cw + 256 + j), e = *(const f32x4*)(cw + 512 + j);
#pragma unroll
        for (int i = 0; i < 4; ++i) { wb[j + i] = a[i]; w0[j + i] = b[i]; w1[j + i] = d[i]; w2[j + i] = e[i]; } }
    float u[6][8];
#pragma unroll
    for (int i = 0; i < 6; ++i)
#pragma unroll
        for (int q = 0; q < 4; ++q) { u[i][2 * q] = bflo(ac[i][q]) * bflo(ax[i][q]); u[i][2 * q + 1] = bfhi(ac[i][q]) * bfhi(ax[i][q]); }
#pragma unroll
    for (int i = 0; i < 4; ++i) { u32x4 o;
#pragma unroll
        for (int q = 0; q < 4; ++q) { const int j = 2 * q;
            const float y0 = bflo(ab[i][q]) * (wb[j] + w0[j] * u[i][j] + w1[j] * u[i + 1][j] + w2[j] * u[i + 2][j]);
            const float y1 = bfhi(ab[i][q]) * (wb[j + 1] + w0[j + 1] * u[i][j + 1] + w1[j + 1] * u[i + 1][j + 1] + w2[j + 1] * u[i + 2][j + 1]);
            o[q] = pk2(y0, y1); }
        *(GAS u32x4*)(row + (size_t)i * NP + C_AB) = o; }
}
__device__ __forceinline__ void conv_xbc_chunk(Fr& F, int l, int c) { KA_DECL;
    int t_ = F.tid; asm volatile("" : "+v"(t_));
    const int r0 = 64 * c + 8 * (t_ >> 6), c0 = (t_ & 63) * 8, s0 = r0 % RPB;
    const bool vp = (s0 != 0) && (s0 != CTXL), vn = (s0 + 8 != CTXL) && (s0 + 8 != RPB);
    GAS bf16* row = (GAS bf16*)(WSP(bf16, BG_PROJ) + (size_t)r0 * NP);
    const float* cw = KA->in[I_SCW] + l * 3 * 512 + c0; const float* cb = KA->in[I_SCB] + l * 512 + c0;
    const u32x4 zc = {0, 0, 0, 0};
    u32x4 x[10];
    x[0] = vp ? *(const GAS u32x4*)(row - NP + C_XBC + c0) : zc;
#pragma unroll
    for (int i = 0; i < 8; ++i) x[i + 1] = *(const GAS u32x4*)(row + (size_t)i * NP + C_XBC + c0);
    x[9] = vn ? *(const GAS u32x4*)(row + (size_t)8 * NP + C_XBC + c0) : zc;
    {   float* p = WSP(float, SM_DT) + (size_t)c * 512 + t_; const float xx = *p + KA->in[I_DTB][l * 8 + (t_ & 7)]; *p = xx > 15.f ? xx : __logf(1.0f + __expf(xx)); }
    float wb[8], w0[8], w1[8], w2[8];
#pragma unroll
    for (int j = 0; j < 8; j += 4) { const f32x4 a = *(const f32x4*)(cb + j), b = *(const f32x4*)(cw + j), d = *(const f32x4*)(cw + 512 + j), e = *(const f32x4*)(cw + 1024 + j);
#pragma unroll
        for (int i = 0; i < 4; ++i) { wb[j + i] = a[i]; w0[j + i] = b[i]; w1[j + i] = d[i]; w2[j + i] = e[i]; } }
    const int oc = c0 < 256 ? C_XS + c0 : C_BC + (c0 - 256);
#pragma unroll
    for (int i = 0; i < 8; ++i) { u32x4 o;
#pragma unroll
        for (int q = 0; q < 4; ++q) { const int j = 2 * q;
            const float y0 = siluf_(wb[j] + w0[j] * bflo(x[i][q]) + w1[j] * bflo(x[i + 1][q]) + w2[j] * bflo(x[i + 2][q]));
            const float y1 = siluf_(wb[j + 1] + w0[j + 1] * bfhi(x[i][q]) + w1[j + 1] * bfhi(x[i + 1][q]) + w2[j + 1] * bfhi(x[i + 2][q]));
            o[q] = pk2(y0, y1); }
        *(GAS u32x4*)(row + (size_t)i * NP + oc) = o; }
}

template <int MIX  , bool OUT>
__device__ __forceinline__ void span_task(Fr& F, int l, int span) { KA_DECL;
    const int b = span / SPB, sp = span - b * SPB, row0 = b * RPB + sp * 64;
    const int w = F.wave, h = w >> 1, dir = w & 1, lane = F.lane, g = h >> 1;
    bf16* P = WSP(bf16, BG_PROJ) + (size_t)row0 * NP;
    const float* DT = WSP(const float, SM_DT) + (size_t)row0 * 8 + dir * 4 + h;
    float* STp = WSP(float, BG_ST) + ((size_t)((b * 8 + w) * SPB + sp)) * 4096 + lane;
    LAS float* E = (LAS float*)F.lds;
    LAS float* SSQ = (LAS float*)(F.lds + 65536);
    float S[64];
    if (OUT) {
#pragma unroll
        for (int k = 0; k < 64; ++k) S[k] = STp[k * 64];
    } else {
#pragma unroll
        for (int k = 0; k < 64; ++k) S[k] = 0.f;
    }
    float lb = 0.f, dtb = 0.f, Aexp = 0.f, Dh = 0.f;
    if (MIX == 0) { if (l > 0) { const float a0 = KA->in[I_HLB][(dir * DEPTH + 0) * 256 + h * 64 + lane], a1 = KA->in[I_HLB][(dir * DEPTH + l) * 256 + h * 64 + lane]; lb = 1.0f / (1.0f + __expf(a0 - a1)); } }
    else { dtb = KA->in[I_DTB][(l * 2 + dir) * 4 + h]; Aexp = __expf(KA->in[I_ALOG][(l * 2 + dir) * 4 + h]); Dh = KA->in[I_SD][l * 4 + h]; }
    const float oml = 1.0f - lb;
    float dec = 1.0f;
    const int c1 = MIX == 0 ? C_FF + dir * 256 + h * 64 + lane : C_XS + h * 64 + lane;
    const int c2 = MIX == 0 ? C_I + h * 64 + lane : C_BC + g * 64 + lane;
    const int c3 = MIX == 0 ? C_Q + h * 64 + lane : C_BC + 128 + g * 64 + lane;
    const int c4 = C_Z + h * 64 + lane;
    constexpr int BS = (MIX == 1 && OUT) ? 4 : 8;
    unsigned short n1[BS], n2[BS], n3[BS], n4[BS]; float ndt[BS];
    unsigned short r1[BS], r2[BS], r3[BS], r4[BS]; float rdt[BS];
#pragma unroll
    for (int s_ = 0; s_ < BS; ++s_) { n1[s_] = 0; n2[s_] = 0; n3[s_] = 0; n4[s_] = 0; ndt[s_] = 0.f; }
    const int tstep = dir ? -1 : 1, t0 = dir ? 63 : 0;
#define SP_LOAD(blk) do { const bf16* rb_ = P + (long)(t0 + (blk) * BS * tstep) * NP; const float* db_ = DT + (long)(t0 + (blk) * BS * tstep) * 8; asm volatile("" : "+v"(rb_), "+v"(db_)); \
        _Pragma("unroll") for (int s_ = 0; s_ < BS; ++s_) { const bf16* rp_ = rb_ + (long)(s_ * tstep) * NP; \
        n1[s_] = rp_[c1]; n2[s_] = rp_[c2]; if (OUT || MIX == 1) n3[s_] = rp_[c3]; if (MIX == 1) { ndt[s_] = db_[(long)(s_ * tstep) * 8]; if (OUT) n4[s_] = rp_[c4]; } } } while (0)
    SP_LOAD(0);
    for (int blk = 0; blk < 64 / BS; ++blk) {
#pragma unroll
        for (int s_ = 0; s_ < BS; ++s_) { r1[s_] = n1[s_]; r2[s_] = n2[s_]; r3[s_] = n3[s_]; r4[s_] = n4[s_]; rdt[s_] = ndt[s_]; }
        if (blk < 64 / BS - 1) SP_LOAD(blk + 1);
        if (OUT && blk == 32 / BS) __syncthreads();
#pragma unroll
        for (int s = 0; s < BS; ++s) {
            const int i = blk * BS + s; const int tt = dir ? 63 - i : i;
            float o = 0.f, xv = 0.f;
            if (MIX == 0) {
                const float fr_ = bf2f(r1[s]), vv = bf2f(r2[s]);
                const float sg = sigmoidf_(fr_), fg = lb + oml * sg;
                float qq = 0.f; if (OUT) { const float qr = bf2f(r3[s]); qq = siluf_(qr); }
                dec *= fg;
                int fgi = __builtin_bit_cast(int, fg), qqi = __builtin_bit_cast(int, qq);
#pragma unroll
                for (int k = 0; k < 64; ++k) { const float f_ = __builtin_bit_cast(float, __builtin_amdgcn_readlane(fgi, k));
                    S[k] = vv + f_ * (S[k] - vv);
                    if (OUT) { const float q_ = __builtin_bit_cast(float, __builtin_amdgcn_readlane(qqi, k)); o += q_ * S[k]; }
                    if ((k & 7) == 7) asm volatile("" : "+v"(fgi), "+v"(qqi), "+v"(S[k - 7]), "+v"(S[k - 6]), "+v"(S[k - 5]), "+v"(S[k - 4]), "+v"(S[k - 3]), "+v"(S[k - 2]), "+v"(S[k - 1]), "+v"(S[k])); }
            } else {
                xv = bf2f(r1[s]); const float Bv = bf2f(r2[s]), Cv = bf2f(r3[s]);
                const float dt = softplusf_(rdt[s] + dtb), a = __expf(-dt * Aexp), bdt = Bv * dt;
                dec *= a;
                int bdi = __builtin_bit_cast(int, bdt), cvi = __builtin_bit_cast(int, Cv);
#pragma unroll
                for (int k = 0; k < 64; ++k) { const float b_ = __builtin_bit_cast(float, __builtin_amdgcn_readlane(bdi, k));
                    S[k] = a * S[k] + b_ * xv;
                    if (OUT) { const float c_ = __builtin_bit_cast(float, __builtin_amdgcn_readlane(cvi, k)); o += c_ * S[k]; }
                    if ((k & 7) == 7) asm volatile("" : "+v"(bdi), "+v"(cvi), "+v"(S[k - 7]), "+v"(S[k - 6]), "+v"(S[k - 5]), "+v"(S[k - 4]), "+v"(S[k - 3]), "+v"(S[k - 2]), "+v"(S[k - 1]), "+v"(S[k])); }
            }
            if (OUT) {
                if (i < 32) E[(w * 32 + i) * 64 + lane] = o;
                else { LAS float* slot = E + ((w ^ 1) * 32 + (63 - i)) * 64 + lane;
                    float tot = o + *slot;
                    if (MIX == 1) { const float z = bf2f(r4[s]); tot = (tot + Dh * xv) * siluf_(z); }
                    const float q2 = wave_sum(tot * tot);
                    if (lane == 0) SSQ[h * 64 + tt] = q2;
                    *slot = tot; }
            }
        }
    }
#undef SP_LOAD
    if (!OUT) {
#pragma unroll
        for (int k = 0; k < 64; ++k) STp[k * 64] = S[k];
        WSP(float, SM_DEC)[((size_t)((b * 8 + w) * SPB + sp)) * 64 + lane] = dec;
    } else {
        __syncthreads();
        const float* nwp = MIX == 0 ? KA->in[I_HNW] + l * 64 : KA->in[I_SNW] + l * 256;
        const float nwc = MIX == 0 ? nwp[F.tid & 63] : nwp[F.tid & 255];
#pragma unroll 4
        for (int it = 0; it < 32; ++it) { const int e = it * 512 + F.tid, tt = e >> 8, ch = e & 255, hh = ch >> 6, dv = ch & 63;
            const float v = tt < 32 ? E[((2 * hh) * 32 + tt) * 64 + dv] : E[((2 * hh + 1) * 32 + (63 - tt)) * 64 + dv];
            float y;
            if (MIX == 0) { const float rs = 1.0f / sqrtf(SSQ[hh * 64 + tt] * (1.f / 64.f) + EPS); const float gr = bf2f(P[(size_t)tt * NP + C_G + ch]); y = v * rs * nwc * siluf_(gr); }
            else { const int g2 = hh >> 1; const float rs = 1.0f / sqrtf((SSQ[(2 * g2) * 64 + tt] + SSQ[(2 * g2 + 1) * 64 + tt]) * (1.f / 128.f) + EPS); y = v * rs * nwc; }
            P[(size_t)tt * NP + (MIX == 0 ? C_Q : C_Z) + ch] = (bf16)f2bf(y); }
        __syncthreads();
    }
}
__device__ __forceinline__ bf16x8 pack8(float a0, float a1, float a2, float a3, float a4, float a5, float a6, float a7) {
    u32x4 w; w.x = pk2(a0, a1); w.y = pk2(a2, a3); w.z = pk2(a4, a5); w.w = pk2(a6, a7); return __builtin_bit_cast(bf16x8, w); }
template <int MIX  , bool OUT>
__device__ __forceinline__ void span_task_mfma(Fr& F, int l, int span) { KA_DECL;
    const int b = span / SPB, sp = span - b * SPB, row0 = b * RPB + sp * 64;
    const int w = F.wave, h = w >> 1, dir = w & 1, lane = F.lane, g = h >> 1, gq = lane >> 4, li = lane & 15;
    bf16* P = WSP(bf16, BG_PROJ) + (size_t)row0 * NP;
    const float* DT = WSP(const float, SM_DT) + (size_t)row0 * 8 + dir * 4 + h;
    bf16* STb = WSP(bf16, MIX ? BG_ST2 : BG_ST) + ((size_t)((b * 8 + w) * SPB + sp)) * 4096;
    LAS float* E = (LAS float*)F.lds;
    LAS float* SSQ = (LAS float*)(F.lds + 65536);
    LAS unsigned char* WL = F.lds + 66560 + w * 8960;
    LAS bf16* QT = (LAS bf16*)WL; LAS bf16* KT = (LAS bf16*)(WL + 2304); LAS bf16* KH = (LAS bf16*)(WL + 4608); LAS bf16* VT = (LAS bf16*)(WL + 6656); LAS float* DV = (LAS float*)(WL + 8704);
    f32x4 S[4][4];
#pragma unroll
    for (int kb = 0; kb < 4; ++kb)
#pragma unroll
        for (int m = 0; m < 4; ++m)
#pragma unroll
            for (int r = 0; r < 4; ++r) S[kb][m][r] = 0.f;
    if (OUT) {
#pragma unroll
        for (int kb = 0; kb < 4; ++kb)
#pragma unroll
            for (int m = 0; m < 4; ++m) { const u32x2 s2 = *(const u32x2*)(STb + ((kb * 4 + m) * 64 + lane) * 4); S[kb][m] = (f32x4){bflo(s2.x), bfhi(s2.x), bflo(s2.y), bfhi(s2.y)}; } }
    float lb = 0.f, dtb = 0.f, Aexp = 0.f, Dh = 0.f;
    if (MIX == 0) { if (l > 0) { const float a0 = KA->in[I_HLB][(dir * DEPTH + 0) * 256 + h * 64 + lane], a1 = KA->in[I_HLB][(dir * DEPTH + l) * 256 + h * 64 + lane]; lb = 1.0f / (1.0f + __expf(a0 - a1)); } }
    else { dtb = KA->in[I_DTB][(l * 2 + dir) * 4 + h]; Aexp = __expf(KA->in[I_ALOG][(l * 2 + dir) * 4 + h]); Dh = KA->in[I_SD][l * 4 + h]; }
    const float oml = 1.0f - lb;
    float dtot = 1.0f;
    const int c1 = MIX == 0 ? C_FF + dir * 256 + h * 64 + lane : C_XS + h * 64 + lane;
    const int c2 = MIX == 0 ? C_I + h * 64 + lane : C_BC + g * 64 + lane;
    const int c3 = MIX == 0 ? C_Q + h * 64 + lane : C_BC + 128 + g * 64 + lane;
    const int tstep = dir ? -1 : 1, t0 = dir ? 63 : 0;
    unsigned short n1[16], n2[16], n3[16]; float ndt[16];
#pragma unroll
    for (int i = 0; i < 16; ++i) { n1[i] = 0; n2[i] = 0; n3[i] = 0; ndt[i] = 0.f; }
#define SM_LOAD(c) do { unsigned long long rbi_ = (unsigned long long)(P + (long)(t0 + (c) * 16 * tstep) * NP), dbi_ = (unsigned long long)(DT + (long)(t0 + (c) * 16 * tstep) * 8); asm volatile("" : "+v"(rbi_), "+v"(dbi_)); \
        const GAS bf16* rb_ = (const GAS bf16*)rbi_; const GAS float* db_ = (const GAS float*)dbi_;     \
        _Pragma("unroll") for (int i_ = 0; i_ < 16; ++i_) { const GAS bf16* rp_ = rb_ + (long)(i_ * tstep) * NP; n1[i_] = rp_[c1]; n2[i_] = rp_[c2]; if (OUT || MIX == 1) n3[i_] = rp_[c3]; if (MIX == 1) ndt[i_] = db_[(long)(i_ * tstep) * 8]; } } while (0)
    constexpr bool PF = !(MIX == 1 && OUT);
    if (PF) SM_LOAD(0);
    for (int c = 0; c < 4; ++c) {
        if (!PF) SM_LOAD(c);
#define r1 n1
#define r2 n2
#define r3 n3
#define rdt ndt
        if (OUT && c == 2) __syncthreads();
        float cl = 0.f, clv[16], kkv[16];
#pragma unroll
        for (int i = 0; i < 16; ++i) { float lf, kk, qq = 0.f;
            if (MIX == 0) { const float fr_ = bf2f(r1[i]); const float sg = sigmoidf_(fr_), fg = lb + oml * sg; lf = __logf(fg); kk = 1.0f - fg; if (OUT) qq = siluf_(bf2f(r3[i])); }
            else { const float dt = rdt[i]; lf = -dt * Aexp; kk = bf2f(r2[i]) * dt; qq = bf2f(r3[i]); }
            cl += lf; clv[i] = cl; kkv[i] = kk;
            if (OUT) { QT[i * 72 + lane] = (bf16)f2bf(qq * __expf(cl)); KT[i * 72 + lane] = (bf16)f2bf(kk * __expf(fminf(-cl, 60.f))); } }
        {   float kh[16];
#pragma unroll
            for (int i = 0; i < 16; ++i) kh[i] = kkv[i] * __expf(cl - clv[i]);
            *(LAS bf16x8*)(KH + lane * 16) = pack8(kh[0], kh[1], kh[2], kh[3], kh[4], kh[5], kh[6], kh[7]); *(LAS bf16x8*)(KH + lane * 16 + 8) = pack8(kh[8], kh[9], kh[10], kh[11], kh[12], kh[13], kh[14], kh[15]);
            u32x4 v0, v1;
#define VR(i) ((unsigned)(MIX == 0 ? r2[i] : r1[i]))
            v0.x = VR(0) | (VR(1) << 16); v0.y = VR(2) | (VR(3) << 16); v0.z = VR(4) | (VR(5) << 16); v0.w = VR(6) | (VR(7) << 16);
            v1.x = VR(8) | (VR(9) << 16); v1.y = VR(10) | (VR(11) << 16); v1.z = VR(12) | (VR(13) << 16); v1.w = VR(14) | (VR(15) << 16);
#undef VR
            *(LAS u32x4*)(VT + lane * 16) = v0; *(LAS u32x4*)(VT + lane * 16 + 8) = v1;
            const float Dd = __expf(cl); DV[lane] = Dd; dtot *= Dd; }
#undef r1
#undef r2
#undef r3
#undef rdt
        if (PF && c < 3) SM_LOAD(c + 1);
        LDS_WAIT(); asm volatile("" ::: "memory");
        if (OUT) {
            const int tau = 16 * c + li, tt = dir ? 63 - tau : tau;
            u32x2 fx[4], fz[4];
#pragma unroll
            for (int m = 0; m < 4; ++m) { fx[m] = (u32x2){0u, 0u}; fz[m] = (u32x2){0u, 0u}; }
            if (c >= 2) { const GAS bf16* Pg = (const GAS bf16*)P + (size_t)tt * NP + h * 64 + 4 * gq;
#pragma unroll
                for (int m = 0; m < 4; ++m) { if (MIX == 1) { fx[m] = *(const GAS u32x2*)(Pg + C_XS + 16 * m); fz[m] = *(const GAS u32x2*)(Pg + C_Z + 16 * m); } else fx[m] = *(const GAS u32x2*)(Pg + C_G + 16 * m); } }
            f32x4 Pm = {0.f, 0.f, 0.f, 0.f};
#pragma unroll
            for (int ks = 0; ks < 2; ++ks) Pm = __builtin_amdgcn_mfma_f32_16x16x32_bf16(*(const LAS bf16x8*)(KT + li * 72 + 32 * ks + 8 * gq), *(const LAS bf16x8*)(QT + li * 72 + 32 * ks + 8 * gq), Pm, 0, 0, 0);
#pragma unroll
            for (int r = 0; r < 4; ++r) if (4 * gq + r > li) Pm[r] = 0.f;
            const bf16x8 pb = pack8(Pm[0], Pm[1], Pm[2], Pm[3], 0.f, 0.f, 0.f, 0.f);
            f32x4 oT[4];
#pragma unroll
            for (int m = 0; m < 4; ++m) { const u32x2 vv = *(const LAS u32x2*)(VT + (16 * m + li) * 16 + 4 * gq); const u32x4 av = {vv.x, vv.y, 0u, 0u};
                oT[m] = __builtin_amdgcn_mfma_f32_16x16x32_bf16(__builtin_bit_cast(bf16x8, av), pb, (f32x4){0.f, 0.f, 0.f, 0.f}, 0, 0, 0); }
#pragma unroll
            for (int ks = 0; ks < 2; ++ks) { const u32x2 q0 = *(const LAS u32x2*)(QT + li * 72 + 32 * ks + 4 * gq), q1 = *(const LAS u32x2*)(QT + li * 72 + 32 * ks + 16 + 4 * gq); const u32x4 bq = {q0.x, q0.y, q1.x, q1.y};
#pragma unroll
                for (int m = 0; m < 4; ++m) { const f32x4 s0 = S[2 * ks][m], s1 = S[2 * ks + 1][m];
                    oT[m] = __builtin_amdgcn_mfma_f32_16x16x32_bf16(pack8(s0[0], s0[1], s0[2], s0[3], s1[0], s1[1], s1[2], s1[3]), __builtin_bit_cast(bf16x8, bq), oT[m], 0, 0, 0); } }
            if (c < 2) {
#pragma unroll
                for (int m = 0; m < 4; ++m) *(LAS f32x4*)(E + (w * 32 + tau) * 64 + 4 * (((4 * m + gq) ^ tau) & 15)) = oT[m];
            } else { float q2 = 0.f;
#pragma unroll
                for (int m = 0; m < 4; ++m) { LAS f32x4* slot = (LAS f32x4*)(E + ((w ^ 1) * 32 + (63 - tau)) * 64 + 4 * (((4 * m + gq) ^ (63 - tau)) & 15));
                    f32x4 tot = oT[m] + *slot;
                    if (MIX == 1) { const u32x2 xx = fx[m], zz = fz[m];
                        const f32x4 xv = {bflo(xx.x), bfhi(xx.x), bflo(xx.y), bfhi(xx.y)}; const f32x4 zv = {bflo(zz.x), bfhi(zz.x), bflo(zz.y), bfhi(zz.y)};
                        tot = tot + xv * Dh; tot.x *= siluf_(zv.x); tot.y *= siluf_(zv.y); tot.z *= siluf_(zv.z); tot.w *= siluf_(zv.w); }
                    q2 += (tot.x * tot.x + tot.y * tot.y) + (tot.z * tot.z + tot.w * tot.w);
                    *slot = tot; }
                q2 += __shfl_xor(q2, 16); q2 += __shfl_xor(q2, 32);
                if (MIX == 1) { if (gq == 0) SSQ[h * 64 + tt] = q2; }
                else {
                    const float rs = 1.0f / sqrtf(q2 * (1.f / 64.f) + EPS); const float* nwp = KA->in[I_HNW] + l * 64;
#pragma unroll
                    for (int m = 0; m < 4; ++m) { LAS f32x4* slot = (LAS f32x4*)(E + ((w ^ 1) * 32 + (63 - tau)) * 64 + 4 * (((4 * m + gq) ^ (63 - tau)) & 15));
                        const f32x4 tot = *slot; const u32x2 gg = fx[m]; const f32x4 nw4 = *(const f32x4*)(nwp + 16 * m + 4 * gq);
                        const f32x4 gv = {bflo(gg.x), bfhi(gg.x), bflo(gg.y), bfhi(gg.y)};
                        u32x2 o; o.x = pk2(tot.x * rs * nw4.x * siluf_(gv.x), tot.y * rs * nw4.y * siluf_(gv.y)); o.y = pk2(tot.z * rs * nw4.z * siluf_(gv.z), tot.w * rs * nw4.w * siluf_(gv.w));
                        *(u32x2*)(P + (size_t)tt * NP + C_Q + h * 64 + 16 * m + 4 * gq) = o; } } }
        }
        if (!OUT || c < 3) {
#pragma unroll
            for (int kb = 0; kb < 4; ++kb) { const f32x4 dd = *(const LAS f32x4*)(DV + 16 * kb + 4 * gq);
                const u32x4 z4 = {0u, 0u, 0u, 0u};
                const bf16x8 ak = gq < 2 ? *(const LAS bf16x8*)(KH + (16 * kb + li) * 16 + 8 * gq) : __builtin_bit_cast(bf16x8, z4);
#pragma unroll
                for (int m = 0; m < 4; ++m) { const bf16x8 bv = gq < 2 ? *(const LAS bf16x8*)(VT + (16 * m + li) * 16 + 8 * gq) : __builtin_bit_cast(bf16x8, z4);
                    S[kb][m] = __builtin_amdgcn_mfma_f32_16x16x32_bf16(ak, bv, S[kb][m] * dd, 0, 0, 0); } }
        }
        LDS_WAIT(); asm volatile("" ::: "memory");
    }
#undef SM_LOAD
    if (!OUT) {
#pragma unroll
        for (int kb = 0; kb < 4; ++kb)
#pragma unroll
            for (int m = 0; m < 4; ++m) { u32x2 s2; s2.x = pk2(S[kb][m][0], S[kb][m][1]); s2.y = pk2(S[kb][m][2], S[kb][m][3]); *(u32x2*)(STb + ((kb * 4 + m) * 64 + lane) * 4) = s2; }
        WSP(float, MIX ? SM_DEC2 : SM_DEC)[((size_t)((b * 8 + w) * SPB + sp)) * 64 + lane] = dtot;
    } else if (MIX == 0) { __syncthreads(); }
    else {
        __syncthreads();
        const float* nwp = MIX == 0 ? KA->in[I_HNW] + l * 64 : KA->in[I_SNW] + l * 256;
#pragma unroll 4
        for (int it = 0; it < 32; ++it) { const int e = it * 512 + F.tid, tt = e >> 8, ch = e & 255, hh = ch >> 6, dv = ch & 63;
            const int sl = tt < 32 ? tt : 63 - tt; const float v = E[((2 * hh + (tt < 32 ? 0 : 1)) * 32 + sl) * 64 + 4 * (((dv >> 2) ^ sl) & 15) + (dv & 3)];
            float y;
            if (MIX == 0) { const float rs = 1.0f / sqrtf(SSQ[hh * 64 + tt] * (1.f / 64.f) + EPS); const float gr = bf2f(P[(size_t)tt * NP + C_G + ch]); y = v * rs * nwp[dv] * siluf_(gr); }
            else { const int g2 = hh >> 1; const float rs = 1.0f / sqrtf((SSQ[(2 * g2) * 64 + tt] + SSQ[(2 * g2 + 1) * 64 + tt]) * (1.f / 128.f) + EPS); y = v * rs * nwp[ch]; }
            P[(size_t)tt * NP + (MIX == 0 ? C_Q : C_Z) + ch] = (bf16)f2bf(y); }
        __syncthreads();
    }
}
__device__ __forceinline__ void state_scan(Fr& F, int mix) { KA_DECL;
    for (int e = F.bid * 512 + F.tid; e < NB * 8 * 2048; e += F.G * 512) {
    const int bh = e >> 11, ip = e & 2047, idx = 2 * ip, dk = 16 * (idx >> 10) + 4 * ((idx >> 6) & 3) + (idx & 3), dir = bh & 1;
    unsigned* ST = (unsigned*)(KA->ws + (mix ? BG_ST2 : BG_ST)) + (size_t)bh * SPB * 2048 + ip; const float* DC = (const float*)(KA->ws + (mix ? SM_DEC2 : SM_DEC)) + (size_t)bh * SPB * 64 + dk;
    float st0 = 0.f, st1 = 0.f;
    const GAS unsigned* STg = (const GAS unsigned*)ST; const GAS float* DCg = (const GAS float*)DC;
    unsigned nl[12]; f32x2 nd[12];
#pragma unroll
    for (int j = 0; j < 12; ++j) { const int sx = dir ? (j < 4 ? 3 - j : 135 - j) : j; nl[j] = STg[(size_t)sx * 2048]; nd[j] = *(const GAS f32x2*)(DCg + sx * 64); }
    for (int p0 = 0; p0 < SPB; p0 += 12) {
        unsigned loc[12]; f32x2 d[12];
#pragma unroll
        for (int j = 0; j < 12; ++j) { loc[j] = nl[j]; d[j] = nd[j]; }
        if (p0 + 12 < SPB) {
#pragma unroll
            for (int j = 0; j < 12; ++j) { const int p = p0 + 12 + j, sx = dir ? (p < 4 ? 3 - p : 135 - p) : p; nl[j] = STg[(size_t)sx * 2048]; nd[j] = *(const GAS f32x2*)(DCg + sx * 64); } }
#pragma unroll
        for (int j = 0; j < 12; ++j) { const int p = p0 + j, sx = dir ? (p < 4 ? 3 - p : 135 - p) : p; if (DBG_NOCTX && p == 4) { st0 = 0.f; st1 = 0.f; }
            ST[(size_t)sx * 2048] = pk2(st0, st1); st0 = d[j].x * st0 + bflo(loc[j]); st1 = d[j].y * st1 + bfhi(loc[j]); }
    }
    }
}

__device__ __forceinline__ void lds_load_f32(Fr& F, const float* src, int n) {
    __syncthreads();
    int t_ = F.tid; asm volatile("" : "+v"(t_));
    for (int e = t_ * 4; e < n; e += 2048) *(LAS f32x4*)((LAS float*)F.lds + e) = *(const f32x4*)(src + e);
    __syncthreads();
}
constexpr int FFT_MAT = 69632;
template <int K>
__device__ __forceinline__ void lds_load_mat(Fr& F, const bf16* src) {
    __syncthreads();
    int t_ = F.tid; asm volatile("" : "+v"(t_));
    for (int c = t_; c < 128 * (K / 8); c += 512) { const int row = c / (K / 8), cc = c % (K / 8);
        *(LAS u32x4*)(F.lds + FFT_MAT + row * (K * 2 + 16) + cc * 16) = *(const u32x4*)(src + (size_t)row * K + cc * 8); }
    __syncthreads();
}
template <int STRIDE>
__device__ __forceinline__ bf16x8 fft_bop(const LAS unsigned short* dp) {
    u32x4 q;
    q.x = (unsigned)dp[0] | ((unsigned)dp[STRIDE / 2] << 16); q.y = (unsigned)dp[2 * (STRIDE / 2)] | ((unsigned)dp[3 * (STRIDE / 2)] << 16);
    q.z = (unsigned)dp[4 * (STRIDE / 2)] | ((unsigned)dp[5 * (STRIDE / 2)] << 16); q.w = (unsigned)dp[6 * (STRIDE / 2)] | ((unsigned)dp[7 * (STRIDE / 2)] << 16);
    return __builtin_bit_cast(bf16x8, q);
}
__device__ __forceinline__ void fft_stage_a(Fr& F, int unit) { KA_DECL;
    int t_ = F.tid; asm volatile("" : "+v"(t_));
    const int b = unit >> 7, t2 = unit & 127, lane = t_ & 63, w = __builtin_amdgcn_readfirstlane(t_ >> 6), n = lane & 31, ch = 32 * w + n, kh = lane >> 5;
    {   const GAS bf16* U = (const GAS bf16*)(WSP(const bf16, BG_PROJ) + ((size_t)b * RPB + CTXL + t2) * NP + C_UR);
        u32x4 v[8];
#pragma unroll
        for (int q = 0; q < 8; ++q) { const int c = t_ + 512 * q, k = c >> 5, cc = c & 31; v[q] = *(const GAS u32x4*)(U + (size_t)(128 * (k & 63)) * NP + (k >> 6) * 256 + cc * 8); }
        __syncthreads();
#pragma unroll
        for (int q = 0; q < 8; ++q) { const int c = t_ + 512 * q, k = c >> 5, cc = c & 31; *(LAS u32x4*)(F.lds + k * 528 + cc * 16) = v[q]; }
        __syncthreads(); }
    f32x16 acc[4];
#pragma unroll
    for (int m = 0; m < 4; ++m)
#pragma unroll
        for (int q = 0; q < 16; ++q) acc[m][q] = 0.f;
    const LAS unsigned short* dp = (const LAS unsigned short*)(F.lds + (8 * kh) * 528 + ch * 2);
    const LAS char* mp = (const LAS char*)(F.lds + FFT_MAT + n * 272 + 16 * kh);
#pragma unroll 2
    for (int s = 0; s < 8; ++s) { const bf16x8 bq = fft_bop<528>(dp + s * (16 * 264));
#pragma unroll
        for (int m = 0; m < 4; ++m) acc[m] = __builtin_amdgcn_mfma_f32_32x32x16_bf16(*(const LAS bf16x8*)(mp + (32 * m) * 272 + 32 * s), bq, acc[m], 0, 0, 0); }
    bf16* AP = WSP(bf16, BG_AP) + (size_t)b * 64 * 2 * 128 * 256;
    const float* TW = WSP(const float, SM_TW) + (size_t)t2 * 128;
#pragma unroll
    for (int m = 0; m < 2; ++m)
#pragma unroll
        for (int q = 0; q < 16; ++q) { const int k1 = 32 * m + (q & 3) + 8 * (q >> 2) + 4 * kh; const float c = TW[2 * k1], s = TW[2 * k1 + 1];
            const float ar = acc[m][q], ai = acc[m + 2][q];
            bf16* dst = AP + ((size_t)(k1 * 2) * 128 + t2) * 256 + ch;
            dst[0] = (bf16)f2bf(ar * c + ai * s); dst[128 * 256] = (bf16)f2bf(ai * c - ar * s); }
}
__device__ __forceinline__ void fft_stage_b(Fr& F, int unit) { KA_DECL;
    int t_ = F.tid; asm volatile("" : "+v"(t_));
    const int chh = unit & 1, k1 = (unit >> 1) & 63, b = unit >> 7, lane = t_ & 63, w = __builtin_amdgcn_readfirstlane(t_ >> 6), n = lane & 31, kh = lane >> 5, cbk = w & 3, mh = w >> 2;
    {   const GAS bf16* AP = (const GAS bf16*)(WSP(const bf16, BG_AP) + ((size_t)(b * 64 + k1) * 2) * 128 * 256 + chh * 128);
        u32x4 v[8];
#pragma unroll
        for (int q = 0; q < 8; ++q) { const int c = t_ + 512 * q, k = c >> 4, cc = c & 15; v[q] = *(const GAS u32x4*)(AP + (size_t)k * 256 + cc * 8); }
        __syncthreads();
#pragma unroll
        for (int q = 0; q < 8; ++q) { const int c = t_ + 512 * q, k = c >> 4, cc = c & 15; *(LAS u32x4*)(F.lds + k * 272 + cc * 16) = v[q]; }
        __syncthreads(); }
    f32x16 acc[2];
#pragma unroll
    for (int m = 0; m < 2; ++m)
#pragma unroll
        for (int q = 0; q < 16; ++q) acc[m][q] = 0.f;
    const LAS unsigned short* dp = (const LAS unsigned short*)(F.lds + (8 * kh) * 272 + (32 * cbk + n) * 2);
    const LAS char* mp = (const LAS char*)(F.lds + FFT_MAT + (64 * mh + n) * 528 + 16 * kh);
#pragma unroll 2
    for (int s = 0; s < 16; ++s) { const bf16x8 bq = fft_bop<272>(dp + s * (16 * 136));
#pragma unroll
        for (int m = 0; m < 2; ++m) acc[m] = __builtin_amdgcn_mfma_f32_32x32x16_bf16(*(const LAS bf16x8*)(mp + (32 * m) * 528 + 32 * s), bq, acc[m], 0, 0, 0); }
    bf16* P = WSP(bf16, BG_PROJ) + ((size_t)b * RPB + CTXL + k1) * NP + C_UR + chh * 128 + 32 * cbk + n;
    const float scale = 0.001381067932f;
#pragma unroll
    for (int m = 0; m < 2; ++m)
#pragma unroll
        for (int q = 0; q < 16; ++q) { const int k2 = 64 * mh + 32 * m + (q & 3) + 8 * (q >> 2) + 4 * kh; P[(size_t)(64 * k2) * NP] = (bf16)f2bf(acc[m][q] * scale); }
}
__device__ __forceinline__ void fft_ctx(Fr& F, int unit) { KA_DECL;
    const int b = unit >> 2, mq = unit & 3, lane = F.lane, w = F.wave, ch = 32 * w + (lane & 31), kh = lane >> 5;
    const bf16* U = WSP(const bf16, BG_PROJ) + ((size_t)b * RPB) * NP + C_UR + ch;
    const float* M3 = WSP(const float, SM_M3) + 64 * mq + (lane & 31);
    f32x16 acc[2];
#pragma unroll
    for (int m = 0; m < 2; ++m)
#pragma unroll
        for (int q = 0; q < 16; ++q) acc[m][q] = 0.f;
#pragma unroll 4
    for (int k0 = 0; k0 < 512; k0 += 2) { const int k = k0 + kh, ri = k >> 8, t = k & 255;
        const float bv = bf2f(U[(size_t)t * NP + ri * 256]);
#pragma unroll
        for (int m = 0; m < 2; ++m) acc[m] = __builtin_amdgcn_mfma_f32_32x32x2f32(M3[k * 256 + 32 * m], bv, acc[m], 0, 0, 0); }
    bf16* CY = WSP(bf16, SM_CY) + (size_t)b * 256 * 256 + ch;
#pragma unroll
    for (int m = 0; m < 2; ++m)
#pragma unroll
        for (int q = 0; q < 16; ++q) { const int tp = 64 * mq + 32 * m + (q & 3) + 8 * (q >> 2) + 4 * kh; CY[(size_t)tp * 256] = (bf16)f2bf(acc[m][q] * (1.0f / 128.0f)); }
}
__device__ __forceinline__ void ctx_y_copy(Fr& F) { KA_DECL;
    const int gt = F.bid * 512 + F.tid, NGT = F.G * 512;
    for (int e = gt; e < NB * 256 * 32; e += NGT) { const int b = e >> 13, t = (e >> 5) & 255, c0 = (e & 31) * 8;
        *(u32x4*)(WSP(bf16, BG_PROJ) + ((size_t)b * RPB + t) * NP + C_UR + c0) = *(const u32x4*)(WSP(const bf16, SM_CY) + ((size_t)b * 256 + t) * 256 + c0); }
}

__device__ __forceinline__ f32x4 ld_agent_f4(const float* p) {
    const unsigned long long a = __hip_atomic_load((const unsigned long long*)p, __ATOMIC_RELAXED, __HIP_MEMORY_SCOPE_AGENT), b = __hip_atomic_load((const unsigned long long*)p + 1, __ATOMIC_RELAXED, __HIP_MEMORY_SCOPE_AGENT);
    const f32x2 lo = __builtin_bit_cast(f32x2, a), hi = __builtin_bit_cast(f32x2, b); return (f32x4){lo.x, lo.y, hi.x, hi.y}; }
__device__ __forceinline__ void ctx_tile_finish(Fr& F, int l) { KA_DECL;
    const int task = F.bid, t16 = task >> 2, b = t16 >> 2, pn = t16 & 3;
    volatile LAS int* fl = (volatile LAS int*)(F.lds + MISC_OFF + 520);
    int t_ = F.tid; asm volatile("" : "+v"(t_));
    asm volatile("s_waitcnt vmcnt(0)" ::: "memory"); __builtin_amdgcn_fence(__ATOMIC_RELEASE, "workgroup"); __syncthreads();
    if (t_ == 0) fl[0] = (int)__hip_atomic_fetch_add(WSP(unsigned, WS_CTL) + CW_WQ + (l * 4 + 3) * 64 + t16, 1u, __ATOMIC_RELAXED, __HIP_MEMORY_SCOPE_AGENT);
    __syncthreads();
    if (fl[0] != 3) return;
    for (int e0 = t_; e0 < 256 * 32; e0 += 4 * 512) {
        f32x4 v[4][8];
#pragma unroll
        for (int i = 0; i < 4; ++i) { const int e = e0 + 512 * i, r = e >> 5, c8 = e & 31;
            const GAS float* s = (const GAS float*)(WSP(const float, BG_MF) + (size_t)(b * 256 + r) * D + pn * 256 + c8 * 8);
#pragma unroll
            for (int k = 0; k < 4; ++k) { v[i][2 * k] = ld_agent_f4((const float*)s + (size_t)k * (NB * CTXL * D)); v[i][2 * k + 1] = ld_agent_f4((const float*)s + (size_t)k * (NB * CTXL * D) + 4); } }
#pragma unroll
        for (int i = 0; i < 4; ++i) { const int e = e0 + 512 * i, r = e >> 5, c8 = e & 31;
            const f32x4 a = (v[i][0] + v[i][2]) + (v[i][4] + v[i][6]), d = (v[i][1] + v[i][3]) + (v[i][5] + v[i][7]);
            u32x4 w; w.x = pk2(a.x, a.y); w.y = pk2(a.z, a.w); w.z = pk2(d.x, d.y); w.w = pk2(d.z, d.w);
            *(u32x4*)(WSP(bf16, BG_MERGED) + ((size_t)b * RPB + r) * D + pn * 256 + c8 * 8) = w; } }
}
struct SchedGrid {
    const char* A; const char* B; unsigned lda, ldb; int nt, nM, nN, G, c; bool skip_ctx;
    __device__ __forceinline__ bool next(int i, ge::Unit& u) const {
        int pm, pn; if (!ge::tile_order((long)i * G + c, nM, nN, pm, pn)) return false;
        if (skip_ctx) pm = (pm >> 5) * 33 + 1 + (pm & 31);
        u.A = A + (size_t)pm * 256 * lda; u.B = B + (size_t)pn * 256 * ldb; u.rows = nullptr; u.lda = lda; u.ldb = ldb; u.nt = nt; u.kind = 0; u.pm = pm; u.pn = pn; u.aux = 256; return true; }
};
struct EpiStore {
    static constexpr bool PERM = true, DRAIN = false;
    bf16* O; int ldc;
    __device__ __forceinline__ void operator()(const f32x4 (&acc)[2][2][4][2], const ge::Unit& u, int wr, int wc, int fr, int fq, int tid) const {
        const int row0 = u.pm * 256 + wr * 64 + fr, col0 = u.pn * 256 + wc * 32 + 8 * fq;
#pragma unroll
        for (int ai = 0; ai < 2; ++ai)
#pragma unroll
            for (int m = 0; m < 4; ++m) { bf16* rowp = O + (size_t)(row0 + ai * 128 + m * 16) * ldc + col0;
#pragma unroll
                for (int bj = 0; bj < 2; ++bj) { const f32x4 v0 = acc[ai][bj][m][0], v1 = acc[ai][bj][m][1]; u32x4 w;
                    w.x = ge::cvt_pk_bf16(v0[0], v0[1]); w.y = ge::cvt_pk_bf16(v0[2], v0[3]); w.z = ge::cvt_pk_bf16(v1[0], v1[1]); w.w = ge::cvt_pk_bf16(v1[2], v1[3]);
                    *(u32x4*)(rowp + bj * 128) = w; } }
    }
};
struct SchedD1 {
    const char* H; const char* P; const char* Wg; const char* Wb; int nM, G, c, nlat; bool skip_ctx;
    __device__ __forceinline__ bool next(int i, ge::Unit& u) const {
        int ti = i >> 3, sub = i & 7, k = sub >> 1; int pm, pn; bool ctxu = false;
        if (ge::tile_order((long)ti * G + c, nM, 4, pm, pn)) pm = (pm >> 5) * 33 + 1 + (pm & 31);
        else { const int j = i - 8 * nlat;
            if (skip_ctx || c >= 64 || j < 0 || j >= 2) return false;
            pm = (c >> 4) * 33; pn = (c >> 2) & 3; k = c & 3; sub = j; ctxu = true; }
        u.rows = nullptr; u.pm = pm; u.pn = pn; u.aux = 256;
        if (!(sub & 1)) { u.A = H + (size_t)pm * 256 * 2048; u.lda = 2048; u.B = Wg + ((size_t)k * 1024 + pn * 256) * 2048; u.ldb = 2048; u.nt = 16; u.kind = 0; }
        else { const int colk = k == 0 ? C_AB : (k == 1 ? C_Q : (k == 2 ? C_UR : C_Z));
            u.A = P + (size_t)pm * 256 * (NP * 2) + colk * 2; u.lda = NP * 2; u.B = Wb + ((size_t)k * 1024 + pn * 256) * 512; u.ldb = 512; u.nt = 4; u.kind = (ctxu ? 5 : 1) + k; }
        return true; }
};
#ifndef DBG_L
#define DBG_L 0
#endif
#ifndef MOE_SCALE
#define MOE_SCALE 2.0f
#endif
#ifndef DBG_D1
#define DBG_D1 0
#endif
#ifndef BRMASK
#define BRMASK 15
#endif
struct EpiD1 {
    static constexpr bool PERM = true, DRAIN = false;
    bf16* M; unsigned char* scr; unsigned char* mscr; float* MF;
    __device__ __forceinline__ void operator()(const f32x4 (&acc)[2][2][4][2], const ge::Unit& u, int wr, int wc, int fr, int fq, int tid) const {
        const int row0 = u.pm * 256 + wr * 64 + fr, col0 = u.pn * 256 + wc * 32 + 8 * fq;
        u32x4* sp0 = (u32x4*)(scr + (size_t)(tid >> 6) * 16384 + (size_t)(tid & 63) * 16);
        u32x4* mq0 = (u32x4*)(mscr + (size_t)(tid >> 6) * 16384 + (size_t)(tid & 63) * 16);
        if (u.kind == 0) {
#pragma unroll
            for (int ai = 0; ai < 2; ++ai)
#pragma unroll
                for (int m = 0; m < 4; ++m)
#pragma unroll
                    for (int bj = 0; bj < 2; ++bj) { const int piece = (ai * 4 + m) * 2 + bj; const f32x4 v0 = acc[ai][bj][m][0], v1 = acc[ai][bj][m][1]; u32x4 w;
                        w.x = ge::cvt_pk_bf16(sigmoidf_(v0[0]), sigmoidf_(v0[1])); w.y = ge::cvt_pk_bf16(sigmoidf_(v0[2]), sigmoidf_(v0[3]));
                        w.z = ge::cvt_pk_bf16(sigmoidf_(v1[0]), sigmoidf_(v1[1])); w.w = ge::cvt_pk_bf16(sigmoidf_(v1[2]), sigmoidf_(v1[3])); sp0[piece * 64] = w; }
        } else {
#pragma unroll
            for (int b = 0; b < 4; ++b) {
                u32x4 gb[4], pb[4];
#pragma unroll
                for (int i = 0; i < 4; ++i) { gb[i] = sp0[(4 * b + i) * 64]; pb[i] = mq0[(4 * b + i) * 64]; }
#pragma unroll
                for (int i = 0; i < 4; ++i) { const int piece = 4 * b + i, ai = piece >> 3, m = (piece >> 1) & 3, bj = piece & 1;
                    const f32x4 v0 = acc[ai][bj][m][0], v1 = acc[ai][bj][m][1]; const u32x4 g = gb[i], p = pb[i];
                    float o[8] = {bflo(g.x) * v0[0], bfhi(g.x) * v0[1], bflo(g.y) * v0[2], bfhi(g.y) * v0[3], bflo(g.z) * v1[0], bfhi(g.z) * v1[1], bflo(g.w) * v1[2], bfhi(g.w) * v1[3]};
                    if (u.kind >= 5) {
                        float* mf = MF + (size_t)(u.kind - 5) * (NB * CTXL * D) + (size_t)((u.pm / 33) * 256 + wr * 64 + fr + ai * 128 + m * 16) * D + col0 + bj * 128;
#pragma unroll
                        for (int j = 0; j < 4; ++j) { const f32x2 pr = {o[2 * j], o[2 * j + 1]};
                            __hip_atomic_store((unsigned long long*)mf + j, __builtin_bit_cast(unsigned long long, pr), __ATOMIC_RELAXED, __HIP_MEMORY_SCOPE_AGENT); } }
                    else {
                        if (u.kind > 1) { o[0] += bflo(p.x); o[1] += bfhi(p.x); o[2] += bflo(p.y); o[3] += bfhi(p.y); o[4] += bflo(p.z); o[5] += bfhi(p.z); o[6] += bflo(p.w); o[7] += bfhi(p.w); }
                        u32x4 w; w.x = ge::cvt_pk_bf16(o[0], o[1]); w.y = ge::cvt_pk_bf16(o[2], o[3]); w.z = ge::cvt_pk_bf16(o[4], o[5]); w.w = ge::cvt_pk_bf16(o[6], o[7]);
                        if (u.kind == 4) *(u32x4*)(M + (size_t)(row0 + ai * 128 + m * 16) * D + col0 + bj * 128) = w; else mq0[piece * 64] = w; } }
                asm volatile("" ::: "memory");
            }
        }
    }
};
struct EpiResid {
    static constexpr bool PERM = false, DRAIN = false;
    const float* in_x; const float* in_ctx; float* X; const float* mod; int l;
    __device__ __forceinline__ void operator()(const f32x4 (&acc)[2][2][4][2], const ge::Unit& u, int wr, int wc, int fr, int fq, int tid) const {
        const int b = u.pm / 33, j = u.pm - b * 33;
        const float* src = l > 0 ? (const float*)X + (size_t)u.pm * 256 * D : (j == 0 ? in_ctx + (size_t)b * CTXL * D : in_x + ((size_t)b * SEQ + (size_t)(j - 1) * 256) * D);
        const float* gv = mod + (size_t)(j == 0 ? 4 : b) * 6144 + 2048;
        float* dst = X + (size_t)u.pm * 256 * D;
        const int col0 = u.pn * 256 + wc * 32 + 4 * fq;
        f32x4 gg[2][2];
#pragma unroll
        for (int bj = 0; bj < 2; ++bj)
#pragma unroll
            for (int n = 0; n < 2; ++n) gg[bj][n] = *(const f32x4*)(gv + col0 + bj * 128 + n * 16);
#pragma unroll
        for (int ai = 0; ai < 2; ++ai) {
            f32x4 xo[4][2][2];
#pragma unroll
            for (int m = 0; m < 4; ++m) { const GAS float* sp_ = (const GAS float*)(src + (size_t)(ai * 128 + wr * 64 + m * 16 + fr) * D + col0);
#pragma unroll
                for (int bj = 0; bj < 2; ++bj)
#pragma unroll
                    for (int n = 0; n < 2; ++n) xo[m][bj][n] = *(const GAS f32x4*)(sp_ + bj * 128 + n * 16); }
#pragma unroll
            for (int m = 0; m < 4; ++m) { float* dp_ = dst + (size_t)(ai * 128 + wr * 64 + m * 16 + fr) * D + col0;
#pragma unroll
                for (int bj = 0; bj < 2; ++bj)
#pragma unroll
                    for (int n = 0; n < 2; ++n) *(f32x4*)(dp_ + bj * 128 + n * 16) = xo[m][bj][n] + gg[bj][n] * acc[ai][bj][m][n]; } }
    }
};
__device__ __forceinline__ void moe_prefix(Fr& F, int l) { KA_DECL;
    LAS int* ts = (LAS int*)(F.lds + CTRL_OFF); LAS int* cn = (LAS int*)(F.lds + CTRL_OFF + 160);
    __syncthreads();
    if (F.tid < 64) {
        const unsigned* cnt = WSP(const unsigned, WS_CTL) + CW_CNT + l * 32 * 64; const int e = F.tid;
        const int c = e < NE ? (int)__hip_atomic_load(cnt + e * 64, RLX_AGENT) : 0; const int t = (c + 255) >> 8; int s = t;
#pragma unroll
        for (int o = 1; o < 32; o <<= 1) { const int n = __shfl_up(s, o); if (e >= o) s += n; }
        if (e < NE) { ts[e] = s - t; cn[e] = c; }
        if (e == NE - 1) ts[NE] = s; }
    __syncthreads();
}
struct SchedMoE {
    const LAS int* ts; const LAS int* cn; int stage; const char* A; const char* W; const int* list; int G, vc;
    __device__ __forceinline__ bool next(int i, ge::Unit& u) const {
        const int L = i * G + vc, T = L >> 2, pn = L & 3; if (T >= ts[NE] || T >= MAXT) return false;
        int e = 0;
#pragma unroll
        for (int s = 16; s >= 1; s >>= 1) if (ts[e + s] <= T) e += s;
        const int t = T - ts[e];
        u.pm = T; u.pn = pn; u.kind = 0;
        if (stage == 1) { u.A = A; u.rows = list + (size_t)e * R + t * 256; u.aux = min(256, cn[e] - t * 256); u.lda = 2048; u.B = W + (size_t)e * (D * D * 2) + (size_t)pn * 256 * 2048; u.ldb = 2048; u.nt = 16; }
        else { u.A = A + (size_t)T * 256 * 1024; u.rows = nullptr; u.aux = 256; u.lda = 1024; u.B = W + (size_t)e * (D * DFF * 2) + (size_t)pn * 256 * 1024; u.ldb = 1024; u.nt = 8; }
        return true; }
};
struct EpiAct {
    static constexpr bool PERM = true, DRAIN = false;
    bf16* O;
    __device__ __forceinline__ void operator()(const f32x4 (&acc)[2][2][4][2], const ge::Unit& u, int wr, int wc, int fr, int fq, int tid) const {
        const int row0 = u.pm * 256 + wr * 64 + fr, col0 = u.pn * 128 + wc * 32 + 8 * fq;
#pragma unroll
        for (int ai = 0; ai < 2; ++ai)
#pragma unroll
            for (int m = 0; m < 4; ++m) { const f32x4 a0 = acc[ai][0][m][0], a1 = acc[ai][0][m][1], b0 = acc[ai][1][m][0], b1 = acc[ai][1][m][1]; u32x4 w;
                w.x = ge::cvt_pk_bf16(siluf_(a0[0]) * b0[0], siluf_(a0[1]) * b0[1]); w.y = ge::cvt_pk_bf16(siluf_(a0[2]) * b0[2], siluf_(a0[3]) * b0[3]);
                w.z = ge::cvt_pk_bf16(siluf_(a1[0]) * b1[0], siluf_(a1[1]) * b1[1]); w.w = ge::cvt_pk_bf16(siluf_(a1[2]) * b1[2], siluf_(a1[3]) * b1[3]);
                *(u32x4*)(O + (size_t)(row0 + ai * 128 + m * 16) * DFF + col0) = w; }
    }
};

__device__ __forceinline__ int act_row(int l, int q) { return l == 0 ? q : (q >> 13) * RPB + CTXL + (q & 8191); }
__device__ __forceinline__ void pe1_router(Fr& F, int l) { KA_DECL;
    const int nrows = l == 0 ? R : NB * SEQ;
    const int gw = F.bid * 8 + F.wave, NGW = F.G * 8, lane = F.lane;
    const float* nw = KA->in[I_NFFN] + l * D;
    const float* rgw = KA->in[I_RGW] + (size_t)l * D * 4; const float* rew = KA->in[I_REW] + (size_t)l * D * 32;
    const float* rgb = KA->in[I_RGB] + l * 4; const float* reb = KA->in[I_REB] + l * 32;
    unsigned* cnt = WSP(unsigned, WS_CTL) + CW_CNT + l * 32 * 64;
    for (int q = gw; q < nrows; q += NGW) {
        float a[36];
#pragma unroll
        for (int j = 0; j < 36; ++j) a[j] = 0.f;
        f32x4 f[4];
        const int r = act_row(l, q);
        {   const float* mod = WSP(const float, SM_MOD) + ((size_t)l * 5 + row_cr(r)) * 6144;
            const f32x4* xr = (const f32x4*)(WSP(const float, WS_X) + (size_t)r * D) + lane; float s = 0.f;
#pragma unroll
            for (int j = 0; j < 4; ++j) { f[j] = xr[64 * j]; const f32x4 v = f[j]; s += (v.x * v.x + v.y * v.y) + (v.z * v.z + v.w * v.w); }
            const float rstd = 1.0f / sqrtf(wave_sum(s) * (1.f / D) + EPS);
            unsigned long long* o8 = (unsigned long long*)(WSP(bf16, WS_H) + (size_t)r * D) + lane;
#pragma unroll
            for (int j = 0; j < 4; ++j) { const int k = 4 * (lane + 64 * j);
                const f32x4 w4 = *(const f32x4*)(nw + k), sh = *(const f32x4*)(mod + 3072 + k), sc = *(const f32x4*)(mod + 4096 + k);
                const f32x4 h = (f[j] * rstd) * w4 * (sc + 1.0f) + sh; f[j] = h;
                o8[64 * j] = (unsigned long long)pk2(h.x, h.y) | ((unsigned long long)pk2(h.z, h.w) << 32); } }
#pragma unroll
        for (int j = 0; j < 4; ++j)
#pragma unroll
            for (int e = 0; e < 4; ++e) { const int k = 4 * (lane + 64 * j) + e;
                const f32x4 wg = *(const f32x4*)(rgw + (size_t)k * 4); const f32x4* wep = (const f32x4*)(rew + (size_t)k * 32);
                const float fv = f[j][e];
#pragma unroll
                for (int t = 0; t < 4; ++t) a[t] += fv * wg[t];
#pragma unroll
                for (int t = 0; t < 8; ++t) { const f32x4 we = wep[t]; a[4 + 4 * t] += fv * we.x; a[5 + 4 * t] += fv * we.y; a[6 + 4 * t] += fv * we.z; a[7 + 4 * t] += fv * we.w; }
                asm volatile("" ::: "memory"); }
        {
#pragma unroll
            for (int j = 0; j < 36; ++j) a[j] = wave_sum(a[j]) + (j < 4 ? rgb[j] : reb[j - 4]);
            int gt = 0; float gm = a[0];
#pragma unroll
            for (int j = 1; j < 4; ++j) if (a[j] > gm) { gm = a[j]; gt = j; }
            float gs = 0.f;
#pragma unroll
            for (int j = 0; j < 4; ++j) gs += __expf(a[j] - gm);
            const float pg = 1.0f / gs;
            float el[8];
#pragma unroll
            for (int i = 0; i < 8; ++i) el[i] = gt == 0 ? a[4 + i] : (gt == 1 ? a[12 + i] : (gt == 2 ? a[20 + i] : a[28 + i]));
            int i1 = 0; float m1 = el[0];
#pragma unroll
            for (int i = 1; i < 8; ++i) if (el[i] > m1) { m1 = el[i]; i1 = i; }
            int i2 = -1; float m2 = -3.0e38f;
#pragma unroll
            for (int i = 0; i < 8; ++i) if (i != i1 && el[i] > m2) { m2 = el[i]; i2 = i; }
            float one_ = 1.0f; asm volatile("" : "+s"(one_)); const float e2 = __expf(m2 - m1), den = __builtin_amdgcn_rcpf(one_ + e2);
            const float w1 = pg * den, w2 = pg * e2 * den;
            if (lane == 0) { const int x1 = gt * 8 + i1, x2 = gt * 8 + i2;
                const unsigned k1 = __hip_atomic_fetch_add(cnt + x1 * 64, 1u, RLX_AGENT), k2 = __hip_atomic_fetch_add(cnt + x2 * 64, 1u, RLX_AGENT);
                int* lst = WSP(int, SM_LIST); lst[(size_t)x1 * R + k1] = r; lst[(size_t)x2 * R + k2] = r;
                u32x4* tk = (u32x4*)(WSP(unsigned, SM_TOK) + (size_t)r * 8);
                tk[0] = (u32x4){(unsigned)x1, (unsigned)x2, k1, k2}; tk[1] = (u32x4){__builtin_bit_cast(unsigned, w1), __builtin_bit_cast(unsigned, w2), 0u, 0u}; }
        }
    }
}
__device__ __forceinline__ void router_fold(Fr& F, int l) { KA_DECL;
    const int gt = F.bid * 512 + F.tid, NGT = F.G * 512;
    const float* nw = KA->in[I_NFFN] + l * D; const float* rgw = KA->in[I_RGW] + (size_t)l * D * 4; const float* rew = KA->in[I_REW] + (size_t)l * D * 32;
    for (int e = gt; e < 5 * 1024 * 64; e += NGT) { const int cr = e >> 16, k = (e >> 6) & 1023, j = e & 63;
        const float a = nw[k] * (1.0f + WSP(const float, SM_MOD)[((size_t)l * 5 + cr) * 6144 + 4096 + k]);
        const float w = j < 32 ? rew[k * 32 + j] : (j < 36 ? rgw[k * 4 + (j - 32)] : 0.f);
        WSP(float, SM_WF)[e] = a * w; }
    const int gw = F.bid * 8 + F.wave, NGW = F.G * 8, lane = F.lane;
    for (int idx = gw; idx < 5 * 36; idx += NGW) { const int cr = idx / 36, j = idx % 36; const float* sh = WSP(const float, SM_MOD) + ((size_t)l * 5 + cr) * 6144 + 3072; float s = 0.f;
        for (int k = lane; k < 1024; k += 64) s += sh[k] * (j < 32 ? rew[k * 32 + j] : rgw[k * 4 + (j - 32)]);
        s = wave_sum(s);
        if (lane == 0) WSP(float, SM_RC)[cr * 64 + j] = s + (j < 32 ? KA->in[I_REB][l * 32 + j] : KA->in[I_RGB][l * 4 + (j - 32)]); }
}
__device__ __forceinline__ void pe1_router_mfma(Fr& F, int l) { KA_DECL;
    const int ntiles = (l == 0 ? R : NB * SEQ) / 32;
    const int gw = F.bid * 8 + F.wave, NGW = F.G * 8, lane = F.lane, ri = lane & 31, kh = lane >> 5;
    const float* nw = KA->in[I_NFFN] + l * D;
    unsigned* cnt = WSP(unsigned, WS_CTL) + CW_CNT + l * 32 * 64;
    LAS float* LG = (LAS float*)(F.lds + F.wave * 8448);
    LAS int* cntL = (LAS int*)(F.lds + 69632); LAS int* baseL = cntL + 32;
    if (F.tid < 32) cntL[F.tid] = 0;
    __syncthreads();
    const int tile = F.wave * F.G + F.bid;
    const bool has = tile < ntiles;
    int x1 = 0, x2 = 0, lr1 = 0, lr2 = 0; float w1 = 0.f, w2 = 0.f, rstd = 0.f; int row0 = 0, cr = 0;
    if (has) {
        row0 = act_row(l, tile * 32); cr = row_cr(row0);
        const float* xr = WSP(const float, WS_X) + (size_t)(row0 + ri) * D + 4 * kh;
        const float* wf = WSP(const float, SM_WF) + (size_t)cr * 65536 + (size_t)(4 * kh) * 64 + ri;
        f32x16 acc0, acc1;
#pragma unroll
        for (int q = 0; q < 16; ++q) { acc0[q] = 0.f; acc1[q] = 0.f; }
        float ss = 0.f;
        f32x4 xn_[4]; float wn0[16], wn1[16]; f32x4 xc_[4]; float wc0[16], wc1[16];
#define RT_LOAD(st) do { _Pragma("unroll") for (int u_ = 0; u_ < 4; ++u_) { const int t_ = (st) * 4 + u_; xn_[u_] = *(const f32x4*)(xr + 8 * t_); \
            _Pragma("unroll") for (int e_ = 0; e_ < 4; ++e_) { wn0[u_ * 4 + e_] = wf[(size_t)(8 * t_ + e_) * 64]; wn1[u_ * 4 + e_] = wf[(size_t)(8 * t_ + e_) * 64 + 32]; } } } while (0)
        RT_LOAD(0);
        for (int st = 0; st < (PROBE_RT == 1 ? 1 : 32); ++st) {
#pragma unroll
            for (int u_ = 0; u_ < 4; ++u_) xc_[u_] = xn_[u_];
#pragma unroll
            for (int u_ = 0; u_ < 16; ++u_) { wc0[u_] = wn0[u_]; wc1[u_] = wn1[u_]; }
            if (st < 31) RT_LOAD(st + 1);
#pragma unroll
            for (int u_ = 0; u_ < 4; ++u_) { const f32x4 xv = xc_[u_]; ss += (xv.x * xv.x + xv.y * xv.y) + (xv.z * xv.z + xv.w * xv.w);
#pragma unroll
                for (int e = 0; e < 4; ++e) { acc0 = __builtin_amdgcn_mfma_f32_32x32x2f32(xv[e], wc0[u_ * 4 + e], acc0, 0, 0, 0); acc1 = __builtin_amdgcn_mfma_f32_32x32x2f32(xv[e], wc1[u_ * 4 + e], acc1, 0, 0, 0); } }
        }
#undef RT_LOAD
        ss += __shfl_xor(ss, 32);
        rstd = 1.0f / sqrtf(ss * (1.f / D) + EPS);
        if (lane < 32) ((LAS float*)(F.lds + 131072))[F.wave * 32 + ri] = rstd;
#pragma unroll
        for (int q = 0; q < 16; ++q) { const int row = (q & 3) + 8 * (q >> 2) + 4 * kh; LG[row * 66 + ri] = acc0[q]; LG[row * 66 + 32 + ri] = acc1[q]; }
        LDS_WAIT(); asm volatile("" ::: "memory");
        if (lane < 32) {
            const float* rc = WSP(const float, SM_RC) + cr * 64; const LAS float* lg = LG + ri * 66;
            float g4[4];
#pragma unroll
            for (int j = 0; j < 4; ++j) g4[j] = lg[32 + j] * rstd + rc[32 + j];
            int gt = 0; float gm = g4[0];
#pragma unroll
            for (int j = 1; j < 4; ++j) if (g4[j] > gm) { gm = g4[j]; gt = j; }
            float gs = 0.f;
#pragma unroll
            for (int j = 0; j < 4; ++j) gs += __expf(g4[j] - gm);
            const float pg = 1.0f / gs;
            float el[8];
#pragma unroll
            for (int i = 0; i < 8; ++i) el[i] = lg[gt * 8 + i] * rstd + rc[gt * 8 + i];
            int i1 = 0; float m1 = el[0];
#pragma unroll
            for (int i = 1; i < 8; ++i) if (el[i] > m1) { m1 = el[i]; i1 = i; }
            int i2 = -1; float m2 = -3.0e38f;
#pragma unroll
            for (int i = 0; i < 8; ++i) if (i != i1 && el[i] > m2) { m2 = el[i]; i2 = i; }
            float one_ = 1.0f; asm volatile("" : "+s"(one_)); const float e2 = __expf(m2 - m1), den = __builtin_amdgcn_rcpf(one_ + e2);
            w1 = pg * den; w2 = pg * e2 * den; x1 = gt * 8 + i1; x2 = gt * 8 + i2;
            lr1 = __hip_atomic_fetch_add(cntL + x1, 1, __ATOMIC_RELAXED, __HIP_MEMORY_SCOPE_WORKGROUP); lr2 = __hip_atomic_fetch_add(cntL + x2, 1, __ATOMIC_RELAXED, __HIP_MEMORY_SCOPE_WORKGROUP);
        }
    }
    __syncthreads();
    if (F.tid < 32) { const int c = cntL[F.tid]; baseL[F.tid] = c ? (int)__hip_atomic_fetch_add(cnt + F.tid * 64, (unsigned)c, RLX_AGENT) : 0; }
    __syncthreads();
    if (has) {
        if (lane < 32) { const int r = row0 + ri; const unsigned k1 = (unsigned)(baseL[x1] + lr1), k2 = (unsigned)(baseL[x2] + lr2);
            int* lst = WSP(int, SM_LIST); lst[(size_t)x1 * R + k1] = r; lst[(size_t)x2 * R + k2] = r;
            unsigned* tk = WSP(unsigned, SM_TOK) + (size_t)r * 8;
            tk[0] = (unsigned)x1; tk[1] = (unsigned)x2; tk[2] = k1; tk[3] = k2; tk[4] = __builtin_bit_cast(unsigned, w1); tk[5] = __builtin_bit_cast(unsigned, w2);
        }
    }
    {   int w_ = F.wave; asm volatile("" : "+s"(w_));
        for (int t = 0; t * F.G + F.bid < ntiles; ++t) { const int trow0 = act_row(l, (t * F.G + F.bid) * 32), tcr = row_cr(trow0);
            const float* mod = WSP(const float, SM_MOD) + ((size_t)l * 5 + tcr) * 6144;
            f32x4 xv[4][4]; float rs[4];
#pragma unroll
            for (int i = 0; i < 4; ++i) { const int rr = w_ + 8 * i; const GAS f32x4* xq = (const GAS f32x4*)(WSP(const float, WS_X) + (size_t)(trow0 + rr) * D) + lane;
#pragma unroll
                for (int j = 0; j < 4; ++j) xv[i][j] = xq[64 * j];
                rs[i] = ((const LAS float*)(F.lds + 131072))[t * 32 + rr]; }
            f32x4 ca[4], cs[4];
#pragma unroll
            for (int j = 0; j < 4; ++j) { const int k = 4 * (lane + 64 * j); ca[j] = *(const f32x4*)(nw + k) * (*(const f32x4*)(mod + 4096 + k) + 1.0f); cs[j] = *(const f32x4*)(mod + 3072 + k); }
#pragma unroll
            for (int i = 0; i < 4; ++i) { unsigned long long* o8 = (unsigned long long*)(WSP(bf16, WS_H) + (size_t)(trow0 + w_ + 8 * i) * D) + lane;
#pragma unroll
                for (int j = 0; j < 4; ++j) { const f32x4 h = (xv[i][j] * rs[i]) * ca[j] + cs[j];
                    o8[64 * j] = (unsigned long long)pk2(h.x, h.y) | ((unsigned long long)pk2(h.z, h.w) << 32); } } }
        LDS_WAIT(); asm volatile("" ::: "memory"); }
}
__device__ __forceinline__ void pe4_combine(Fr& F, int l) { KA_DECL;
    const LAS int* ts = (const LAS int*)(F.lds + CTRL_OFF);
    LAS float* wdt = (LAS float*)F.lds;
    if (l < DEPTH - 1) { const float* win2 = KA->in[I_WIN] + (size_t)(l + 1) * D * NIN; for (int e = F.tid; e < D * 8; e += 512) wdt[e] = win2[(size_t)(e >> 3) * NIN + 3072 + (e & 7)]; __syncthreads(); }
    const int nrows = l == 0 ? R : NB * SEQ;
    const int gw = F.bid * 8 + F.wave, NGW = F.G * 8, lane = F.lane;
    const bf16* YO = WSP(const bf16, BG_YO);
    unsigned nt0 = 0, nt1 = 0, nt2 = 0, nt3 = 0, nt4 = 0, nt5 = 0;
    f32x4 px[4]; u32x2 pa[4], pb[4]; float pw1 = 0.f, pw2 = 0.f;
#pragma unroll
    for (int j = 0; j < 4; ++j) { px[j] = (f32x4){0.f, 0.f, 0.f, 0.f}; pa[j] = (u32x2){0u, 0u}; pb[j] = (u32x2){0u, 0u}; }
#define E4_REC(qq) do { const unsigned* tkp = WSP(const unsigned, SM_TOK) + (size_t)act_row(l, (qq)) * 8; nt0 = tkp[0]; nt1 = tkp[1]; nt2 = tkp[2]; nt3 = tkp[3]; nt4 = tkp[4]; nt5 = tkp[5]; } while (0)
#define E4_ROWS(qq) do { const size_t s1_ = (size_t)ts[nt0] * 256 + nt2, s2_ = (size_t)ts[nt1] * 256 + nt3; pw1 = __builtin_bit_cast(float, nt4); pw2 = __builtin_bit_cast(float, nt5); \
        const GAS f32x4* xr_ = (const GAS f32x4*)(WSP(float, WS_X) + (size_t)act_row(l, (qq)) * D) + lane; const GAS u32x2* y1_ = (const GAS u32x2*)(YO + s1_ * D) + lane; const GAS u32x2* y2_ = (const GAS u32x2*)(YO + s2_ * D) + lane; \
        _Pragma("unroll") for (int j_ = 0; j_ < 4; ++j_) { px[j_] = xr_[64 * j_]; pa[j_] = y1_[64 * j_]; pb[j_] = y2_[64 * j_]; } } while (0)
    f32x4 wl4[4];
#pragma unroll
    for (int j = 0; j < 4; ++j) wl4[j] = *(const f32x4*)((l < DEPTH - 1 ? KA->in[I_NMIX] + (l + 1) * D : KA->in[I_FNW]) + 4 * (lane + 64 * j));
    if (gw < nrows) { E4_REC(gw); E4_ROWS(gw); if (gw + NGW < nrows) E4_REC(gw + NGW); }
    for (int q = gw; q < nrows; q += NGW) { const int r = act_row(l, q);
        f32x4 cx[4]; u32x2 ca[4], cb[4]; const float w1 = pw1, w2 = pw2;
#pragma unroll
        for (int j = 0; j < 4; ++j) { cx[j] = px[j]; ca[j] = pa[j]; cb[j] = pb[j]; }
        if (q + NGW < nrows) { E4_ROWS(q + NGW); if (q + 2 * NGW < nrows) E4_REC(q + 2 * NGW); }
        const GAS float* mod = (const GAS float*)(WSP(const float, SM_MOD) + ((size_t)l * 5 + row_cr(r)) * 6144 + 5120);
        f32x4* xr = (f32x4*)(WSP(float, WS_X) + (size_t)r * D) + lane;
        f32x4 xn[4]; float ss = 0.f;
        f32x4 gg4[4], sh4[4], sc4[4];
#pragma unroll
        for (int j = 0; j < 4; ++j) { const int k = 4 * (lane + 64 * j); gg4[j] = *(const GAS f32x4*)(mod + k);
            if (l < DEPTH - 1) { const GAS float* m2 = (const GAS float*)(WSP(const float, SM_MOD) + ((size_t)(l + 1) * 5 + row_cr(r)) * 6144); sh4[j] = *(const GAS f32x4*)(m2 + k); sc4[j] = *(const GAS f32x4*)(m2 + 1024 + k); } }
#pragma unroll
        for (int j = 0; j < 4; ++j) { const f32x4 x = cx[j], gg = gg4[j]; const u32x2 a = ca[j], b = cb[j];
            const f32x4 ya = {bflo(a.x), bfhi(a.x), bflo(a.y), bfhi(a.y)}, yb = {bflo(b.x), bfhi(b.x), bflo(b.y), bfhi(b.y)};
            xn[j] = x + gg * (ya * w1 + yb * w2) * DBG_E4S; const f32x4 v = xn[j]; ss += (v.x * v.x + v.y * v.y) + (v.z * v.z + v.w * v.w); }
        if (l == DEPTH - 1) { const float rstd = 1.0f / sqrtf(wave_sum(ss) * (1.f / D) + EPS);
            const int b = r / RPB, s = r - b * RPB; f32x4* orow = (f32x4*)(KA->out + ((size_t)b * SEQ + (s - CTXL)) * D) + lane;
#pragma unroll
            for (int j = 0; j < 4; ++j) orow[64 * j] = xn[j] * rstd * wl4[j]; }
        else {
            const float rstd = 1.0f / sqrtf(wave_sum(ss) * (1.f / D) + EPS);
            unsigned long long* o8 = (unsigned long long*)(WSP(bf16, WS_H) + (size_t)r * D) + lane;
            float d8[8] = {0, 0, 0, 0, 0, 0, 0, 0};
#pragma unroll
            for (int j = 0; j < 4; ++j) { xr[64 * j] = xn[j]; const int k = 4 * (lane + 64 * j);
                const f32x4 w4 = wl4[j], sh = sh4[j], sc = sc4[j];
                const f32x4 h = (xn[j] * rstd) * w4 * (sc + 1.0f) + sh;
                o8[64 * j] = (unsigned long long)pk2(h.x, h.y) | ((unsigned long long)pk2(h.z, h.w) << 32);
#pragma unroll
                for (int e = 0; e < 4; ++e) { const f32x4 wa = *(const LAS f32x4*)(wdt + (k + e) * 8), wb = *(const LAS f32x4*)(wdt + (k + e) * 8 + 4); const float hv = h[e];
                    d8[0] += hv * wa.x; d8[1] += hv * wa.y; d8[2] += hv * wa.z; d8[3] += hv * wa.w; d8[4] += hv * wb.x; d8[5] += hv * wb.y; d8[6] += hv * wb.z; d8[7] += hv * wb.w; } }
#pragma unroll
            for (int e = 0; e < 8; ++e) d8[e] = wave_sum(d8[e]);
            if (lane == 0) { float* dt = WSP(float, SM_DT) + (size_t)r * 8; *(f32x4*)dt = (f32x4){d8[0], d8[1], d8[2], d8[3]}; *(f32x4*)(dt + 4) = (f32x4){d8[4], d8[5], d8[6], d8[7]}; } }
    }
}

constexpr int PH_PER_L = 14, N_PHASES = 2 + DEPTH * PH_PER_L;
#ifndef USE_CG
#define USE_CG 1
#endif
#ifndef PHMASK
#define PHMASK 0xFFFFFFFFu
#endif
#define PON(x) ((PHSEL < 0 && ((PHMASK >> ((x) >= 100 ? (x) - 86 : (x))) & 1u)) || PHSEL == (x))

template <bool COOP, int PHSEL>
__global__ void __launch_bounds__(512, 2) mk(Args a) {
    extern __shared__ __attribute__((aligned(16))) unsigned char lds_raw[];
    Fr F;
    F.lds = (LAS unsigned char*)lds_raw;
    {   const int t0 = threadIdx.x;
        for (int u = t0; u < (LDS_BYTES - CTRL_OFF) / 4; u += 512) ((LAS unsigned*)(F.lds + CTRL_OFF))[u] = 0u;
        __syncthreads();
        if ((t0 & 63) == 0) ((volatile LAS int*)(F.lds + MISC_OFF + 128))[(unsigned)__builtin_amdgcn_s_getreg((6 << 11) | 4) & 63u] = t0 >> 6;
        __syncthreads();
        if (COOP) { KA_DECL; (void)xcd_barrier_post(WSP(unsigned, WS_CTL) + CW_BAR, (volatile LAS unsigned*)(F.lds + MISC_OFF) + 8); } }
    for (int ph = a.ph_lo; ; ++ph) {
        { KA_DECL; if (ph >= KA->ph_hi) break; }
#define PHASE_ENTER(tag) do { int bid_ = blockIdx.x, g_ = gridDim.x; asm volatile("; enter " tag : "+s"(bid_), "+s"(g_)); \
            const unsigned hw_ = (unsigned)__builtin_amdgcn_s_getreg((6 << 11) | 4) & 63u; int wv_ = __builtin_amdgcn_readfirstlane(((volatile LAS int*)(F.lds + MISC_OFF + 128))[hw_]); \
            unsigned z_ = 0u; asm volatile("; z " tag : "+s"(z_)); int lane_ = (int)__builtin_amdgcn_mbcnt_hi(~0u, __builtin_amdgcn_mbcnt_lo(~0u, z_)) & 63; int tid_ = wv_ * 64 + lane_; asm volatile("; tid " tag : "+v"(tid_)); \
            F.tid = tid_; F.lane = tid_ & 63; F.wave = __builtin_amdgcn_readfirstlane(tid_ >> 6); F.bid = bid_; F.G = g_; } while (0)
        if (ph >= 2 + PH_PER_L && (ph - 2) % PH_PER_L == 0) continue;
        if (ph >= 2 && (ph - 2) % PH_PER_L == 5) continue;
        PHASE_ENTER("top");
        const int vc = (F.G % 8 == 0) ? (F.bid % 8) * (F.G / 8) + F.bid / 8 : F.bid;
        if (ph == 0) { if (PON(100)) { PHASE_ENTER("p100"); p0_prologue(F, -1); } }
        else if (ph == 1) { if (PON(101)) { PHASE_ENTER("p101"); p1_mod(F); } }
        else {
            const int l = (ph - 2) / PH_PER_L, p = (ph - 2) % PH_PER_L; const bool last = (l == DEPTH - 1);
            KA_DECL;
            const char* wt_in = (const char*)(WSP(bf16, WT_IN) + (size_t)l * NWIN * D);
            if (p == 0) { if (PON(0)) { PHASE_ENTER("p0"); pa_hrows(F, l); router_fold(F, l); } }
            else if (p == 1) { if (PON(1)) { PHASE_ENTER("p1");
                SchedGrid S{(const char*)WSP(bf16, WS_H), wt_in, 2048u, 2048u, 16, R / 256, NP / 256, F.G, F.bid, false};
                EpiStore E{WSP(bf16, BG_PROJ), NP};
                ge::gemm_engine<EpiStore, SchedGrid, false>(F.lds, S, E, F.tid);
            } }
            else if (p == 2) { if (PON(2)) { PHASE_ENTER("p2");
                for (int t = F.bid; t < NSPAN; t += F.G) span_task_mfma<0, false>(F, l, t);
                bool mat = false; const int nctx = last ? 0 : 16;
                {   KA_DECL; unsigned* wq = WSP(unsigned, WS_CTL) + CW_WQ + (l * 4 + 0) * 64;
                    dyn_tickets(F, wq, nctx + 512 + R / 64, [&](int c) {
                        if (c < nctx) fft_ctx(F, c);
                        else if (c < nctx + 512) { if (!mat) { KA_DECL; lds_load_mat<128>(F, WSP(const bf16, SM_M1B)); mat = true; } fft_stage_a(F, c - nctx); }
                        else conv_a_chunk(F, l, c - nctx - 512); }); }
            } }
            else if (p == 3 || p == 6) { if (PON(3)) { PHASE_ENTER("p3"); state_scan(F, p == 6);
                if (F.bid * 512 >= NB * 8 * 2048) {
                    KA_DECL;
                    if (p == 3) { unsigned* wq = WSP(unsigned, WS_CTL) + CW_WQ + (l * 4 + 1) * 64;
                        dyn_tickets_n(F, wq, R / 64, 1, [&](int c) { conv_xbc_chunk(F, l, c); __builtin_amdgcn_fence(__ATOMIC_SEQ_CST, "workgroup"); __syncthreads(); span_task_mfma<1, false>(F, l, c); }); }
                    else { unsigned* wq = WSP(unsigned, WS_CTL) + CW_WQ + (l * 4 + 2) * 64; bool mat = false;
                        dyn_tickets_n(F, wq, 512, 4, [&](int c) { if (!mat) { KA_DECL; lds_load_mat<256>(F, WSP(const bf16, SM_M2B)); mat = true; } fft_stage_b(F, c); }); } }
            } }
            else if (p == 4) { if (PON(4)) { PHASE_ENTER("p4");
                if (PROBE_P4 != 1) for (int t = F.bid; t < NSPAN; t += F.G) { if (last && (t % SPB) < 4) continue; span_task_mfma<0, true>(F, l, t); }
                {   KA_DECL; unsigned* wq = WSP(unsigned, WS_CTL) + CW_WQ + (l * 4 + 1) * 64; dyn_tickets(F, wq, R / 64, [&](int c) {
                        conv_xbc_chunk(F, l, c); __builtin_amdgcn_fence(__ATOMIC_SEQ_CST, "workgroup"); __syncthreads(); span_task_mfma<1, false>(F, l, c); }); }
            } }
            else if (p == 5) { }
            else if (p == 7) { if (PON(7)) { PHASE_ENTER("p7");
                for (int t = F.bid; t < NSPAN; t += F.G) { if (last && (t % SPB) < 4) continue; span_task_mfma<1, true>(F, l, t); }
                bool mat = false;
                {   KA_DECL; unsigned* wq = WSP(unsigned, WS_CTL) + CW_WQ + (l * 4 + 2) * 64;
                    dyn_tickets(F, wq, 512, [&](int c) { if (!mat) { KA_DECL; lds_load_mat<256>(F, WSP(const bf16, SM_M2B)); mat = true; } fft_stage_b(F, c); }); }
                if (!last) ctx_y_copy(F);
            } }
            else if (p == 8) { if (PON(8)) { PHASE_ENTER("p8");
                SchedD1 S{(const char*)WSP(bf16, WS_H), (const char*)WSP(bf16, BG_PROJ), wt_in + (size_t)NP * 2048, (const char*)(WSP(bf16, WT_BR) + (size_t)l * 4 * D * 256), 128, F.G, F.bid, (512 + F.G - 1 - F.bid) / F.G, last};
                EpiD1 E{WSP(bf16, BG_MERGED), KA->ws + BG_GSCR + (size_t)F.bid * 131072, KA->ws + BG_MSCR + (size_t)F.bid * 131072, WSP(float, BG_MF)};
                ge::gemm_engine<EpiD1, SchedD1, false, false>(F.lds, S, E, F.tid);
                if (!last && F.bid < 64) ctx_tile_finish(F, l);
                if (l == 0 && DEPTH > 1) {
                    KA_DECL; unsigned* wq = WSP(unsigned, WS_CTL) + CW_WQ + 12 * 64; __syncthreads();
                    dyn_tickets(F, wq, PRO_L1_TICKETS, [&](int c) { p0_prologue(F, c); }); }
            } }
            else if (p == 9) { if (PON(9)) { PHASE_ENTER("p9");
                SchedGrid S{(const char*)WSP(bf16, BG_MERGED), (const char*)(WSP(bf16, WT_OUT) + (size_t)l * D * D), 2048u, 2048u, 16, last ? 128 : 132, 4, F.G, F.bid, last};
                EpiResid E{KA->in[I_X], KA->in[I_CTX], WSP(float, WS_X), WSP(const float, SM_MOD) + (size_t)l * 5 * 6144, l};
                ge::gemm_engine<EpiResid, SchedGrid, false>(F.lds, S, E, F.tid);
                if (!last) moe_convert_tickets(F, l, 0);
            } }
            else if (p == 10) { if (PON(10)) { PHASE_ENTER("p10"); pe1_router_mfma(F, l); moe_convert_tickets(F, l, 0); } }
            else if (p == 11) { if (PON(11)) { PHASE_ENTER("p11");
                moe_prefix(F, l);
                SchedMoE S{(const LAS int*)(F.lds + CTRL_OFF), (const LAS int*)(F.lds + CTRL_OFF + 160), 1, (const char*)WSP(bf16, WS_H), (const char*)WSP(bf16, BG_W13), WSP(const int, SM_LIST), F.G, vc};
                EpiAct E{WSP(bf16, BG_ACT)};
                ge::gemm_engine<EpiAct, SchedMoE, true>(F.lds, S, E, F.tid);
                moe_convert_tickets(F, l, 1);
            } }
            else if (p == 12) { if (PON(12)) { PHASE_ENTER("p12");
                moe_prefix(F, l);
                SchedMoE S{(const LAS int*)(F.lds + CTRL_OFF), (const LAS int*)(F.lds + CTRL_OFF + 160), 2, (const char*)WSP(bf16, BG_ACT), (const char*)WSP(bf16, BG_W2), nullptr, F.G, vc};
                EpiStore E{WSP(bf16, BG_YO), D};
                ge::gemm_engine<EpiStore, SchedMoE, false>(F.lds, S, E, F.tid);
            } }
            else { if (PON(13)) { PHASE_ENTER("p13"); moe_prefix(F, l); pe4_combine(F, l); if (l < DEPTH - 1) router_fold(F, l + 1); } }
        }
        { KA_DECL; if (ph + 1 >= KA->ph_hi) break; }
        {
            if (COOP) { if (USE_CG && ph == 0) cg::this_grid().sync(); else { KA_DECL; XcdBarrier bar; bar.bar = WSP(unsigned, WS_CTL) + CW_BAR; bar.x = xb_xcc_id(); bar.st = (volatile LAS unsigned*)(F.lds + MISC_OFF) + 8; xcd_barrier(bar, F.tid); } }
        }
    }
}

#ifndef PROFILE_P
#define PROFILE_P 2
#endif
#ifndef PROFILE_SEL
#define PROFILE_SEL 0
#endif
#ifndef PROFILE_UNIT_US
#define PROFILE_UNIT_US 20.f
#endif
#ifndef PROFILE_GROUPS
#define PROFILE_GROUPS 0
#endif
#ifndef ONE_LAUNCH
#define ONE_LAUNCH 1
#endif
#ifndef DBG_STOP
#define DBG_STOP 0
#endif
#ifndef DBG_K
#define DBG_K 30.f
#endif
__global__ void __launch_bounds__(256) dbg_gemm(const bf16* A, int lda, const bf16* Bt, int ldb, int K, const bf16* C, int ldc, int c0, float* out) {
    const int q = blockIdx.x, r = (q >> 13) * RPB + CTXL + (q & 8191);
    __shared__ float arow[1024];
    for (int k = threadIdx.x; k < K; k += 256) arow[k] = bf2f(A[(size_t)r * lda + k]);
    __syncthreads();
    for (int c = threadIdx.x; c < 1024; c += 256) { const bf16* b = Bt + (size_t)(c0 + c) * ldb; float s = 0.f;
        for (int k = 0; k < K; k += 8) { const u32x4 w = *(const u32x4*)(b + k);
            s += arow[k] * bflo(w.x) + arow[k + 1] * bfhi(w.x) + arow[k + 2] * bflo(w.y) + arow[k + 3] * bfhi(w.y) + arow[k + 4] * bflo(w.z) + arow[k + 5] * bfhi(w.z) + arow[k + 6] * bflo(w.w) + arow[k + 7] * bfhi(w.w); }
        out[(size_t)q * D + c] = DBG_K * (bf2f(C[(size_t)r * ldc + c0 + c]) - s); }
}
__global__ void __launch_bounds__(256) dbg_merged(const bf16* H, const bf16* P, const bf16* Wg, const bf16* Wb, const bf16* M, float* out) {
    const int q = blockIdx.x, r = (q >> 13) * RPB + CTXL + (q & 8191);
    __shared__ float hrow[1024]; __shared__ float yrow[1024];
    for (int k = threadIdx.x; k < 1024; k += 256) { hrow[k] = bf2f(H[(size_t)r * D + k]); const int br = k >> 8, kk = k & 255; const int colk = br == 0 ? C_AB : (br == 1 ? C_Q : (br == 2 ? C_UR : C_Z)); yrow[k] = bf2f(P[(size_t)r * NP + colk + kk]); }
    __syncthreads();
    for (int c = threadIdx.x; c < 1024; c += 256) { float tot = 0.f;
        for (int br = 0; br < 4; ++br) { if (!((BRMASK >> br) & 1)) continue; const bf16* wg = Wg + (size_t)(br * 1024 + c) * D; float g = 0.f; for (int k = 0; k < 1024; ++k) g += hrow[k] * bf2f(wg[k]);
            const bf16* wb = Wb + ((size_t)br * 1024 + c) * 256; float p = 0.f; for (int k = 0; k < 256; ++k) p += yrow[br * 256 + k] * bf2f(wb[k]);
            tot += DBG_D1 == 1 ? 1.f / (1.f + expf(-g)) : (DBG_D1 == 2 ? p : p / (1.f + expf(-g))); }
        out[(size_t)q * D + c] = DBG_K * (bf2f(M[(size_t)r * D + c]) - tot); }
}
__global__ void __launch_bounds__(256) dbg_d2(const bf16* M, const bf16* Wo, const float* X, const float* xin, const float* mod, float* out) {
    const int q = blockIdx.x, b = q >> 13, r = b * RPB + CTXL + (q & 8191);
    __shared__ float mrow[1024];
    for (int k = threadIdx.x; k < 1024; k += 256) mrow[k] = bf2f(M[(size_t)r * D + k]);
    __syncthreads();
    for (int c = threadIdx.x; c < 1024; c += 256) { const bf16* w = Wo + (size_t)c * D; float s = 0.f; for (int k = 0; k < 1024; ++k) s += mrow[k] * bf2f(w[k]);
        out[(size_t)q * D + c] = DBG_K * (X[(size_t)r * D + c] - (xin[(size_t)q * D + c] + mod[(size_t)b * 6144 + 2048 + c] * s)); }
}
__global__ void __launch_bounds__(256) dbg_moe(const bf16* F, const unsigned* TOK, const unsigned* CNT, const bf16* YO, const float* W1, const float* W3, const float* W2, float* out) {
    const int q = blockIdx.x, r = (q >> 13) * RPB + CTXL + (q & 8191), tid = threadIdx.x;
    __shared__ float frow[1024]; __shared__ float act[512]; __shared__ int ts[33];
    if (tid == 0) { int a = 0; for (int e = 0; e < 32; ++e) { ts[e] = a; a += ((int)CNT[e] + 255) >> 8; } ts[32] = a; }
    for (int k = tid; k < 1024; k += 256) frow[k] = bf2f(F[(size_t)r * D + k]);
    __syncthreads();
    const unsigned* tk = TOK + (size_t)r * 8; const int ex[2] = {(int)tk[0], (int)tk[1]}; const unsigned rk[2] = {tk[2], tk[3]}; const float ww[2] = {__builtin_bit_cast(float, tk[4]), __builtin_bit_cast(float, tk[5])};
    float y[4] = {0, 0, 0, 0}, mine[4] = {0, 0, 0, 0};
    for (int s = 0; s < 2; ++s) { const int e = ex[s];
        const float* w1 = W1 + (size_t)e * D * DFF; const float* w3 = W3 + (size_t)e * D * DFF; const float* w2 = W2 + (size_t)e * DFF * D;
        for (int j = tid; j < 512; j += 256) { float a = 0.f, b = 0.f; for (int k = 0; k < 1024; ++k) { a += frow[k] * w1[(size_t)k * DFF + j]; b += frow[k] * w3[(size_t)k * DFF + j]; } act[j] = a / (1.f + expf(-a)) * b; }
        __syncthreads();
        const size_t slot = (size_t)ts[e] * 256 + rk[s];
        for (int i = 0; i < 4; ++i) { const int c = tid + 256 * i; float o = 0.f; for (int j = 0; j < 512; ++j) o += act[j] * w2[(size_t)j * D + c]; y[i] += ww[s] * o; mine[i] += ww[s] * bf2f(YO[slot * D + c]); }
        __syncthreads(); }
    for (int i = 0; i < 4; ++i) out[(size_t)q * D + tid + 256 * i] = DBG_K * (mine[i] - y[i]);
}
__global__ void __launch_bounds__(256) dbg_router(const float* X, const float* mod, const float* nw, const float* rgw, const float* rgb, const float* rew, const float* reb, const unsigned* TOK, float* out) {
    const int q = blockIdx.x, b = q >> 13, r = b * RPB + CTXL + (q & 8191), tid = threadIdx.x;
    __shared__ float f[1024]; __shared__ float red[256]; __shared__ float lg[36];
    float ss = 0.f; for (int k = tid; k < 1024; k += 256) { const float v = X[(size_t)r * D + k]; ss += v * v; }
    red[tid] = ss; __syncthreads(); for (int s = 128; s > 0; s >>= 1) { if (tid < s) red[tid] += red[tid + s]; __syncthreads(); }
    const float rstd = 1.0f / sqrtf(red[0] / 1024.f + EPS);
    for (int k = tid; k < 1024; k += 256) f[k] = X[(size_t)r * D + k] * rstd * nw[k] * (1.f + mod[(size_t)b * 6144 + 4096 + k]) + mod[(size_t)b * 6144 + 3072 + k];
    __syncthreads();
    if (tid < 36) { float s = 0.f; if (tid < 4) { for (int k = 0; k < 1024; ++k) s += f[k] * rgw[k * 4 + tid]; s += rgb[tid]; } else { for (int k = 0; k < 1024; ++k) s += f[k] * rew[k * 32 + tid - 4]; s += reb[tid - 4]; } lg[tid] = s; }
    __syncthreads();
    for (int c = tid; c < 1024; c += 256) out[(size_t)q * D + c] = 0.f;
    __syncthreads();
    if (tid == 0) { int gt = 0; for (int j = 1; j < 4; ++j) if (lg[j] > lg[gt]) gt = j; float gs = 0.f; for (int j = 0; j < 4; ++j) gs += expf(lg[j] - lg[gt]); const float pg = 1.f / gs;
        const float* el = lg + 4 + gt * 8; int i1 = 0; for (int i = 1; i < 8; ++i) if (el[i] > el[i1]) i1 = i; int i2 = -1; for (int i = 0; i < 8; ++i) if (i != i1 && (i2 < 0 || el[i] > el[i2])) i2 = i;
        const float e2 = expf(el[i2] - el[i1]), w1 = pg / (1.f + e2), w2 = pg * e2 / (1.f + e2);
        const unsigned* tk = TOK + (size_t)r * 8;
        out[(size_t)q * D + 0] = 1000.f * ((float)tk[0] - (float)(gt * 8 + i1)); out[(size_t)q * D + 1] = 1000.f * ((float)tk[1] - (float)(gt * 8 + i2));
        out[(size_t)q * D + 2] = 1000.f * (__builtin_bit_cast(float, tk[4]) - w1); out[(size_t)q * D + 3] = 1000.f * (__builtin_bit_cast(float, tk[5]) - w2); }
}
__device__ __forceinline__ float dbg_conv_silu(const bf16* P, int r, int c, const float* cw, const float* cb) {
    bool vp, vn; nbr_valid(r, vp, vn); const bf16* row = P + (size_t)r * NP + C_XBC + c;
    const float a = vp ? bf2f(row[-NP]) : 0.f, b = bf2f(row[0]), n = vn ? bf2f(row[NP]) : 0.f; const float v = cb[c] + cw[c] * a + cw[512 + c] * b + cw[1024 + c] * n; return v / (1.f + expf(-v)); }
__global__ void __launch_bounds__(64) dbg_naive_scan(const bf16* P, const float* DT, float* XO, const float* scw, const float* scb, const float* alog, const float* dtb, const float* sd, const float* hlb, int mix) {
    const int b = blockIdx.x >> 3, h = (blockIdx.x >> 1) & 3, dir = blockIdx.x & 1, lane = threadIdx.x, g = h >> 1;
    __shared__ float Ssh[64][64];
#define S_(k) Ssh[k][lane]
    for (int k = 0; k < 64; ++k) S_(k) = 0.f;
    const float A = expf(alog[dir * 4 + h]), bias = dtb[dir * 4 + h], Dh = sd[h];
    __shared__ float lbs[64]; lbs[lane] = DBG_L ? 1.f / (1.f + expf(hlb[(dir * DEPTH + 0) * 256 + h * 64 + lane] - hlb[(dir * DEPTH + DBG_L) * 256 + h * 64 + lane])) : 0.f; __syncthreads();
    for (int p = 0; p < RPB; ++p) {
        int s; if (!dir) s = p; else s = p < CTXL ? CTXL - 1 - p : RPB - 1 - (p - CTXL);
        const int r = b * RPB + s; const bf16* row = P + (size_t)r * NP; float o = 0.f;
        if (mix == 0) { const float vv = bf2f(row[C_I + h * 64 + lane]);
            for (int k = 0; k < 64; ++k) { const float fr = bf2f(row[C_FF + dir * 256 + h * 64 + k]), qr = bf2f(row[C_Q + h * 64 + k]); const float f = lbs[k] + (1.f - lbs[k]) / (1.f + expf(-fr)), q = qr / (1.f + expf(-qr));
                S_(k) = f * S_(k) + (1.f - f) * vv; o += q * S_(k); }
            if (s >= CTXL) XO[((size_t)b * SEQ + (s - CTXL)) * D + (dir ? 0 : 256) + h * 64 + lane] = o;
        } else { const float xv = dbg_conv_silu(P, r, h * 64 + lane, scw, scb); const float dtr = DT[(size_t)r * 8 + dir * 4 + h] + bias; const float dt = dtr > 20.f ? dtr : log1pf(expf(dtr)); const float a = expf(-dt * A);
            for (int k = 0; k < 64; ++k) { const float Bv = dbg_conv_silu(P, r, 256 + g * 64 + k, scw, scb), Cv = dbg_conv_silu(P, r, 384 + g * 64 + k, scw, scb);
                S_(k) = a * S_(k) + Bv * dt * xv; o += Cv * S_(k); }
            if (s >= CTXL) XO[((size_t)b * SEQ + (s - CTXL)) * D + (dir ? 512 : 768) + h * 64 + lane] = dir ? o : o + Dh * xv;
        }
    }
}
__global__ void __launch_bounds__(256) dbg_scan_cmp(const bf16* P, const float* XO, const bf16* GZ, const float* hnw, const float* snw, float* out) {
    const int q = blockIdx.x, r = (q >> 13) * RPB + CTXL + (q & 8191), c = threadIdx.x; __shared__ float red[256];
    {   const float o = XO[(size_t)q * D + 256 + c] + XO[(size_t)q * D + c]; red[c] = o * o; __syncthreads();
        for (int s = 32; s > 0; s >>= 1) { if ((c & 63) < s) red[c] += red[c + s]; __syncthreads(); }
        const float rs = 1.f / sqrtf(red[c & ~63] / 64.f + EPS); const float gr = bf2f(P[(size_t)r * NP + C_G + c]); const float y = o * rs * hnw[c & 63] * gr / (1.f + expf(-gr));
        out[(size_t)q * D + 256 + c] = DBG_K * (bf2f(P[(size_t)r * NP + C_Q + c]) - y); __syncthreads(); }
    {   const float zr = bf2f(GZ[(size_t)r * 256 + c]); const float v = (XO[(size_t)q * D + 768 + c] + XO[(size_t)q * D + 512 + c]) * zr / (1.f + expf(-zr)); red[c] = v * v; __syncthreads();
        for (int s = 64; s > 0; s >>= 1) { if ((c & 127) < s) red[c] += red[c + s]; __syncthreads(); }
        const float rs = 1.f / sqrtf(red[c & ~127] / 128.f + EPS); const float y = v * rs * snw[c];
        out[(size_t)q * D + 768 + c] = DBG_K * (bf2f(P[(size_t)r * NP + C_Z + c]) - y); }
    out[(size_t)q * D + c] = 0.f; out[(size_t)q * D + 512 + c] = 0.f;
}
__global__ void dbg_save_gz(const bf16* P, bf16* GZ) {
    const int r = blockIdx.x, c = threadIdx.x; GZ[(size_t)r * 256 + c] = P[(size_t)r * NP + C_Z + c];
}
__global__ void __launch_bounds__(256) dbg_four(const bf16* H, const float* win, const bf16* P, float* out) {
    const int q = blockIdx.x, r = (q >> 13) * RPB + CTXL + (q & 8191), c = threadIdx.x; __shared__ float hrow[1024]; __shared__ float four[256];
    for (int k = c; k < 1024; k += 256) hrow[k] = bf2f(H[(size_t)r * D + k]);
    __syncthreads();
    { float s = 0.f; for (int k = 0; k < 1024; ++k) s += hrow[k] * win[(size_t)k * NIN + 2048 + c]; four[c] = s; }
    __syncthreads();
    const int g = c >> 6, cp = c & 63; float ur = 0.f, ui = 0.f;
    for (int i = 0; i < 64; ++i) { float sn, cs; sincospif(2.0f * (float)((i * cp) & 63) / 64.0f, &sn, &cs); ur += four[g * 64 + i] * cs; ui -= four[g * 64 + i] * sn; }
    out[(size_t)q * D + c] = DBG_K * (bf2f(P[(size_t)r * NP + C_UR + c]) - ur); out[(size_t)q * D + 256 + c] = DBG_K * (bf2f(P[(size_t)r * NP + C_UI + c]) - ui);
    out[(size_t)q * D + 512 + c] = 0.f; out[(size_t)q * D + 768 + c] = 0.f;
}
__global__ void dbg_save_u(const bf16* P, bf16* U) { const int r = blockIdx.x, c = threadIdx.x; U[(size_t)r * 512 + c] = P[(size_t)r * NP + C_UR + c]; U[(size_t)r * 512 + 256 + c] = P[(size_t)r * NP + C_UI + c]; }
__global__ void __launch_bounds__(256) dbg_dft(const bf16* U, const bf16* P, float* out) {
    const int q = blockIdx.x, b = q >> 13, tp = q & 8191, ch = threadIdx.x; __shared__ float ct[8192]; __shared__ float st[8192];
    for (int i = ch; i < 8192; i += 256) { float sn, cs; sincospif(2.0f * (float)i / 8192.0f, &sn, &cs); ct[i] = cs; st[i] = sn; }
    __syncthreads();
    float acc = 0.f; const bf16* u = U + ((size_t)b * RPB + CTXL) * 512 + ch;
    for (int t = 0; t < 8192; ++t) { const int idx = (t * tp) & 8191; acc += bf2f(u[(size_t)t * 512]) * ct[idx] + bf2f(u[(size_t)t * 512 + 256]) * st[idx]; }
    const int r = b * RPB + CTXL + tp;
    out[(size_t)q * D + 512 + ch] = DBG_K * (bf2f(P[(size_t)r * NP + C_UR + ch]) - acc * 0.001381067932f);
    out[(size_t)q * D + ch] = 0.f; out[(size_t)q * D + 256 + ch] = 0.f; out[(size_t)q * D + 768 + ch] = 0.f;
}
__global__ void dbg_mod(const float* c, const float* cctx, const float* adaw, const float* adab, float* MN) {
    const int j = blockIdx.x * 256 + threadIdx.x, cr = blockIdx.y; if (j >= 6144) return; const float* cv = cr < 4 ? c + cr * D : cctx; float s = adab[j];
    for (int k = 0; k < 1024; ++k) { const float x = cv[k]; s += x / (1.f + expf(-x)) * adaw[(size_t)k * 6144 + j]; } MN[cr * 6144 + j] = s; }
__global__ void __launch_bounds__(256) dbg_h(const float* xin, const float* MN, const float* nw, const float* win, const bf16* H, const float* DT, float* out) {
    const int q = blockIdx.x, b = q >> 13, r = b * RPB + CTXL + (q & 8191), tid = threadIdx.x; __shared__ float red[256]; __shared__ float hrow[1024];
    float ss = 0.f; for (int k = tid; k < 1024; k += 256) { const float v = xin[(size_t)q * D + k]; ss += v * v; } red[tid] = ss; __syncthreads();
    for (int s = 128; s > 0; s >>= 1) { if (tid < s) red[tid] += red[tid + s]; __syncthreads(); }
    const float rstd = 1.f / sqrtf(red[0] / 1024.f + EPS);
    for (int k = tid; k < 1024; k += 256) { const float h = xin[(size_t)q * D + k] * rstd * nw[k] * (1.f + MN[b * 6144 + 1024 + k]) + MN[b * 6144 + k]; hrow[k] = h; out[(size_t)q * D + k] = DBG_K * (bf2f(H[(size_t)r * D + k]) - h); }
    __syncthreads();
    if (tid < 8) { float s = 0.f; for (int k = 0; k < 1024; ++k) s += hrow[k] * win[(size_t)k * NIN + 3072 + tid]; out[(size_t)q * D + tid] = 100.f * DBG_K * (DT[(size_t)r * 8 + tid] - s); }
}
__global__ void __launch_bounds__(256) dbg_wt(const float* win, const float* wbr, const float* wout, const bf16* WTI, const bf16* WTB, const bf16* WTO, float* out) {
    const int q = blockIdx.x, tid = threadIdx.x;
    for (int k = tid; k < 1024; k += 256) { float d = 0.f;
        if (q < 7424) { int src = -1; if (q < 2048) src = q; else if (q >= 2560 && q < 2816) src = 2304 + (q - 2560); else if (q >= 2816 && q < 3328) src = 2560 + (q - 2816); else if (q >= 3328) src = 3080 + (q - 3328);
            if (src >= 0) d = bf2f(WTI[(size_t)q * D + k]) - win[(size_t)k * NIN + src]; }
        else if (q >= 8192 && q < 12288) { const int n = q - 8192, br = n >> 10, nn = n & 1023; if (k < 256) d = bf2f(WTB[((size_t)br * 1024 + nn) * 256 + k]) - wbr[((size_t)br * 256 + k) * D + nn]; }
        else if (q >= 12288 && q < 13312) { const int n = q - 12288; d = bf2f(WTO[(size_t)n * D + k]) - wout[(size_t)k * D + n]; }
        out[(size_t)q * D + k] = 1000.f * d; }
}
__global__ void dbg_save_a(const bf16* P, bf16* S) { const int r = blockIdx.x, c = threadIdx.x; for (int j = 0; j < 3; ++j) S[(size_t)r * 768 + j * 256 + c] = P[(size_t)r * NP + j * 256 + c]; }
__global__ void __launch_bounds__(256) dbg_conva(const bf16* S, const bf16* P, const float* cw, const float* cb, float* out) {
    const int q = blockIdx.x, r = (q >> 13) * RPB + CTXL + (q & 8191), t = q & 8191, c = threadIdx.x;
    const bf16* s0 = S + (size_t)r * 768; const float u0 = bf2f(s0[256 + c]) * bf2f(s0[512 + c]);
    const float up = t > 0 ? bf2f(s0[-768 + 256 + c]) * bf2f(s0[-768 + 512 + c]) : 0.f, un = t < 8191 ? bf2f(s0[768 + 256 + c]) * bf2f(s0[768 + 512 + c]) : 0.f;
    const float y = bf2f(s0[c]) * (cb[c] + cw[c] * up + cw[256 + c] * u0 + cw[512 + c] * un);
    out[(size_t)q * D + c] = DBG_K * (bf2f(P[(size_t)r * NP + C_AB + c]) - y); out[(size_t)q * D + 256 + c] = 0.f; out[(size_t)q * D + 512 + c] = 0.f; out[(size_t)q * D + 768 + c] = 0.f;
}
__global__ void __launch_bounds__(256) dbg_final(const float* X, const float* mod, const unsigned* TOK, const unsigned* CNT, const bf16* YO, const float* fnw, float* out) {
    const int q = blockIdx.x, b = q >> 13, r = b * RPB + CTXL + (q & 8191), tid = threadIdx.x; __shared__ int ts[33]; __shared__ float red[256];
    if (tid == 0) { int a = 0; for (int e = 0; e < 32; ++e) { ts[e] = a; a += ((int)CNT[e - (DBG_VAR == 3 ? 32 : 0)] + 255) >> 8; } ts[32] = a; }
    __syncthreads();
    const unsigned* tk = TOK + (size_t)r * 8; const size_t s1 = (size_t)ts[tk[0]] * 256 + tk[2], s2 = (size_t)ts[tk[1]] * 256 + tk[3]; float w1 = __builtin_bit_cast(float, tk[4]), w2 = __builtin_bit_cast(float, tk[5]); if (DBG_VAR == 1) { const float t_ = w1; w1 = w2; w2 = t_; } if (DBG_VAR == 2) mod -= 5 * 6144;
    float xn[4]; float ss = 0.f;
    for (int i = 0; i < 4; ++i) { const int c = tid + 256 * i; xn[i] = X[(size_t)r * D + c] + DBG_E4S * mod[(size_t)b * 6144 + 5120 + c] * (w1 * bf2f(YO[s1 * D + c]) + w2 * bf2f(YO[s2 * D + c])); ss += xn[i] * xn[i]; }
    red[tid] = ss; __syncthreads(); for (int s = 128; s > 0; s >>= 1) { if (tid < s) red[tid] += red[tid + s]; __syncthreads(); }
    const float rstd = 1.f / sqrtf(red[0] / 1024.f + EPS);
    for (int i = 0; i < 4; ++i) { const int c = tid + 256 * i; out[(size_t)q * D + c] = DBG_K * (out[(size_t)q * D + c] - xn[i] * rstd * fnw[c]) + 1e-3f; }
}
#ifndef DBG_MODE
#define DBG_MODE -6
#define DBG_C0 2304
#endif
__global__ void __launch_bounds__(512) dbg_dump(Args a) {
    const int gw = blockIdx.x * 8 + (threadIdx.x >> 6), lane = threadIdx.x & 63;
    for (int q = gw; q < NB * SEQ; q += gridDim.x * 8) { const int r = (q >> 13) * RPB + CTXL + (q & 8191);
        float* orow = a.out + (size_t)q * D;
        if (DBG_MODE == 1) {
            const f32x4* xr = (DBG_STOP <= 2 ? (const f32x4*)(a.in[I_X] + (size_t)q * D) : (const f32x4*)((const float*)(a.ws + WS_X) + (size_t)r * D)) + lane; f32x4 v[4]; float ss = 0.f;
            for (int j = 0; j < 4; ++j) { v[j] = xr[64 * j]; ss += v[j].x * v[j].x + v[j].y * v[j].y + v[j].z * v[j].z + v[j].w * v[j].w; }
            const float rstd = 1.0f / sqrtf(wave_sum(ss) * (1.f / D) + EPS);
            for (int j = 0; j < 4; ++j) ((f32x4*)orow)[lane + 64 * j] = v[j] * rstd * ((const f32x4*)a.in[I_FNW])[lane + 64 * j];
        } else if (DBG_MODE == 2) {
            const bf16* m = (const bf16*)(a.ws + BG_MERGED) + (size_t)r * D; for (int j = 0; j < 16; ++j) orow[lane + 64 * j] = bf2f(m[lane + 64 * j]);
        } else if (DBG_MODE == 3) {
            const bf16* p = (const bf16*)(a.ws + BG_PROJ) + (size_t)r * NP;
            for (int j = 0; j < 4; ++j) { orow[lane + 64 * j] = bf2f(p[C_AB + lane + 64 * j]); orow[256 + lane + 64 * j] = bf2f(p[C_Q + lane + 64 * j]); orow[512 + lane + 64 * j] = bf2f(p[C_UR + lane + 64 * j]); orow[768 + lane + 64 * j] = bf2f(p[C_Z + lane + 64 * j]); }
        } else if (DBG_MODE == 4) {
            const bf16* m = (const bf16*)(a.ws + WS_H) + (size_t)r * D; for (int j = 0; j < 16; ++j) orow[lane + 64 * j] = bf2f(m[lane + 64 * j]);
        } else {
            const bf16* p = (const bf16*)(a.ws + BG_PROJ) + (size_t)r * NP + DBG_MODE; for (int j = 0; j < 16; ++j) orow[lane + 64 * j] = bf2f(p[lane + 64 * j]);
        }
    }
}
template <int PHSEL> static void launch_phase(const Args& a, int grid, hipStream_t stream) {
    static bool attr = false;
    if (!attr) { (void)hipFuncSetAttribute((const void*)mk<false, PHSEL>, hipFuncAttributeMaxDynamicSharedMemorySize, LDS_BYTES); attr = true; }
    hipLaunchKernelGGL((mk<false, PHSEL>), dim3(grid), dim3(512), LDS_BYTES, stream, a);
}
__global__ void dbg_nop() {}
static void launch_any(const Args& a, int ph, int grid, hipStream_t stream) {
        if (ph == 0) launch_phase<100>(a, grid, stream);
        else if (ph == 1) launch_phase<101>(a, grid, stream);
        else switch ((ph - 2) % PH_PER_L) {
            case 0: launch_phase<0>(a, grid, stream); break;
            case 1: launch_phase<1>(a, grid, stream); break;
            case 2: launch_phase<2>(a, grid, stream); break;
            case 3: case 6: launch_phase<3>(a, grid, stream); break;
            case 4: launch_phase<4>(a, grid, stream); break;
            case 5: launch_phase<5>(a, grid, stream); break;
            case 7: launch_phase<7>(a, grid, stream); break;
            case 8: launch_phase<8>(a, grid, stream); break;
            case 9: launch_phase<9>(a, grid, stream); break;
            case 10: launch_phase<10>(a, grid, stream); break;
            case 11: launch_phase<11>(a, grid, stream); break;
            case 12: launch_phase<12>(a, grid, stream); break;
            default: launch_phase<13>(a, grid, stream); break;
        }
}
extern "C" void kernel_launch(void* const* d_in, const int* in_sizes, int n_in, void* d_out, int out_size, void* d_ws, size_t ws_size, hipStream_t stream) {
    static int grid = 0;
    if (grid == 0) {
        if (n_in != 29 || ws_size < WS_END || out_size != NB * SEQ * D) { fprintf(stderr, "kernel_launch: unexpected shapes (n_in %d, ws %zu, out %d)\n", n_in, ws_size, out_size); grid = -1; }
        else {
            int dev = 0, cus = 0; (void)hipGetDevice(&dev); (void)hipDeviceGetAttribute(&cus, hipDeviceAttributeMultiprocessorCount, dev);
            grid = cus;
            if (grid != 256) { fprintf(stderr, "kernel_launch: %d CUs: expected 256\n", cus); if (grid <= 0 || grid % 8) grid = -1; }
        }
    }
    if (grid < 0) { (void)hipMemsetAsync(d_out, 0, (size_t)out_size * 4, stream); return; }
    (void)hipMemsetAsync((char*)d_ws + WS_CTL, 0, 1 * MiB, stream);
    Args a{};
    for (int i = 0; i < 29; ++i) a.in[i] = (const float*)d_in[i];
    a.out = (float*)d_out; a.ws = (unsigned char*)d_ws; a.coop = 0; a.pad = 0;
#if PROFILE_GROUPS
    {
        static int extra_k = -1, extra_m = -1;
        hipStreamCaptureStatus cs = hipStreamCaptureStatusNone; (void)hipStreamIsCapturing(stream, &cs);
        if (extra_k < 0 && cs == hipStreamCaptureStatusNone) {
            hipEvent_t ev[N_PHASES + 1]; for (int i = 0; i <= N_PHASES; ++i) (void)hipEventCreate(&ev[i]);
            for (int rep = 0; rep < 2; ++rep) {
                (void)hipMemsetAsync((char*)d_ws + WS_CTL, 0, 1 * MiB, stream);
                for (int ph = 0; ph < N_PHASES; ++ph) { (void)hipEventRecord(ev[ph], stream); a.ph_lo = ph; a.ph_hi = ph + 1; launch_any(a, ph, grid, stream); }
                (void)hipEventRecord(ev[N_PHASES], stream); (void)hipStreamSynchronize(stream); }
            float g[4] = {0, 0, 0, 0};
            for (int ph = 0; ph < N_PHASES; ++ph) { float ms = 0.f; (void)hipEventElapsedTime(&ms, ev[ph], ev[ph + 1]); const int p = ph < 2 ? 100 + ph : (ph - 2) % PH_PER_L;
                const int grp = PROFILE_GROUPS == 7 ? (p == 101 ? 0 : -1) : PROFILE_GROUPS == 6 ? (p == 100 ? 0 : -1) : PROFILE_GROUPS == 5 ? (p == PROFILE_P ? 0 : -1) : PROFILE_GROUPS == 1 ? ((p == 10) ? 0 : ((p == 2 || p == 4 || p == 5 || p == 7) ? 1 : -1)) : PROFILE_GROUPS == 2 ? ((p == 1 || p == 8 || p == 9 || p == 11 || p == 12) ? 0 : ((p == 3 || p == 6 || p == 0 || p == 13) ? 1 : -1)) : PROFILE_GROUPS == 3 ? ((p == 8) ? 0 : (p == 1 ? 1 : -1)) : ((p == 11 || p == 12) ? 0 : (p >= 100 ? 1 : -1));
                if (grp >= 0) g[grp] += ms; }
            extra_k = (int)(g[PROFILE_SEL] * 1000.f / PROFILE_UNIT_US + 0.5f); extra_m = 0; if (extra_k > 33) extra_k = 33;
        }
        (void)hipMemsetAsync((char*)d_ws + WS_CTL, 0, 1 * MiB, stream);
        for (int ph = 0; ph < N_PHASES; ++ph) { a.ph_lo = ph; a.ph_hi = ph + 1; launch_any(a, ph, grid, stream); }
        for (int i = 0; i < (extra_k > 0 ? extra_k : 0); ++i) hipLaunchKernelGGL(dbg_nop, dim3(1), dim3(64), 0, stream);
        for (int i = 0; i < (extra_m > 0 ? extra_m : 0); ++i) (void)hipMemsetAsync((char*)d_ws + WS_CTL + 512 * 1024, 0, 4, stream);
        return;
    }
#endif
#if ONE_LAUNCH
    {   static bool attr = false;
        if (!attr) { (void)hipFuncSetAttribute((const void*)mk<true, -1>, hipFuncAttributeMaxDynamicSharedMemorySize, LDS_BYTES); attr = true; }
        a.ph_lo = 0; a.ph_hi = N_PHASES; a.coop = 1;
        void* args[] = {&a};
        hipError_t e = hipLaunchCooperativeKernel((const void*)mk<true, -1>, dim3(grid), dim3(512), args, LDS_BYTES, stream);
        if (e != hipSuccess) fprintf(stderr, "cooperative launch failed: %s\n", hipGetErrorString(e));
        return;
    }
#endif
    for (int ph = 0; ph < (DBG_STOP ? DBG_STOP : N_PHASES); ++ph) {
        a.ph_lo = ph; a.ph_hi = ph + 1;
        if (DBG_STOP && DBG_MODE == -8 && ph == 4) hipLaunchKernelGGL(dbg_save_u, dim3(R), dim3(256), 0, stream, (const bf16*)((char*)d_ws + BG_PROJ), (bf16*)((char*)d_ws + WS_X));
        if (DBG_STOP && DBG_MODE == -11 && ph == 4) hipLaunchKernelGGL(dbg_save_a, dim3(R), dim3(256), 0, stream, (const bf16*)((char*)d_ws + BG_PROJ), (bf16*)((char*)d_ws + WS_X));
        if (DBG_STOP && DBG_MODE == -6 && ph == 4 + DBG_L * PH_PER_L) {
            hipLaunchKernelGGL(dbg_save_gz, dim3(R), dim3(256), 0, stream, (const bf16*)((char*)d_ws + BG_PROJ), (bf16*)((char*)d_ws + BG_MIX_END));
            for (int mix = 0; mix < 2; ++mix) hipLaunchKernelGGL(dbg_naive_scan, dim3(32), dim3(64), 0, stream, (const bf16*)((char*)d_ws + BG_PROJ), (const float*)((char*)d_ws + SM_DT), (float*)d_out, (const float*)d_in[13] + DBG_L * 3 * 512, (const float*)d_in[14] + DBG_L * 512, (const float*)d_in[15] + DBG_L * 8, (const float*)d_in[16] + DBG_L * 8, (const float*)d_in[17] + DBG_L * 4, (const float*)d_in[11], mix);
        }
        launch_any(a, ph, grid, stream);
    }
    if (DBG_STOP && DBG_MODE == -1) hipLaunchKernelGGL(dbg_gemm, dim3(NB * SEQ), dim3(256), 0, stream, (const bf16*)((char*)d_ws + WS_H), D, (const bf16*)((char*)d_ws + WT_IN), D, D, (const bf16*)((char*)d_ws + BG_PROJ), NP, DBG_C0, (float*)d_out);
    else if (DBG_STOP && DBG_MODE == -2) hipLaunchKernelGGL(dbg_merged, dim3(NB * SEQ), dim3(256), 0, stream, (const bf16*)((char*)d_ws + WS_H), (const bf16*)((char*)d_ws + BG_PROJ), (const bf16*)((char*)d_ws + WT_IN) + (size_t)DBG_L * NWIN * D + (size_t)NP * D, (const bf16*)((char*)d_ws + WT_BR) + (size_t)DBG_L * 4 * D * 256, (const bf16*)((char*)d_ws + BG_MERGED), (float*)d_out);
    else if (DBG_STOP && DBG_MODE == -4) hipLaunchKernelGGL(dbg_moe, dim3(NB * SEQ), dim3(256), 0, stream, (const bf16*)((char*)d_ws + WS_H), (const unsigned*)((char*)d_ws + SM_TOK), (const unsigned*)((char*)d_ws + WS_CTL) + CW_CNT + DBG_L * 32, (const bf16*)((char*)d_ws + BG_YO), (const float*)d_in[25] + (size_t)DBG_L * NE * D * DFF, (const float*)d_in[26] + (size_t)DBG_L * NE * D * DFF, (const float*)d_in[27] + (size_t)DBG_L * NE * D * DFF, (float*)d_out);
    else if (DBG_STOP && DBG_MODE == -5) hipLaunchKernelGGL(dbg_router, dim3(NB * SEQ), dim3(256), 0, stream, (const float*)((char*)d_ws + WS_X), (const float*)((char*)d_ws + SM_MOD) + DBG_L * 5 * 6144, (const float*)d_in[7] + DBG_L * D, (const float*)d_in[21] + DBG_L * D * 4, (const float*)d_in[22] + DBG_L * 4, (const float*)d_in[23] + DBG_L * D * 32, (const float*)d_in[24] + DBG_L * 32, (const unsigned*)((char*)d_ws + SM_TOK), (float*)d_out);
    else if (DBG_STOP && DBG_MODE == -6) hipLaunchKernelGGL(dbg_scan_cmp, dim3(NB * SEQ), dim3(256), 0, stream, (const bf16*)((char*)d_ws + BG_PROJ), (const float*)d_out, (const bf16*)((char*)d_ws + BG_MIX_END), (const float*)d_in[12] + DBG_L * 64, (const float*)d_in[18] + DBG_L * 256, (float*)d_out);
    else if (DBG_STOP && DBG_MODE == -7) hipLaunchKernelGGL(dbg_four, dim3(NB * SEQ), dim3(256), 0, stream, (const bf16*)((char*)d_ws + WS_H), (const float*)d_in[8], (const bf16*)((char*)d_ws + BG_PROJ), (float*)d_out);
    else if (DBG_STOP && DBG_MODE == -8) hipLaunchKernelGGL(dbg_dft, dim3(NB * SEQ), dim3(256), 0, stream, (const bf16*)((char*)d_ws + WS_X), (const bf16*)((char*)d_ws + BG_PROJ), (float*)d_out);
    else if (DBG_STOP && DBG_MODE == -9) { float* MN = (float*)((char*)d_ws + BG_MIX_END);
        hipLaunchKernelGGL(dbg_mod, dim3(24, 5), dim3(256), 0, stream, (const float*)d_in[1], (const float*)d_in[3], (const float*)d_in[4], (const float*)d_in[5], MN);
        hipLaunchKernelGGL(dbg_h, dim3(NB * SEQ), dim3(256), 0, stream, (const float*)d_in[0], MN, (const float*)d_in[6], (const float*)d_in[8], (const bf16*)((char*)d_ws + WS_H), (const float*)((char*)d_ws + SM_DT), (float*)d_out); }
    else if (DBG_STOP && DBG_MODE == -10) hipLaunchKernelGGL(dbg_wt, dim3(NB * SEQ), dim3(256), 0, stream, (const float*)d_in[8] + (size_t)DBG_L * D * NIN, (const float*)d_in[19] + (size_t)DBG_L * 4 * 256 * D, (const float*)d_in[20] + (size_t)DBG_L * D * D,
        (const bf16*)((char*)d_ws + WT_IN) + (size_t)DBG_L * NWIN * D, (const bf16*)((char*)d_ws + WT_BR) + (size_t)DBG_L * 4 * D * 256, (const bf16*)((char*)d_ws + WT_OUT) + (size_t)DBG_L * D * D, (float*)d_out);
    else if (DBG_STOP && DBG_MODE == -11) hipLaunchKernelGGL(dbg_conva, dim3(NB * SEQ), dim3(256), 0, stream, (const bf16*)((char*)d_ws + WS_X), (const bf16*)((char*)d_ws + BG_PROJ), (const float*)d_in[9], (const float*)d_in[10], (float*)d_out);
    else if (DBG_STOP && DBG_MODE == -12) hipLaunchKernelGGL(dbg_final, dim3(NB * SEQ), dim3(256), 0, stream, (const float*)((char*)d_ws + WS_X), (const float*)((char*)d_ws + SM_MOD) + 5 * 6144, (const unsigned*)((char*)d_ws + SM_TOK), (const unsigned*)((char*)d_ws + WS_CTL) + CW_CNT + 32, (const bf16*)((char*)d_ws + BG_YO), (const float*)d_in[28], (float*)d_out);
    else if (DBG_STOP && DBG_MODE == -3) hipLaunchKernelGGL(dbg_d2, dim3(NB * SEQ), dim3(256), 0, stream, (const bf16*)((char*)d_ws + BG_MERGED), (const bf16*)((char*)d_ws + WT_OUT), (const float*)((char*)d_ws + WS_X), (const float*)d_in[0], (const float*)((char*)d_ws + SM_MOD), (float*)d_out);
    else if (DBG_STOP) hipLaunchKernelGGL(dbg_dump, dim3(256), dim3(512), 0, stream, a);
}
```

```cpp
#include <hip/hip_runtime.h>
#include <hip/hip_cooperative_groups.h>
#include <cstdio>
#include <cstdint>
namespace cg = cooperative_groups;

#define GAS __attribute__((address_space(1)))
#define LAS __attribute__((address_space(3)))
typedef unsigned short bf16;
typedef short bf16x8 __attribute__((ext_vector_type(8)));
typedef float f32x4 __attribute__((ext_vector_type(4)));
typedef float f32x2 __attribute__((ext_vector_type(2)));
typedef float f32x16 __attribute__((ext_vector_type(16)));
typedef unsigned u32x4 __attribute__((ext_vector_type(4)));
typedef unsigned u32x2 __attribute__((ext_vector_type(2)));
typedef GAS unsigned gu32;
#define RLX_AGENT __ATOMIC_RELAXED, __HIP_MEMORY_SCOPE_AGENT

#ifndef DBG_VAR
#define DBG_VAR 3
#endif
#ifndef DBG_E4S
#define DBG_E4S 1.0f
#endif
#ifndef PROBE_RT
#define PROBE_RT 0
#endif
#ifndef PROBE_P4
#define PROBE_P4 0
#endif
#ifndef PROBE_P2
#define PROBE_P2 0
#endif
#ifndef PROBE_P0
#define PROBE_P0 0
#endif
#ifndef PROBE_NOCONV
#define PROBE_NOCONV 0
#endif
#ifndef DBG_NOCTX
#define DBG_NOCTX 0
#endif
constexpr int D = 1024, NB = 4, SEQ = 8192, CTXL = 256, DEPTH = 2;
constexpr int RPB = CTXL + SEQ;
constexpr int R = NB * RPB;
constexpr int NIN = 7176;
constexpr int NP = 3328;
constexpr int NWIN = 7424;
constexpr int SPB = RPB / 64;
constexpr int NSPAN = NB * SPB;
constexpr float EPS = 1e-6f;
constexpr int C_AB = 0, C_AC = 256, C_AX = 512, C_Q = 768, C_FF = 1024, C_I = 1536, C_G = 1792, C_UR = 2048, C_UI = 2304, C_Z = 2560, C_XBC = 2816;
constexpr int C_XS = C_AC, C_BC = C_UI;
constexpr int NE = 32, DFF = 512;
constexpr int MAXT = 300;

constexpr size_t MiB = 1u << 20;
constexpr size_t WS_CTL = 0;
constexpr size_t WS_SMALL = 1 * MiB;
constexpr size_t WS_WT = 17 * MiB;
constexpr size_t WS_X = 57 * MiB;
constexpr size_t WS_H = 189 * MiB;
constexpr size_t WS_BIG = 255 * MiB;
constexpr size_t WS_END = 617 * MiB;
constexpr size_t SM_PART = WS_SMALL;
constexpr size_t SM_MOD = SM_PART + 2 * 8 * 5 * 6144 * 4;
constexpr size_t SM_M1 = SM_MOD + 2 * 5 * 6144 * 4;
constexpr size_t SM_M2 = SM_M1 + 128 * 128 * 4;
constexpr size_t SM_M3 = SM_M2 + 256 * 128 * 4;
constexpr size_t SM_TW = SM_M3 + 512 * 256 * 4;
constexpr size_t SM_DT = SM_TW + 128 * 64 * 2 * 4;
constexpr size_t SM_TOK = SM_DT + (size_t)R * 8 * 4;
constexpr size_t SM_LIST = SM_TOK + (size_t)R * 8 * 4;
constexpr size_t SM_CY = SM_LIST + (size_t)NE * R * 4;
constexpr size_t SM_DEC = SM_CY + 4 * 256 * 256 * 2;
constexpr size_t SM_WF = SM_DEC + 4 * 8 * 132 * 64 * 4;
constexpr size_t SM_RC = SM_WF + 5 * 1024 * 64 * 4;
constexpr size_t SM_M1B = SM_RC + 5 * 64 * 4;
constexpr size_t SM_M2B = SM_M1B + 128 * 128 * 2;
constexpr size_t SM_END = SM_M2B + 128 * 256 * 2;
static_assert(SM_END <= WS_WT, "small region");
constexpr size_t WT_IN = WS_WT;
constexpr size_t WT_BR = WT_IN + (size_t)2 * NWIN * D * 2;
constexpr size_t WT_OUT = WT_BR + (size_t)2 * 4 * D * 256 * 2;
static_assert(WT_OUT + (size_t)2 * D * D * 2 <= WS_X, "wt region");
constexpr size_t BG_PROJ = WS_BIG;
constexpr size_t BG_ST = BG_PROJ + (size_t)R * NP * 2;
constexpr size_t BG_ST2 = BG_ST + (size_t)NB * 8 * SPB * 4096 * 2;
constexpr size_t BG_AP = BG_ST + (size_t)NB * 8 * SPB * 4096 * 4;
constexpr size_t BG_MIX_END = BG_AP + (size_t)NB * 64 * 2 * 128 * 256 * 2;
constexpr size_t BG_MERGED = BG_ST;
constexpr size_t BG_GSCR = BG_MERGED + (size_t)R * D * 2;
constexpr size_t BG_MSCR = BG_GSCR + 256 * 131072;
static_assert(BG_MSCR + 256 * 131072 <= WS_END && BG_MIX_END + (size_t)R * 256 * 2 <= WS_END, "big region");
constexpr size_t BG_MF = 600 * MiB;
static_assert(BG_MSCR + 256 * 131072 <= BG_MF && BG_MF + (size_t)4 * NB * CTXL * D * 4 <= WS_END, "ctx branch slabs");
constexpr size_t BG_W13 = WS_BIG;
constexpr size_t BG_W2 = BG_W13 + (size_t)NE * D * D * 2;
constexpr size_t BG_ACT = BG_W2 + (size_t)NE * D * DFF * 2;
constexpr size_t BG_YO = BG_ACT + (size_t)MAXT * 256 * DFF * 2;
static_assert(BG_YO + (size_t)MAXT * 256 * D * 2 <= BG_MF, "moe region");
static_assert(BG_W2 + (size_t)NE * D * DFF * 2 <= BG_MERGED, "moe weights may be converted while merged is live");
constexpr int CW_BAR = 4096;
constexpr int CW_WQ = 32768;
constexpr int CW_CNT = 16384;

constexpr int RING_BYTES = 131072;
constexpr int CTRL_OFF = 139264;
constexpr int MISC_OFF = CTRL_OFF + 320;
constexpr int LDS_BYTES = 147456;

__device__ __forceinline__ unsigned f2bf(float f) { unsigned u = __builtin_bit_cast(unsigned, f); return (u + 0x7fffu + ((u >> 16) & 1u)) >> 16; }
__device__ __forceinline__ unsigned pk2(float lo, float hi) { return f2bf(lo) | (f2bf(hi) << 16); }
__device__ __forceinline__ float bf2f(unsigned short h) { return __builtin_bit_cast(float, (unsigned)h << 16); }
__device__ __forceinline__ float bflo(unsigned u) { return __builtin_bit_cast(float, u << 16); }
__device__ __forceinline__ float bfhi(unsigned u) { return __builtin_bit_cast(float, u & 0xffff0000u); }
__device__ __forceinline__ float wave_sum(float v) {
#pragma unroll
    for (int o = 1; o < 64; o <<= 1) v += __shfl_xor(v, o);
    return v;
}
__device__ __forceinline__ float sigmoidf_(float x) { return __builtin_amdgcn_rcpf(1.0f + __expf(-x)); }
__device__ __forceinline__ float siluf_(float x) { return x * __builtin_amdgcn_rcpf(1.0f + __expf(-x)); }
__device__ __forceinline__ float softplusf_(float x) { return x > 20.f ? x : log1pf(__expf(x)); }
#define LDS_WAIT() asm volatile("s_waitcnt lgkmcnt(0)" ::: "memory")
#define VM_WAIT() asm volatile("s_waitcnt vmcnt(0)" ::: "memory")

__device__ __forceinline__ int row_cr(int r) { const int b = r / RPB, s = r - b * RPB; return s < CTXL ? 4 : b; }

#define XB_TMO      128
#define XB_XCNT(j)  (256  + 64 * (j))
#define XB_XSUB(j)  (1280 + 64 * (j))
#define XB_XGEN(j)  (2304 + 64 * (j))
#define XB_TOP      3328
#define XB_TOPGEN   3392
#define XCD_BAR_WORDS 3456
#define XB_SPIN_CAP (1u << 20)
__device__ __forceinline__ unsigned xb_ld(unsigned* p)              { return __hip_atomic_load(p, __ATOMIC_RELAXED, __HIP_MEMORY_SCOPE_AGENT); }
__device__ __forceinline__ unsigned xb_add(unsigned* p, unsigned v) { return __hip_atomic_fetch_add(p, v, __ATOMIC_RELAXED, __HIP_MEMORY_SCOPE_AGENT); }
__device__ __forceinline__ unsigned xb_xcc_id() { return (unsigned)__builtin_amdgcn_s_getreg((3 << 11) | 20) & 0xFu; }
#define XB_SPIN(cond, bar) do { unsigned _sp = 0; while (cond) { __builtin_amdgcn_s_sleep(1); \
    if ((++_sp & 255u) == 0u) { if (xb_ld(&(bar)[XB_TMO])) break; if (_sp > XB_SPIN_CAP) { atomicAdd(&(bar)[XB_TMO], 1u); break; } } } } while (0)
struct XcdBarrier { unsigned* bar; unsigned x; volatile LAS unsigned* st; };
__device__ __forceinline__ XcdBarrier xcd_barrier_post(unsigned* bar, volatile LAS unsigned* st) {
    XcdBarrier b; b.bar = bar; b.x = xb_xcc_id(); b.st = st;
    if (threadIdx.x == 0) (void)xb_add(&bar[XB_XCNT(b.x)], 1u);
    return b;
}
__device__ __forceinline__ void xcd_barrier_complete(unsigned* bar, unsigned x, unsigned& nloc, unsigned& nx) {
    const unsigned G = gridDim.x * gridDim.y * gridDim.z;
    unsigned sum, cnt, mine, sp = 0u;
    for (;;) {
        sum = 0u; cnt = 0u; mine = 0u;
#pragma unroll
        for (unsigned j = 0; j < 16; ++j) { const unsigned c = xb_ld(&bar[XB_XCNT(j)]); sum += c; cnt += (c > 0u) ? 1u : 0u; mine = (j == x) ? c : mine; }
        if (sum == G) break;
        __builtin_amdgcn_s_sleep(1);
        if ((++sp & 255u) == 0u) { if (xb_ld(&bar[XB_TMO])) break; if (sp > XB_SPIN_CAP) { atomicAdd(&bar[XB_TMO], 1u); break; } }
    }
    nloc = mine > 0u ? mine : 1u; nx = cnt > 0u ? cnt : 1u;
}
__device__ __forceinline__ void xcd_barrier(const XcdBarrier& b, const int tid) {
    asm volatile("s_waitcnt vmcnt(0)" ::: "memory");
    __syncthreads();
    if (tid == 0) {
        unsigned* bar = b.bar;
        __builtin_amdgcn_s_waitcnt(0);
        unsigned nloc = b.st[0], nx = b.st[1];
        if (nloc == 0u) { xcd_barrier_complete(bar, b.x, nloc, nx); b.st[0] = nloc; b.st[1] = nx; }
        const unsigned old = xb_add(&bar[XB_XSUB(b.x)], 1u);
        const unsigned gen = old / nloc;
        if (old + 1u == (gen + 1u) * nloc) {
            __builtin_amdgcn_fence(__ATOMIC_RELEASE, "agent");
            asm volatile("s_waitcnt vmcnt(0)" ::: "memory");
            const unsigned og = xb_add(&bar[XB_TOP], 1u);
            const unsigned tg = og / nx;
            if (og + 1u == (tg + 1u) * nx) xb_add(&bar[XB_TOPGEN], 1u);
            else XB_SPIN(xb_ld(&bar[XB_TOPGEN]) == tg, bar);
            __builtin_amdgcn_fence(__ATOMIC_ACQUIRE, "agent");
            xb_add(&bar[XB_XGEN(b.x)], 1u);
            asm volatile("s_waitcnt vmcnt(0)" ::: "memory");
        } else {
            XB_SPIN(xb_ld(&bar[XB_XGEN(b.x)]) == gen, bar);
            __builtin_amdgcn_fence(__ATOMIC_ACQUIRE, "agent");
            asm volatile("s_waitcnt vmcnt(0)" ::: "memory");
        }
    }
    __syncthreads();
}

namespace ge {
constexpr int BM = 256, BK = 64, HALF = 128, HTB = HALF * BK * 2, NXCD = 8, WGM = 8;
__device__ __forceinline__ int lds_byte(int r, int c) { const int st = (r >> 4) * 2 + (c >> 5), rr = r & 15, cc = c & 31, ob = rr * 64 + cc * 2; return st * 1024 + (ob ^ (((ob >> 9) & 1) << 5)); }
__device__ __forceinline__ void stage_rc(int b, int& R_, int& C_) { const int st = b / 1024, sb = b % 1024, swz = sb ^ (((sb >> 9) & 1) << 5); R_ = (st >> 1) * 16 + swz / 64; C_ = (st & 1) * 32 + (swz % 64) / 2; }
__device__ __forceinline__ int perm32(int rho) { const int n = rho >> 4, i = rho & 15; return 8 * (i >> 2) + 4 * n + (i & 3); }

struct Unit { const char* A; const char* B; const int* rows; unsigned lda, ldb; int nt, kind, pm, pn, aux; };

__device__ __forceinline__ bool tile_order(long L, int nM, int nN, int& pm, int& pn) {
    const int nwg = nM * nN; if (L >= nwg) return false;
    int wgid = (int)L; { const int q = nwg / NXCD, r = nwg % NXCD, xcd = wgid % NXCD, off = wgid / NXCD; wgid = (xcd < r ? xcd * (q + 1) : r * (q + 1) + (xcd - r) * q) + off; }
    const int nig = WGM * nN, gid = wgid / nig, fm = gid * WGM, gsz = (nM - fm) < WGM ? (nM - fm) : WGM;
    pm = fm + ((wgid % nig) % gsz); pn = (wgid % nig) / gsz; return true;
}

template <class Epi, class Sched, bool GATHER, bool ALIGN_EPI = true>
__device__ __forceinline__ void gemm_engine(LAS unsigned char* lds, const Sched& S, const Epi& E, const int tid) {
    const int wid = __builtin_amdgcn_readfirstlane(tid >> 6), lane = tid & 63, wr = wid >> 2, wc = wid & 3, fr = lane & 15, fq = lane >> 4;
    unsigned voffA[2][2], voffB[2];
    const size_t kstep = (size_t)(BK * 2);
    const unsigned ldsw = (unsigned)wid * 1024u;
    const int aoff = lds_byte(wr * 64 + fr, fq * 8), boff = lds_byte(wc * 32 + fr, fq * 8);
#define GE_SETV(u) do { int t_ = tid; asm volatile("" : "+v"(t_)); _Pragma("unroll") for (int _i = 0; _i < 2; ++_i) { int R_, C_; stage_rc(t_ * 16 + _i * 8192, R_, C_); const int Rb_ = Epi::PERM ? ((R_ & ~31) + perm32(R_ & 31)) : R_; \
        if (GATHER) { const int i0_ = R_ < (u).aux ? (u).rows[R_] : 0, i1_ = (HALF + R_) < (u).aux ? (u).rows[HALF + R_] : 0; \
            voffA[0][_i] = (unsigned)i0_ * (u).lda + (unsigned)C_ * 2u; voffA[1][_i] = (unsigned)i1_ * (u).lda + (unsigned)C_ * 2u; } \
        else { voffA[0][_i] = (unsigned)R_ * (u).lda + (unsigned)C_ * 2u; voffA[1][_i] = voffA[0][_i]; } \
        voffB[_i] = (unsigned)Rb_ * (u).ldb + (unsigned)C_ * 2u; } hstepB = (size_t)HALF * (u).ldb; hstepA = GATHER ? (size_t)0 : (size_t)HALF * (u).lda; } while (0)
#define GE_SA(b, h) (((b) * 2 + (h)) * HTB)
#define GE_SB(b, h) ((4 + (b) * 2 + (h)) * HTB)
#define GE_STAGE(bufoff, gbase, voff) do { _Pragma("unroll") for (int _i = 0; _i < 2; ++_i) \
        __builtin_amdgcn_global_load_lds((const unsigned*)((const char*)(gbase) + (voff)[_i]), (LAS unsigned*)(lds + (bufoff) + ldsw + _i * 8192), 16, 0, 0); } while (0)
#define GE_LDA(dst, b, h) do { _Pragma("unroll") for (int m = 0; m < 4; ++m) _Pragma("unroll") for (int k = 0; k < 2; ++k) dst[m][k] = *(const LAS bf16x8*)(lds + GE_SA(b, h) + aoff + m * 2048 + k * 1024); } while (0)
#define GE_LDB(dst, b, h) do { _Pragma("unroll") for (int n = 0; n < 2; ++n) _Pragma("unroll") for (int k = 0; k < 2; ++k) dst[n][k] = *(const LAS bf16x8*)(lds + GE_SB(b, h) + boff + n * 2048 + k * 1024); } while (0)
#define GE_MMA(ai, bj, At, Bt) do { __builtin_amdgcn_s_setprio(1); _Pragma("unroll") for (int m = 0; m < 4; ++m) _Pragma("unroll") for (int n = 0; n < 2; ++n) _Pragma("unroll") for (int k = 0; k < 2; ++k) \
        acc[ai][bj][m][n] = __builtin_amdgcn_mfma_f32_16x16x32_bf16(Bt[n][k], At[m][k], acc[ai][bj][m][n], 0, 0, 0); __builtin_amdgcn_s_setprio(0); } while (0)
#define GE_WAIT_V(n) asm volatile("s_waitcnt vmcnt(" #n ")" ::: "memory")
#define GE_WAIT_L(n) asm volatile("s_waitcnt lgkmcnt(" #n ")" ::: "memory")
#define GE_BAR __builtin_amdgcn_s_barrier()
#define GE_SCHED __builtin_amdgcn_sched_barrier(0)
    Unit cur, nxt; int ui = 0;
    if (!S.next(0, cur)) return;
    f32x4 acc[2][2][4][2];
#pragma unroll
    for (int a = 0; a < 2; ++a)
#pragma unroll
        for (int b = 0; b < 2; ++b)
#pragma unroll
            for (int m = 0; m < 4; ++m)
#pragma unroll
                for (int n = 0; n < 2; ++n) acc[a][b][m][n] = (f32x4){0.f, 0.f, 0.f, 0.f};
    bf16x8 At[4][2], B0[2][2], B1[2][2];
    size_t hstepB, hstepA;
    GE_SETV(cur);
    if (GATHER) { VM_WAIT(); }
    const char* cA = cur.A; const char* cB = cur.B;
    GE_STAGE(GE_SB(0, 0), cB, voffB); GE_STAGE(GE_SB(0, 1), cB + hstepB, voffB); GE_STAGE(GE_SA(0, 0), cA, voffA[0]); GE_STAGE(GE_SA(0, 1), cA + hstepA, voffA[1]);
    if (wr == 1) GE_BAR;
    GE_WAIT_V(2); GE_BAR;
    GE_STAGE(GE_SB(1, 0), cB + kstep, voffB); GE_STAGE(GE_SA(1, 0), cA + kstep, voffA[0]); GE_STAGE(GE_SB(1, 1), cB + hstepB + kstep, voffB);
    GE_WAIT_V(6); GE_BAR;
    for (;;) {
        const bool has_next = S.next(ui + 1, nxt);
        const char* nA = has_next ? nxt.A : cA; const char* nB = has_next ? nxt.B : cB;
        const int nt = cur.nt;
        for (int t = 0; t < nt; t += 2) {
            const bool last = (t == nt - 2);
            const char* a1 = cA + (size_t)(t + 1) * kstep;
            const char* a2 = last ? nA : cA + (size_t)(t + 2) * kstep; const char* b2 = last ? nB : cB + (size_t)(t + 2) * kstep;
            const char* a3 = a2 + kstep; const char* b3 = b2 + kstep;
            GE_LDB(B0, 0, 0); GE_LDB(B1, 0, 1); GE_SCHED; GE_LDA(At, 0, 0); GE_STAGE(GE_SA(1, 1), a1 + hstepA, voffA[1]);
            GE_WAIT_V(8); GE_WAIT_L(0); GE_BAR; GE_MMA(0, 0, At, B0); GE_MMA(0, 1, At, B1); GE_BAR; GE_SCHED;
            if (last && has_next) { GE_SETV(nxt); if (GATHER) { VM_WAIT(); } }
            GE_LDA(At, 0, 1); GE_STAGE(GE_SB(0, 0), b2, voffB); GE_STAGE(GE_SB(0, 1), b2 + hstepB, voffB); GE_STAGE(GE_SA(0, 0), a2, voffA[0]);
            GE_WAIT_V(8); GE_WAIT_L(0); GE_BAR; GE_MMA(1, 0, At, B0); GE_MMA(1, 1, At, B1); GE_BAR; GE_SCHED;
            GE_LDB(B0, 1, 0); GE_LDB(B1, 1, 1); GE_SCHED; GE_LDA(At, 1, 0); GE_STAGE(GE_SA(0, 1), a2 + hstepA, voffA[1]);
            GE_WAIT_V(8); GE_WAIT_L(0); GE_BAR; GE_MMA(0, 0, At, B0); GE_MMA(0, 1, At, B1); GE_BAR; GE_SCHED;
            GE_LDA(At, 1, 1); GE_STAGE(GE_SB(1, 0), b3, voffB); GE_STAGE(GE_SB(1, 1), b3 + hstepB, voffB); GE_STAGE(GE_SA(1, 0), a3, voffA[0]);
            GE_WAIT_V(8); GE_WAIT_L(0); GE_BAR; GE_MMA(1, 0, At, B0); GE_MMA(1, 1, At, B1); GE_BAR; GE_SCHED;
        }
        if (ALIGN_EPI) { if (wr == 0) GE_BAR; }
        { int tid_o = tid, fr_o = fr, fq_o = fq; asm volatile("" : "+v"(tid_o), "+v"(fr_o), "+v"(fq_o)); E(acc, cur, wr, wc, fr_o, fq_o, tid_o); }
        if (!has_next) break;
        if (Epi::DRAIN) GE_WAIT_V(0);
#pragma unroll
        for (int a = 0; a < 2; ++a)
#pragma unroll
            for (int b = 0; b < 2; ++b)
#pragma unroll
                for (int m = 0; m < 4; ++m)
#pragma unroll
                    for (int n = 0; n < 2; ++n) acc[a][b][m][n] = (f32x4){0.f, 0.f, 0.f, 0.f};
        cur = nxt; cA = nA; cB = nB; ++ui;
        if (ALIGN_EPI) { if (wr == 1) GE_BAR; }
    }
    GE_WAIT_V(0);
    if (!ALIGN_EPI) { if (wr == 0) GE_BAR; }
    GE_BAR;
#undef GE_SETV
#undef GE_SA
#undef GE_SB
#undef GE_STAGE
#undef GE_LDA
#undef GE_LDB
#undef GE_MMA
#undef GE_WAIT_V
#undef GE_WAIT_L
#undef GE_BAR
#undef GE_SCHED
}
typedef float cvt_f32x2 __attribute__((ext_vector_type(2)));
typedef __bf16 cvt_bf16x2 __attribute__((ext_vector_type(2)));
__device__ __forceinline__ unsigned cvt_pk_bf16(float lo, float hi) { const cvt_f32x2 v = {lo, hi}; return __builtin_bit_cast(unsigned, __builtin_convertvector(v, cvt_bf16x2)); }
}

struct Args { const float* in[29]; float* out; unsigned char* ws; int ph_lo, ph_hi, coop, pad; };
typedef __attribute__((address_space(4))) const Args CArgs;
__device__ __forceinline__ CArgs* kargs() { unsigned long long p = (unsigned long long)__builtin_amdgcn_kernarg_segment_ptr(); asm volatile("" : "+s"(p)); return (CArgs*)p; }
#define KA_DECL CArgs* const KA = kargs()
struct Fr {
    LAS unsigned char* lds;
    int tid, lane, wave, G, bid;
};
enum { I_X = 0, I_C, I_CTX, I_CCTX, I_ADAW, I_ADAB, I_NMIX, I_NFFN, I_WIN, I_CAW, I_CAB, I_HLB, I_HNW, I_SCW, I_SCB, I_ALOG, I_DTB, I_SD, I_SNW, I_WBR, I_WOUT, I_RGW, I_RGB, I_REW, I_REB, I_W1, I_W3, I_W2, I_FNW };

#define WSP(T, off) ((T*)(KA->ws + (off)))

__device__ __forceinline__ const float* xrow_ptr(CArgs* KA, int l, int r) {
    if (l > 0) return WSP(const float, WS_X) + (size_t)r * D;
    const int b = r / RPB, s = r - b * RPB;
    return s < CTXL ? KA->in[I_CTX] + ((size_t)b * CTXL + s) * D : KA->in[I_X] + ((size_t)b * SEQ + (s - CTXL)) * D;
}

__device__ __forceinline__ void transpose_item(const float* W, int ldw, int k0, int n0, bf16* WT, int ldt, int drow0, LAS float* scr, int lane) {
#pragma unroll 8
    for (int i = 0; i < 32; ++i) { const int kk = 2 * i + (lane >> 5); scr[kk * 33 + (lane & 31)] = W[(size_t)(k0 + kk) * ldw + n0 + (lane & 31)]; }
    LDS_WAIT(); asm volatile("" ::: "memory");
    const int c = lane & 7;
#pragma unroll
    for (int j = 0; j < 4; ++j) { const int n = (lane >> 3) + 8 * j; const LAS float* s = scr + (8 * c) * 33 + n;
        u32x4 o; o.x = pk2(s[0 * 33], s[1 * 33]); o.y = pk2(s[2 * 33], s[3 * 33]); o.z = pk2(s[4 * 33], s[5 * 33]); o.w = pk2(s[6 * 33], s[7 * 33]);
        *(u32x4*)(WT + (size_t)(drow0 + n) * ldt + k0 + 8 * c) = o; }
    LDS_WAIT(); asm volatile("" ::: "memory");
}
__device__ __forceinline__ void transpose_item64(const float* W, int ldw, int k0, int n0, bf16* WT, int ldt, int drow0, LAS unsigned char* scr, int lane) {
    f32x4 v[16];
#pragma unroll
    for (int i = 0; i < 16; ++i) v[i] = *(const f32x4*)(W + (size_t)(k0 + 4 * i + (lane >> 4)) * ldw + n0 + 4 * (lane & 15));
    LAS bf16* img = (LAS bf16*)scr;
#pragma unroll
    for (int i = 0; i < 16; ++i) { const int kk = 4 * i + (lane >> 4), n = 4 * (lane & 15);
        img[(n + 0) * 72 + kk] = (bf16)f2bf(v[i].x); img[(n + 1) * 72 + kk] = (bf16)f2bf(v[i].y); img[(n + 2) * 72 + kk] = (bf16)f2bf(v[i].z); img[(n + 3) * 72 + kk] = (bf16)f2bf(v[i].w); }
    LDS_WAIT(); asm volatile("" ::: "memory");
#pragma unroll
    for (int j = 0; j < 8; ++j) { const int n = 8 * j + (lane >> 3), c = lane & 7;
        *(u32x4*)(WT + (size_t)(drow0 + n) * ldt + k0 + 8 * c) = *(const LAS u32x4*)(img + n * 72 + 8 * c); }
    LDS_WAIT(); asm volatile("" ::: "memory");
}
constexpr int PRO_L1_ITEMS = 16 * 108 + 512 + 256 + 256, PRO_L1_TICKETS = PRO_L1_ITEMS / 8;
__device__ __forceinline__ void p0_prologue(Fr& F, int ticket) { KA_DECL;
    LAS float* scr = (LAS float*)(F.lds + F.wave * 16384);
    const int gw = F.bid * 8 + F.wave, NGW = F.G * 8, lane = F.lane;
    LAS float* ctab = scr + 2400; LAS float* stab = scr + 2464;
    { float s, c; sincospif(2.0f * (float)lane / 64.0f, &s, &c); ctab[lane] = c; stab[lane] = s; }
    LDS_WAIT();
    constexpr int I_INN = 16 * 108, I_DFT = 512, I_BR = 256, I_OUT = 256, I_ADA = 96 * 8;
    constexpr int PER_L = I_INN + I_DFT + I_BR + I_OUT + I_ADA;
    static_assert(PRO_L1_ITEMS == I_INN + I_DFT + I_BR + I_OUT && PRO_L1_ITEMS % 8 == 0, "layer-1 conversion items");
    const int it_lo = ticket < 0 ? gw : PER_L + I_ADA + 8 * ticket + F.wave, it_hi = ticket < 0 ? 2 * PER_L : it_lo + 1, it_st = ticket < 0 ? NGW : 1;
    for (int it = it_lo; it < it_hi; it += it_st) {
        const int l = it / PER_L; int r = it % PER_L;
        if (l == 1) r = (r + PER_L - I_ADA) % PER_L;
        if (ticket < 0 && l == 1 && r < PRO_L1_ITEMS) continue;
        const float* win = KA->in[I_WIN] + (size_t)l * D * NIN;
        bf16* wt_in = WSP(bf16, WT_IN) + (size_t)l * NWIN * D;
        if (PROBE_P0 && PROBE_P0 != 1 && r < I_INN + I_DFT + I_BR + I_OUT && !(r >= I_INN && r < I_INN + I_DFT)) continue;
        if (PROBE_P0 && PROBE_P0 != 2 && r >= I_INN && r < I_INN + I_DFT) continue;
        if (PROBE_P0 && PROBE_P0 != 3 && r >= I_INN + I_DFT + I_BR + I_OUT) continue;
        if (r < I_INN) {
            const int kb = r / 108, q = r % 108; int dst, src;
            if (q < 32) { dst = 64 * q; src = 64 * q; } else if (q < 36) { dst = 2560 + 64 * (q - 32); src = 2304 + 64 * (q - 32); }
            else if (q < 44) { dst = 2816 + 64 * (q - 36); src = 2560 + 64 * (q - 36); } else { dst = 3328 + 64 * (q - 44); src = 3080 + 64 * (q - 44); }
            transpose_item64(win, NIN, 64 * kb, src, wt_in, D, dst, F.lds + F.wave * 16384, lane); continue; }
        r -= I_INN;
        if (r < I_DFT) {
            const int kb = r >> 5, g = (r >> 3) & 3, cpb = r & 7; const int k = 64 * kb + lane;
            float w[64];
            const f32x4* src = (const f32x4*)(win + (size_t)k * NIN + 2048 + g * 64);
#pragma unroll
            for (int j = 0; j < 16; ++j) { const f32x4 v = src[j]; w[4 * j] = v.x; w[4 * j + 1] = v.y; w[4 * j + 2] = v.z; w[4 * j + 3] = v.w; }
            for (int cp = 8 * cpb; cp < 8 * cpb + 8; ++cp) {
                float ur = 0.f, ui = 0.f;
#pragma unroll
                for (int c = 0; c < 64; ++c) { const int m = (c * cp) & 63; ur += w[c] * ctab[m]; ui -= w[c] * stab[m]; }
                wt_in[(size_t)(C_UR + g * 64 + cp) * D + k] = (bf16)f2bf(ur);
                wt_in[(size_t)(C_UI + g * 64 + cp) * D + k] = (bf16)f2bf(ui);
            }
            continue; }
        r -= I_DFT;
        if (r < I_BR) { const int kbr = r >> 6, q = r & 63, kb = q >> 4, nb = q & 15;
            transpose_item64(KA->in[I_WBR] + ((size_t)l * 4 + kbr) * 256 * D, D, 64 * kb, 64 * nb, WSP(bf16, WT_BR) + ((size_t)l * 4 + kbr) * D * 256, 256, 64 * nb, F.lds + F.wave * 16384, lane); continue; }
        r -= I_BR;
        if (r < I_OUT) { const int kb = r >> 4, nb = r & 15;
            transpose_item64(KA->in[I_WOUT] + (size_t)l * D * D, D, 64 * kb, 64 * nb, WSP(bf16, WT_OUT) + (size_t)l * D * D, D, 64 * nb, F.lds + F.wave * 16384, lane); continue; }
        r -= I_OUT;
        {
            const int jb = r >> 3, ks = r & 7, j = jb * 64 + lane;
            const float* aw = KA->in[I_ADAW] + (size_t)l * D * 6144;
            LAS float* sv = scr + 2560;
#pragma unroll
            for (int q = 0; q < 10; ++q) { const int e = q * 64 + lane, cr = e >> 7, kk = e & 127; const float cv = cr < 4 ? KA->in[I_C][cr * D + ks * 128 + kk] : KA->in[I_CCTX][ks * 128 + kk]; sv[e] = siluf_(cv); }
            LDS_WAIT(); asm volatile("" ::: "memory");
            float a0 = 0.f, a1 = 0.f, a2 = 0.f, a3 = 0.f, a4 = 0.f;
#pragma unroll 8
            for (int kk = 0; kk < 128; ++kk) { const float wv = aw[(size_t)(ks * 128 + kk) * 6144 + j];
                a0 += sv[kk] * wv; a1 += sv[128 + kk] * wv; a2 += sv[256 + kk] * wv; a3 += sv[384 + kk] * wv; a4 += sv[512 + kk] * wv; }
            float* part = WSP(float, SM_PART) + ((size_t)(l * 8 + ks) * 5) * 6144 + j;
            part[0] = a0; part[6144] = a1; part[2 * 6144] = a2; part[3 * 6144] = a3; part[4 * 6144] = a4;
            LDS_WAIT(); asm volatile("" ::: "memory");
        }
    }
    if (ticket >= 0) return;
    if (PROBE_P0 && PROBE_P0 != 4) return;
    const int gt = F.bid * 512 + F.tid, NGT = F.G * 512;
    float* M1 = WSP(float, SM_M1); float* M2 = WSP(float, SM_M2); float* M3 = WSP(float, SM_M3); float* TW = WSP(float, SM_TW);
    for (int e = gt; e < 128 * 128; e += NGT) {
        const int k = e >> 7, m = e & 127, ri = k >> 6, t1 = k & 63, ro = m >> 6, k1 = m & 63; float s, c; sincospif(2.0f * (float)((t1 * k1) & 63) / 64.0f, &s, &c);
        M1[e] = ro == 0 ? (ri == 0 ? c : s) : (ri == 0 ? -s : c); }
    for (int e = gt; e < 256 * 128; e += NGT) {
        const int k = e >> 7, k2 = e & 127, ri = k >> 7, t2 = k & 127; float s, c; sincospif(2.0f * (float)((t2 * k2) & 127) / 128.0f, &s, &c);
        M2[e] = ri == 0 ? c : s; }
    for (int e = gt; e < 128 * 128; e += NGT) {
        const int m = e >> 7, k = e & 127, ri = k >> 6, t1 = k & 63, ro = m >> 6, k1 = m & 63; float s, c; sincospif(2.0f * (float)((t1 * k1) & 63) / 64.0f, &s, &c);
        WSP(bf16, SM_M1B)[e] = (bf16)f2bf(ro == 0 ? (ri == 0 ? c : s) : (ri == 0 ? -s : c)); }
    for (int e = gt; e < 128 * 256; e += NGT) {
        const int k2 = e >> 8, k = e & 255, ri = k >> 7, t2 = k & 127; float s, c; sincospif(2.0f * (float)((t2 * k2) & 127) / 128.0f, &s, &c);
        WSP(bf16, SM_M2B)[e] = (bf16)f2bf(ri == 0 ? c : s); }
    for (int e = gt; e < 512 * 256; e += NGT) {
        const int k = e >> 8, tp = e & 255, ri = k >> 8, t = k & 255; float s, c; sincospif(2.0f * (float)((t * tp) & 255) / 256.0f, &s, &c);
        M3[e] = ri == 0 ? c : s; }
    for (int e = gt; e < 128 * 64; e += NGT) {
        const int t2 = e >> 6, k1 = e & 63; float s, c; sincospif(2.0f * (float)(t2 * k1) / 8192.0f, &s, &c); TW[2 * e] = c; TW[2 * e + 1] = s; }
}
__device__ __forceinline__ void p1_mod(Fr& F) { KA_DECL;
    const int gt = F.bid * 512 + F.tid, NGT = F.G * 512;
    for (int e = gt; e < 2 * 5 * 6144; e += NGT) { const int l = e / (5 * 6144), rem = e % (5 * 6144), cr = rem / 6144, j = rem % 6144;
        float s = KA->in[I_ADAB][l * 6144 + j];
#pragma unroll
        for (int ks = 0; ks < 8; ++ks) s += WSP(const float, SM_PART)[((size_t)(l * 8 + ks) * 5 + cr) * 6144 + j];
        WSP(float, SM_MOD)[e] = s; }
}
__device__ __forceinline__ void moe_convert_item(Fr& F, int l, int it) { KA_DECL;
    LAS unsigned char* scr = F.lds + F.wave * 16384; const int lane = F.lane;
    {   const int which = it >> 12, r = it & 4095, e = r >> 7, q = r & 127;
        if (which < 2) { const int kb = q >> 3, nb = q & 7; const float* W = KA->in[which == 0 ? I_W1 : I_W3] + ((size_t)l * NE + e) * D * DFF;
            transpose_item64(W, DFF, 64 * kb, 64 * nb, WSP(bf16, BG_W13) + (size_t)e * D * D, D, (nb >> 1) * 256 + which * 128 + (nb & 1) * 64, scr, lane); }
        else { const int kb = q >> 4, nb = q & 15; const float* W = KA->in[I_W2] + ((size_t)l * NE + e) * DFF * D;
            transpose_item64(W, D, 64 * kb, 64 * nb, WSP(bf16, BG_W2) + (size_t)e * D * DFF, DFF, 64 * nb, scr, lane); }
    }
}

__device__ __forceinline__ void pa_hrows(Fr& F, int l) { KA_DECL;
    LAS float* wdt = (LAS float*)F.lds;
    const float* win = KA->in[I_WIN] + (size_t)l * D * NIN;
    for (int e = F.tid; e < D * 8; e += 512) wdt[e] = win[(size_t)(e >> 3) * NIN + 3072 + (e & 7)];
    __syncthreads();
    const int gw = F.bid * 8 + F.wave, NGW = F.G * 8, lane = F.lane;
    const float* nw = KA->in[I_NMIX] + l * D;
    f32x4 nw4[4];
#pragma unroll
    for (int j = 0; j < 4; ++j) nw4[j] = *(const f32x4*)(nw + 4 * (lane + 64 * j));
    f32x4 p1[4], p2[4];
#pragma unroll
    for (int j = 0; j < 4; ++j) { p1[j] = (f32x4){0.f, 0.f, 0.f, 0.f}; p2[j] = p1[j]; }
#define PA_LOAD(dst, rr) do { const GAS f32x4* xr_ = (const GAS f32x4*)xrow_ptr(KA, l, (rr)) + lane; _Pragma("unroll") for (int j_ = 0; j_ < 4; ++j_) dst[j_] = xr_[64 * j_]; } while (0)
    if (gw < R) PA_LOAD(p1, gw);
    if (gw + NGW < R) PA_LOAD(p2, gw + NGW);
    for (int r = gw; r < R; r += NGW) {
        const int cr = row_cr(r);
        const float* mod = WSP(const float, SM_MOD) + ((size_t)l * 5 + cr) * 6144;
        f32x4 v[4]; float s = 0.f;
#pragma unroll
        for (int j = 0; j < 4; ++j) { v[j] = p1[j]; p1[j] = p2[j]; }
        if (r + 2 * NGW < R) PA_LOAD(p2, r + 2 * NGW);
#pragma unroll
        for (int j = 0; j < 4; ++j) s += (v[j].x * v[j].x + v[j].y * v[j].y) + (v[j].z * v[j].z + v[j].w * v[j].w);
        f32x4 sh4[4], sc4[4];
#pragma unroll
        for (int j = 0; j < 4; ++j) { const int k = 4 * (lane + 64 * j); sh4[j] = *(const GAS f32x4*)((const GAS float*)mod + k); sc4[j] = *(const GAS f32x4*)((const GAS float*)mod + 1024 + k); }
        const float rstd = 1.0f / sqrtf(wave_sum(s) * (1.f / D) + EPS);
        float d8[8] = {0, 0, 0, 0, 0, 0, 0, 0};
        unsigned long long* o8 = (unsigned long long*)(WSP(bf16, WS_H) + (size_t)r * D) + lane;
#pragma unroll
        for (int j = 0; j < 4; ++j) { const int k = 4 * (lane + 64 * j);
            const f32x4 w4 = nw4[j], sh = sh4[j], sc = sc4[j];
            f32x4 h = (v[j] * rstd) * w4 * (sc + 1.0f) + sh;
            o8[64 * j] = (unsigned long long)pk2(h.x, h.y) | ((unsigned long long)pk2(h.z, h.w) << 32);
#pragma unroll
            for (int e = 0; e < 4; ++e) { const f32x4 wa = *(const LAS f32x4*)(wdt + (k + e) * 8), wb = *(const LAS f32x4*)(wdt + (k + e) * 8 + 4); const float hv = h[e];
                d8[0] += hv * wa.x; d8[1] += hv * wa.y; d8[2] += hv * wa.z; d8[3] += hv * wa.w; d8[4] += hv * wb.x; d8[5] += hv * wb.y; d8[6] += hv * wb.z; d8[7] += hv * wb.w; } }
#pragma unroll
        for (int e = 0; e < 8; ++e) d8[e] = wave_sum(d8[e]);
        if (lane == 0) { float* dt = WSP(float, SM_DT) + (size_t)r * 8; *(f32x4*)dt = (f32x4){d8[0], d8[1], d8[2], d8[3]}; *(f32x4*)(dt + 4) = (f32x4){d8[4], d8[5], d8[6], d8[7]}; }
    }
    __syncthreads();
}

__device__ __forceinline__ void nbr_valid(int r, bool& vp, bool& vn) { const int s = r % RPB; vp = (s != 0) && (s != CTXL); vn = (s != CTXL - 1) && (s != RPB - 1); }

__device__ __forceinline__ void conv_a_pass(Fr& F, int l) { KA_DECL;
    const int gt = F.bid * 512 + F.tid, NGT = F.G * 512;
    bf16* P = WSP(bf16, BG_PROJ);
    const float* cw = KA->in[I_CAW] + l * 3 * 256; const float* cb = KA->in[I_CAB] + l * 256;
    for (int e = gt; e < R * 32; e += NGT) {
        const int r = e >> 5, c0 = (e & 31) * 8; bool vp, vn; nbr_valid(r, vp, vn);
        bf16* row = P + (size_t)r * NP;
        const u32x4 zc = {0, 0, 0, 0};
        const u32x4 ac0 = *(const u32x4*)(row + C_AC + c0), ax0 = *(const u32x4*)(row + C_AX + c0), ab = *(const u32x4*)(row + C_AB + c0);
        const u32x4 acp = vp ? *(const u32x4*)(row - NP + C_AC + c0) : zc, axp = vp ? *(const u32x4*)(row - NP + C_AX + c0) : zc;
        const u32x4 acn = vn ? *(const u32x4*)(row + NP + C_AC + c0) : zc, axn = vn ? *(const u32x4*)(row + NP + C_AX + c0) : zc;
        u32x4 o;
#pragma unroll
        for (int q = 0; q < 4; ++q) { float y[2];
#pragma unroll
            for (int hh = 0; hh < 2; ++hh) { const int c = c0 + 2 * q + hh;
                const float up = hh ? bfhi(acp[q]) * bfhi(axp[q]) : bflo(acp[q]) * bflo(axp[q]);
                const float u0 = hh ? bfhi(ac0[q]) * bfhi(ax0[q]) : bflo(ac0[q]) * bflo(ax0[q]);
                const float un = hh ? bfhi(acn[q]) * bfhi(axn[q]) : bflo(acn[q]) * bflo(axn[q]);
                const float b_ = hh ? bfhi(ab[q]) : bflo(ab[q]);
                y[hh] = b_ * (cb[c] + cw[c] * up + cw[256 + c] * u0 + cw[512 + c] * un); }
            o[q] = pk2(y[0], y[1]); }
        *(u32x4*)(row + C_AB + c0) = o;
    }
}
__device__ __forceinline__ void conv_xbc_pass(Fr& F, int l) { KA_DECL;
    const int gt = F.bid * 512 + F.tid, NGT = F.G * 512;
    bf16* P = WSP(bf16, BG_PROJ);
    const float* cw = KA->in[I_SCW] + l * 3 * 512; const float* cb = KA->in[I_SCB] + l * 512;
    for (int e = gt; e < R * 64; e += NGT) {
        const int r = e >> 6, c0 = (e & 63) * 8; bool vp, vn; nbr_valid(r, vp, vn);
        bf16* row = P + (size_t)r * NP;
        const u32x4 zc = {0, 0, 0, 0};
        const u32x4 x0 = *(const u32x4*)(row + C_XBC + c0);
        const u32x4 xp = vp ? *(const u32x4*)(row - NP + C_XBC + c0) : zc, xn = vn ? *(const u32x4*)(row + NP + C_XBC + c0) : zc;
        u32x4 o;
#pragma unroll
        for (int q = 0; q < 4; ++q) { float y[2];
#pragma unroll
            for (int hh = 0; hh < 2; ++hh) { const int c = c0 + 2 * q + hh;
                const float a = hh ? bfhi(xp[q]) : bflo(xp[q]), b_ = hh ? bfhi(x0[q]) : bflo(x0[q]), n_ = hh ? bfhi(xn[q]) : bflo(xn[q]);
                y[hh] = siluf_(cb[c] + cw[c] * a + cw[512 + c] * b_ + cw[1024 + c] * n_); }
            o[q] = pk2(y[0], y[1]); }
        *(u32x4*)(row + (c0 < 256 ? C_XS + c0 : C_BC + (c0 - 256))) = o;
    }
    for (int e = gt; e < R * 8; e += NGT) { float* p = WSP(float, SM_DT) + e; const float x = *p + KA->in[I_DTB][l * 8 + (e & 7)]; *p = x > 15.f ? x : __logf(1.0f + __expf(x)); }
}

template <class Fn>
__device__ __forceinline__ void dyn_tickets(Fr& F, unsigned* cnt, int nt, Fn fn) {
    volatile LAS int* tk = (volatile LAS int*)(F.lds + MISC_OFF + 512);
    int t_ = F.tid; asm volatile("" : "+v"(t_));
    if (t_ == 0) tk[0] = (int)__hip_atomic_fetch_add(cnt, 1u, __ATOMIC_RELAXED, __HIP_MEMORY_SCOPE_AGENT);
    __syncthreads();
    int c = __builtin_amdgcn_readfirstlane(tk[0]), it = 0;
    while (c < nt) {
        unsigned nxt = 0u; if (t_ == 0) nxt = __hip_atomic_fetch_add(cnt, 1u, __ATOMIC_RELAXED, __HIP_MEMORY_SCOPE_AGENT);
        fn(c);
        ++it; if (t_ == 0) tk[it & 1] = (int)nxt;
        __syncthreads();
        c = __builtin_amdgcn_readfirstlane(tk[it & 1]);
    }
}
__device__ __forceinline__ void moe_convert_tickets(Fr& F, int l, int w2) { KA_DECL;
    unsigned* wq = WSP(unsigned, WS_CTL) + CW_WQ + (8 + l * 2 + w2) * 64;
    __syncthreads();
    dyn_tickets(F, wq, w2 ? 512 : 1024, [&](int c) { moe_convert_item(F, l, (w2 ? 8192 : 0) + 8 * c + F.wave); });
}
__device__ __forceinline__ void conv_a_chunk(Fr& F, int l, int c) { KA_DECL;
    int t_ = F.tid; asm volatile("" : "+v"(t_));
    const int r0 = 64 * c + 4 * (t_ >> 5), c0 = (t_ & 31) * 8, s0 = r0 % RPB;
    const bool vp = (s0 != 0) && (s0 != CTXL), vn = (s0 + 4 != CTXL) && (s0 + 4 != RPB);
    GAS bf16* row = (GAS bf16*)(WSP(bf16, BG_PROJ) + (size_t)r0 * NP + c0);
    const float* cw = KA->in[I_CAW] + l * 3 * 256 + c0; const float* cb = KA->in[I_CAB] + l * 256 + c0;
    const u32x4 zc = {0, 0, 0, 0};
    u32x4 ac[6], ax[6], ab[4];
    ac[0] = vp ? *(const GAS u32x4*)(row - NP + C_AC) : zc; ax[0] = vp ? *(const GAS u32x4*)(row - NP + C_AX) : zc;
#pragma unroll
    for (int i = 0; i < 4; ++i) { ac[i + 1] = *(const GAS u32x4*)(row + (size_t)i * NP + C_AC); ax[i + 1] = *(const GAS u32x4*)(row + (size_t)i * NP + C_AX); ab[i] = *(const GAS u32x4*)(row + (size_t)i * NP + C_AB); }
    ac[5] = vn ? *(const GAS u32x4*)(row + (size_t)4 * NP + C_AC) : zc; ax[5] = vn ? *(const GAS u32x4*)(row + (size_t)4 * NP + C_AX) : zc;
    float wb[8], w0[8], w1[8], w2[8];
#pragma unroll
    for (int j = 0; j < 8; j += 4) { const f32x4 a = *(const f32x4*)(cb + j), b = *(const f32x4*)(cw + j), d = *(const f32x4*)(cw + 256 + j), e = *(const f32x4*)(cw + 512 + j);
#pragma unroll
        for (int i = 0; i < 4; ++i) { wb[j + i] = a[i]; w0[j + i] = b[i]; w1[j + i] = d[i]; w2[j + i] = e[i]; } }
    float u[6][8];
#pragma unroll
    for (int i = 0; i < 6; ++i)
#pragma unroll
        for (int q = 0; q < 4; ++q) { u[i][2 * q] = bflo(ac[i][q]) * bflo(ax[i][q]); u[i][2 * q + 1] = bfhi(ac[i][q]) * bfhi(ax[i][q]); }
#pragma unroll
    for (int i = 0; i < 4; ++i) { u32x4 o;
#pragma unroll
        for (int q = 0; q < 4; ++q) { const int j = 2 * q;
            const float y0 = bflo(ab[i][q]) * (wb[j] + w0[j] * u[i][j] + w1[j] * u[i + 1][j] + w2[j] * u[i + 2][j]);
            const float y1 = bfhi(ab[i][q]) * (wb[j + 1] + w0[j + 1] * u[i][j + 1] + w1[j + 1] * u[i + 1][j + 1] + w2[j + 1] * u[i + 2][j + 1]);
            o[q] = pk2(y0, y1); }
        *(GAS u32x4*)(row + (size_t)i * NP + C_AB) = o; }
}
__device__ __forceinline__ void conv_xbc_chunk(Fr& F, int l, int c) { KA_DECL;
    int t_ = F.tid; asm volatile("" : "+v"(t_));
    const int r0 = 64 * c + 8 * (t_ >> 6), c0 = (t_ & 63) * 8, s0 = r0 % RPB;
    const bool vp = (s0 != 0) && (s0 != CTXL), vn = (s0 + 8 != CTXL) && (s0 + 8 != RPB);
    GAS bf16* row = (GAS bf16*)(WSP(bf16, BG_PROJ) + (size_t)r0 * NP);
    const float* cw = KA->in[I_SCW] + l * 3 * 512 + c0; const float* cb = KA->in[I_SCB] + l * 512 + c0;
    const u32x4 zc = {0, 0, 0, 0};
    u32x4 x[10];
    x[0] = vp ? *(const GAS u32x4*)(row - NP + C_XBC + c0) : zc;
#pragma unroll
    for (int i = 0; i < 8; ++i) x[i + 1] = *(const GAS u32x4*)(row + (size_t)i * NP + C_XBC + c0);
    x[9] = vn ? *(const GAS u32x4*)(row + (size_t)8 * NP + C_XBC + c0) : zc;
    {   float* p = WSP(float, SM_DT) + (size_t)c * 512 + t_; const float xx = *p + KA->in[I_DTB][l * 8 + (t_ & 7)]; *p = xx > 15.f ? xx : __logf(1.0f + __expf(xx)); }
    float wb[8], w0[8], w1[8], w2[8];
#pragma unroll
    for (int j = 0; j < 8; j += 4) { const f32x4 a = *(const f32x4*)(cb + j), b = *(const f32x4*)(cw + j), d = *(const f32x4*)(cw + 512 + j), e = *(const f32x4*)(cw + 1024 + j);
#pragma unroll
        for (int i = 0; i < 4; ++i) { wb[j + i] = a[i]; w0[j + i] = b[i]; w1[j + i] = d[i]; w2[j + i] = e[i]; } }
    const int oc = c0 < 256 ? C_XS + c0 : C_BC + (c0 - 256);
#pragma unroll
    for (int i = 0; i < 8; ++i) { u32x4 o;
#pragma unroll
        for (int q = 0; q < 4; ++q) { const int j = 2 * q;
            const float y0 = siluf_(wb[j] + w0[j] * bflo(x[i][q]) + w1[j] * bflo(x[i + 1][q]) + w2[j] * bflo(x[i + 2][q]));
            const float y1 = siluf_(wb[j + 1] + w0[j + 1] * bfhi(x[i][q]) + w1[j + 1] * bfhi(x[i + 1][q]) + w2[j + 1] * bfhi(x[i + 2][q]));
            o[q] = pk2(y0, y1); }
        *(GAS u32x4*)(row + (size_t)i * NP + oc) = o; }
}

template <int MIX  , bool OUT>
__device__ __forceinline__ void span_task(Fr& F, int l, int span) { KA_DECL;
    const int b = span / SPB, sp = span - b * SPB, row0 = b * RPB + sp * 64;
    const int w = F.wave, h = w >> 1, dir = w & 1, lane = F.lane, g = h >> 1;
    bf16* P = WSP(bf16, BG_PROJ) + (size_t)row0 * NP;
    const float* DT = WSP(const float, SM_DT) + (size_t)row0 * 8 + dir * 4 + h;
    float* STp = WSP(float, BG_ST) + ((size_t)((b * 8 + w) * SPB + sp)) * 4096 + lane;
    LAS float* E = (LAS float*)F.lds;
    LAS float* SSQ = (LAS float*)(F.lds + 65536);
    float S[64];
    if (OUT) {
#pragma unroll
        for (int k = 0; k < 64; ++k) S[k] = STp[k * 64];
    } else {
#pragma unroll
        for (int k = 0; k < 64; ++k) S[k] = 0.f;
    }
    float lb = 0.f, dtb = 0.f, Aexp = 0.f, Dh = 0.f;
    if (MIX == 0) { if (l > 0) { const float a0 = KA->in[I_HLB][(dir * DEPTH + 0) * 256 + h * 64 + lane], a1 = KA->in[I_HLB][(dir * DEPTH + l) * 256 + h * 64 + lane]; lb = 1.0f / (1.0f + __expf(a0 - a1)); } }
    else { dtb = KA->in[I_DTB][(l * 2 + dir) * 4 + h]; Aexp = __expf(KA->in[I_ALOG][(l * 2 + dir) * 4 + h]); Dh = KA->in[I_SD][l * 4 + h]; }
    const float oml = 1.0f - lb;
    float dec = 1.0f;
    const int c1 = MIX == 0 ? C_FF + dir * 256 + h * 64 + lane : C_XS + h * 64 + lane;
    const int c2 = MIX == 0 ? C_I + h * 64 + lane : C_BC + g * 64 + lane;
    const int c3 = MIX == 0 ? C_Q + h * 64 + lane : C_BC + 128 + g * 64 + lane;
    const int c4 = C_Z + h * 64 + lane;
    constexpr int BS = (MIX == 1 && OUT) ? 4 : 8;
    unsigned short n1[BS], n2[BS], n3[BS], n4[BS]; float ndt[BS];
    unsigned short r1[BS], r2[BS], r3[BS], r4[BS]; float rdt[BS];
#pragma unroll
    for (int s_ = 0; s_ < BS; ++s_) { n1[s_] = 0; n2[s_] = 0; n3[s_] = 0; n4[s_] = 0; ndt[s_] = 0.f; }
    const int tstep = dir ? -1 : 1, t0 = dir ? 63 : 0;
#define SP_LOAD(blk) do { const bf16* rb_ = P + (long)(t0 + (blk) * BS * tstep) * NP; const float* db_ = DT + (long)(t0 + (blk) * BS * tstep) * 8; asm volatile("" : "+v"(rb_), "+v"(db_)); \
        _Pragma("unroll") for (int s_ = 0; s_ < BS; ++s_) { const bf16* rp_ = rb_ + (long)(s_ * tstep) * NP; \
        n1[s_] = rp_[c1]; n2[s_] = rp_[c2]; if (OUT || MIX == 1) n3[s_] = rp_[c3]; if (MIX == 1) { ndt[s_] = db_[(long)(s_ * tstep) * 8]; if (OUT) n4[s_] = rp_[c4]; } } } while (0)
    SP_LOAD(0);
    for (int blk = 0; blk < 64 / BS; ++blk) {
#pragma unroll
        for (int s_ = 0; s_ < BS; ++s_) { r1[s_] = n1[s_]; r2[s_] = n2[s_]; r3[s_] = n3[s_]; r4[s_] = n4[s_]; rdt[s_] = ndt[s_]; }
        if (blk < 64 / BS - 1) SP_LOAD(blk + 1);
        if (OUT && blk == 32 / BS) __syncthreads();
#pragma unroll
        for (int s = 0; s < BS; ++s) {
            const int i = blk * BS + s; const int tt = dir ? 63 - i : i;
            float o = 0.f, xv = 0.f;
            if (MIX == 0) {
                const float fr_ = bf2f(r1[s]), vv = bf2f(r2[s]);
                const float sg = sigmoidf_(fr_), fg = lb + oml * sg;
                float qq = 0.f; if (OUT) { const float qr = bf2f(r3[s]); qq = siluf_(qr); }
                dec *= fg;
                int fgi = __builtin_bit_cast(int, fg), qqi = __builtin_bit_cast(int, qq);
#pragma unroll
                for (int k = 0; k < 64; ++k) { const float f_ = __builtin_bit_cast(float, __builtin_amdgcn_readlane(fgi, k));
                    S[k] = vv + f_ * (S[k] - vv);
                    if (OUT) { const float q_ = __builtin_bit_cast(float, __builtin_amdgcn_readlane(qqi, k)); o += q_ * S[k]; }
                    if ((k & 7) == 7) asm volatile("" : "+v"(fgi), "+v"(qqi), "+v"(S[k - 7]), "+v"(S[k - 6]), "+v"(S[k - 5]), "+v"(S[k - 4]), "+v"(S[k - 3]), "+v"(S[k - 2]), "+v"(S[k - 1]), "+v"(S[k])); }
            } else {
                xv = bf2f(r1[s]); const float Bv = bf2f(r2[s]), Cv = bf2f(r3[s]);
                const float dt = softplusf_(rdt[s] + dtb), a = __expf(-dt * Aexp), bdt = Bv * dt;
                dec *= a;
                int bdi = __builtin_bit_cast(int, bdt), cvi = __builtin_bit_cast(int, Cv);
#pragma unroll
                for (int k = 0; k < 64; ++k) { const float b_ = __builtin_bit_cast(float, __builtin_amdgcn_readlane(bdi, k));
                    S[k] = a * S[k] + b_ * xv;
                    if (OUT) { const float c_ = __builtin_bit_cast(float, __builtin_amdgcn_readlane(cvi, k)); o += c_ * S[k]; }
                    if ((k & 7) == 7) asm volatile("" : "+v"(bdi), "+v"(cvi), "+v"(S[k - 7]), "+v"(S[k - 6]), "+v"(S[k - 5]), "+v"(S[k - 4]), "+v"(S[k - 3]), "+v"(S[k - 2]), "+v"(S[k - 1]), "+v"(S[k])); }
            }
            if (OUT) {
                if (i < 32) E[(w * 32 + i) * 64 + lane] = o;
                else { LAS float* slot = E + ((w ^ 1) * 32 + (63 - i)) * 64 + lane;
                    float tot = o + *slot;
                    if (MIX == 1) { const float z = bf2f(r4[s]); tot = (tot + Dh * xv) * siluf_(z); }
                    const float q2 = wave_sum(tot * tot);
                    if (lane == 0) SSQ[h * 64 + tt] = q2;
                    *slot = tot; }
            }
        }
    }
#undef SP_LOAD
    if (!OUT) {
#pragma unroll
        for (int k = 0; k < 64; ++k) STp[k * 64] = S[k];
        WSP(float, SM_DEC)[((size_t)((b * 8 + w) * SPB + sp)) * 64 + lane] = dec;
    } else {
        __syncthreads();
        const float* nwp = MIX == 0 ? KA->in[I_HNW] + l * 64 : KA->in[I_SNW] + l * 256;
        const float nwc = MIX == 0 ? nwp[F.tid & 63] : nwp[F.tid & 255];
#pragma unroll 4
        for (int it = 0; it < 32; ++it) { const int e = it * 512 + F.tid, tt = e >> 8, ch = e & 255, hh = ch >> 6, dv = ch & 63;
            const float v = tt < 32 ? E[((2 * hh) * 32 + tt) * 64 + dv] : E[((2 * hh + 1) * 32 + (63 - tt)) * 64 + dv];
            float y;
            if (MIX == 0) { const float rs = 1.0f / sqrtf(SSQ[hh * 64 + tt] * (1.f / 64.f) + EPS); const float gr = bf2f(P[(size_t)tt * NP + C_G + ch]); y = v * rs * nwc * siluf_(gr); }
            else { const int g2 = hh >> 1; const float rs = 1.0f / sqrtf((SSQ[(2 * g2) * 64 + tt] + SSQ[(2 * g2 + 1) * 64 + tt]) * (1.f / 128.f) + EPS); y = v * rs * nwc; }
            P[(size_t)tt * NP + (MIX == 0 ? C_Q : C_Z) + ch] = (bf16)f2bf(y); }
        __syncthreads();
    }
}
__device__ __forceinline__ bf16x8 pack8(float a0, float a1, float a2, float a3, float a4, float a5, float a6, float a7) {
    u32x4 w; w.x = pk2(a0, a1); w.y = pk2(a2, a3); w.z = pk2(a4, a5); w.w = pk2(a6, a7); return __builtin_bit_cast(bf16x8, w); }
template <int MIX  , bool OUT>
__device__ __forceinline__ void span_task_mfma(Fr& F, int l, int span) { KA_DECL;
    const int b = span / SPB, sp = span - b * SPB, row0 = b * RPB + sp * 64;
    const int w = F.wave, h = w >> 1, dir = w & 1, lane = F.lane, g = h >> 1, gq = lane >> 4, li = lane & 15;
    bf16* P = WSP(bf16, BG_PROJ) + (size_t)row0 * NP;
    const float* DT = WSP(const float, SM_DT) + (size_t)row0 * 8 + dir * 4 + h;
    bf16* STb = WSP(bf16, MIX ? BG_ST2 : BG_ST) + ((size_t)((b * 8 + w) * SPB + sp)) * 4096;
    LAS float* E = (LAS float*)F.lds;
    LAS float* SSQ = (LAS float*)(F.lds + 65536);
    LAS unsigned char* WL = F.lds + 66560 + w * 8960;
    LAS bf16* QT = (LAS bf16*)WL; LAS bf16* KT = (LAS bf16*)(WL + 2304); LAS bf16* KH = (LAS bf16*)(WL + 4608); LAS bf16* VT = (LAS bf16*)(WL + 6656); LAS float* DV = (LAS float*)(WL + 8704);
    f32x4 S[4][4];
#pragma unroll
    for (int kb = 0; kb < 4; ++kb)
#pragma unroll
        for (int m = 0; m < 4; ++m)
#pragma unroll
            for (int r = 0; r < 4; ++r) S[kb][m][r] = 0.f;
    if (OUT) {
#pragma unroll
        for (int kb = 0; kb < 4; ++kb)
#pragma unroll
            for (int m = 0; m < 4; ++m) { const u32x2 s2 = *(const u32x2*)(STb + ((kb * 4 + m) * 64 + lane) * 4); S[kb][m] = (f32x4){bflo(s2.x), bfhi(s2.x), bflo(s2.y), bfhi(s2.y)}; } }
    float lb = 0.f, dtb = 0.f, Aexp = 0.f, Dh = 0.f;
    if (MIX == 0) { if (l > 0) { const float a0 = KA->in[I_HLB][(dir * DEPTH + 0) * 256 + h * 64 + lane], a1 = KA->in[I_HLB][(dir * DEPTH + l) * 256 + h * 64 + lane]; lb = 1.0f / (1.0f + __expf(a0 - a1)); } }
    else { dtb = KA->in[I_DTB][(l * 2 + dir) * 4 + h]; Aexp = __expf(KA->in[I_ALOG][(l * 2 + dir) * 4 + h]); Dh = KA->in[I_SD][l * 4 + h]; }
    const float oml = 1.0f - lb;
    float dtot = 1.0f;
    const int c1 = MIX == 0 ? C_FF + dir * 256 + h * 64 + lane : C_XS + h * 64 + lane;
    const int c2 = MIX == 0 ? C_I + h * 64 + lane : C_BC + g * 64 + lane;
    const int c3 = MIX == 0 ? C_Q + h * 64 + lane : C_BC + 128 + g * 64 + lane;
    const int tstep = dir ? -1 : 1, t0 = dir ? 63 : 0;
    unsigned short n1[16], n2[16], n3[16]; float ndt[16];
#pragma unroll
    for (int i = 0; i < 16; ++i) { n1[i] = 0; n2[i] = 0; n3[i] = 0; ndt[i] = 0.f; }
#define SM_LOAD(c) do { unsigned long long rbi_ = (unsigned long long)(P + (long)(t0 + (c) * 16 * tstep) * NP), dbi_ = (unsigned long long)(DT + (long)(t0 + (c) * 16 * tstep) * 8); asm volatile("" : "+v"(rbi_), "+v"(dbi_)); \
        const GAS bf16* rb_ = (const GAS bf16*)rbi_; const GAS float* db_ = (const GAS float*)dbi_;     \
        _Pragma("unroll") for (int i_ = 0; i_ < 16; ++i_) { const GAS bf16* rp_ = rb_ + (long)(i_ * tstep) * NP; n1[i_] = rp_[c1]; n2[i_] = rp_[c2]; if (OUT || MIX == 1) n3[i_] = rp_[c3]; if (MIX == 1) ndt[i_] = db_[(long)(i_ * tstep) * 8]; } } while (0)
    constexpr bool PF = !(MIX == 1 && OUT);
    if (PF) SM_LOAD(0);
    for (int c = 0; c < 4; ++c) {
        if (!PF) SM_LOAD(c);
#define r1 n1
#define r2 n2
#define r3 n3
#define rdt ndt
        if (OUT && c == 2) __syncthreads();
        float cl = 0.f, clv[16], kkv[16];
#pragma unroll
        for (int i = 0; i < 16; ++i) { float lf, kk, qq = 0.f;
            if (MIX == 0) { const float fr_ = bf2f(r1[i]); const float sg = sigmoidf_(fr_), fg = lb + oml * sg; lf = __logf(fg); kk = 1.0f - fg; if (OUT) qq = siluf_(bf2f(r3[i])); }
            else { const float dt = rdt[i]; lf = -dt * Aexp; kk = bf2f(r2[i]) * dt; qq = bf2f(r3[i]); }
            cl += lf; clv[i] = cl; kkv[i] = kk;
            if (OUT) { QT[i * 72 + lane] = (bf16)f2bf(qq * __expf(cl)); KT[i * 72 + lane] = (bf16)f2bf(kk * __expf(fminf(-cl, 60.f))); } }
        {   float kh[16];
#pragma unroll
            for (int i = 0; i < 16; ++i) kh[i] = kkv[i] * __expf(cl - clv[i]);
            *(LAS bf16x8*)(KH + lane * 16) = pack8(kh[0], kh[1], kh[2], kh[3], kh[4], kh[5], kh[6], kh[7]); *(LAS bf16x8*)(KH + lane * 16 + 8) = pack8(kh[8], kh[9], kh[10], kh[11], kh[12], kh[13], kh[14], kh[15]);
            u32x4 v0, v1;
#define VR(i) ((unsigned)(MIX == 0 ? r2[i] : r1[i]))
            v0.x = VR(0) | (VR(1) << 16); v0.y = VR(2) | (VR(3) << 16); v0.z = VR(4) | (VR(5) << 16); v0.w = VR(6) | (VR(7) << 16);
            v1.x = VR(8) | (VR(9) << 16); v1.y = VR(10) | (VR(11) << 16); v1.z = VR(12) | (VR(13) << 16); v1.w = VR(14) | (VR(15) << 16);
#undef VR
            *(LAS u32x4*)(VT + lane * 16) = v0; *(LAS u32x4*)(VT + lane * 16 + 8) = v1;
            const float Dd = __expf(cl); DV[lane] = Dd; dtot *= Dd; }
#undef r1
#undef r2
#undef r3
#undef rdt
        if (PF && c < 3) SM_LOAD(c + 1);
        LDS_WAIT(); asm volatile("" ::: "memory");
        if (OUT) {
            const int tau = 16 * c + li, tt = dir ? 63 - tau : tau;
            u32x2 fx[4], fz[4];
#pragma unroll
            for (int m = 0; m < 4; ++m) { fx[m] = (u32x2){0u, 0u}; fz[m] = (u32x2){0u, 0u}; }
            if (c >= 2) { const GAS bf16* Pg = (const GAS bf16*)P + (size_t)tt * NP + h * 64 + 4 * gq;
#pragma unroll
                for (int m = 0; m < 4; ++m) { if (MIX == 1) { fx[m] = *(const GAS u32x2*)(Pg + C_XS + 16 * m); fz[m] = *(const GAS u32x2*)(Pg + C_Z + 16 * m); } else fx[m] = *(const GAS u32x2*)(Pg + C_G + 16 * m); } }
            f32x4 Pm = {0.f, 0.f, 0.f, 0.f};
#pragma unroll
            for (int ks = 0; ks < 2; ++ks) Pm = __builtin_amdgcn_mfma_f32_16x16x32_bf16(*(const LAS bf16x8*)(KT + li * 72 + 32 * ks + 8 * gq), *(const LAS bf16x8*)(QT + li * 72 + 32 * ks + 8 * gq), Pm, 0, 0, 0);
#pragma unroll
            for (int r = 0; r < 4; ++r) if (4 * gq + r > li) Pm[r] = 0.f;
            const bf16x8 pb = pack8(Pm[0], Pm[1], Pm[2], Pm[3], 0.f, 0.f, 0.f, 0.f);
            f32x4 oT[4];
#pragma unroll
            for (int m = 0; m < 4; ++m) { const u32x2 vv = *(const LAS u32x2*)(VT + (16 * m + li) * 16 + 4 * gq); const u32x4 av = {vv.x, vv.y, 0u, 0u};
                oT[m] = __builtin_amdgcn_mfma_f32_16x16x32_bf16(__builtin_bit_cast(bf16x8, av), pb, (f32x4){0.f, 0.f, 0.f, 0.f}, 0, 0, 0); }
#pragma unroll
            for (int ks = 0; ks < 2; ++ks) { const u32x2 q0 = *(const LAS u32x2*)(QT + li * 72 + 32 * ks + 4 * gq), q1 = *(const LAS u32x2*)(QT + li * 72 + 32 * ks + 16 + 4 * gq); const u32x4 bq = {q0.x, q0.y, q1.x, q1.y};
#pragma unroll
                for (int m = 0; m < 4; ++m) { const f32x4 s0 = S[2 * ks][m], s1 = S[2 * ks + 1][m];
                    oT[m] = __builtin_amdgcn_mfma_f32_16x16x32_bf16(pack8(s0[0], s0[1], s0[2], s0[3], s1[0], s1[1], s1[2], s1[3]), __builtin_bit_cast(bf16x8, bq), oT[m], 0, 0, 0); } }
            if (c < 2) {
#pragma unroll
                for (int m = 0; m < 4; ++m) *(LAS f32x4*)(E + (w * 32 + tau) * 64 + 4 * (((4 * m + gq) ^ tau) & 15)) = oT[m];
            } else { float q2 = 0.f;
#pragma unroll
                for (int m = 0; m < 4; ++m) { LAS f32x4* slot = (LAS f32x4*)(E + ((w ^ 1) * 32 + (63 - tau)) * 64 + 4 * (((4 * m + gq) ^ (63 - tau)) & 15));
                    f32x4 tot = oT[m] + *slot;
                    if (MIX == 1) { const u32x2 xx = fx[m], zz = fz[m];
                        const f32x4 xv = {bflo(xx.x), bfhi(xx.x), bflo(xx.y), bfhi(xx.y)}; const f32x4 zv = {bflo(zz.x), bfhi(zz.x), bflo(zz.y), bfhi(zz.y)};
                        tot = tot + xv * Dh; tot.x *= siluf_(zv.x); tot.y *= siluf_(zv.y); tot.z *= siluf_(zv.z); tot.w *= siluf_(zv.w); }
                    q2 += (tot.x * tot.x + tot.y * tot.y) + (tot.z * tot.z + tot.w * tot.w);
                    *slot = tot; }
                q2 += __shfl_xor(q2, 16); q2 += __shfl_xor(q2, 32);
                if (MIX == 1) { if (gq == 0) SSQ[h * 64 + tt] = q2; }
                else {
                    const float rs = 1.0f / sqrtf(q2 * (1.f / 64.f) + EPS); const float* nwp = KA->in[I_HNW] + l * 64;
#pragma unroll
                    for (int m = 0; m < 4; ++m) { LAS f32x4* slot = (LAS f32x4*)(E + ((w ^ 1) * 32 + (63 - tau)) * 64 + 4 * (((4 * m + gq) ^ (63 - tau)) & 15));
                        const f32x4 tot = *slot; const u32x2 gg = fx[m]; const f32x4 nw4 = *(const f32x4*)(nwp + 16 * m + 4 * gq);
                        const f32x4 gv = {bflo(gg.x), bfhi(gg.x), bflo(gg.y), bfhi(gg.y)};
                        u32x2 o; o.x = pk2(tot.x * rs * nw4.x * siluf_(gv.x), tot.y * rs * nw4.y * siluf_(gv.y)); o.y = pk2(tot.z * rs * nw4.z * siluf_(gv.z), tot.w * rs * nw4.w * siluf_(gv.w));
                        *(u32x2*)(P + (size_t)tt * NP + C_Q + h * 64 + 16 * m + 4 * gq) = o; } } }
        }
        if (!OUT || c < 3) {
#pragma unroll
            for (int kb = 0; kb < 4; ++kb) { const f32x4 dd = *(const LAS f32x4*)(DV + 16 * kb + 4 * gq);
                const u32x4 z4 = {0u, 0u, 0u, 0u};
                const bf16x8 ak = gq < 2 ? *(const LAS bf16x8*)(KH + (16 * kb + li) * 16 + 8 * gq) : __builtin_bit_cast(bf16x8, z4);
#pragma unroll
                for (int m = 0; m < 4; ++m) { const bf16x8 bv = gq < 2 ? *(const LAS bf16x8*)(VT + (16 * m + li) * 16 + 8 * gq) : __builtin_bit_cast(bf16x8, z4);
                    S[kb][m] = __builtin_amdgcn_mfma_f32_16x16x32_bf16(ak, bv, S[kb][m] * dd, 0, 0, 0); } }
        }
        LDS_WAIT(); asm volatile("" ::: "memory");
    }
#undef SM_LOAD
    if (!OUT) {
#pragma unroll
        for (int kb = 0; kb < 4; ++kb)
#pragma unroll
            for (int m = 0; m < 4; ++m) { u32x2 s2; s2.x = pk2(S[kb][m][0], S[kb][m][1]); s2.y = pk2(S[kb][m][2], S[kb][m][3]); *(u32x2*)(STb + ((kb * 4 + m) * 64 + lane) * 4) = s2; }
        WSP(float, SM_DEC)[((size_t)((b * 8 + w) * SPB + sp)) * 64 + lane] = dtot;
    } else if (MIX == 0) { __syncthreads(); }
    else {
        __syncthreads();
        const float* nwp = MIX == 0 ? KA->in[I_HNW] + l * 64 : KA->in[I_SNW] + l * 256;
#pragma unroll 4
        for (int it = 0; it < 32; ++it) { const int e = it * 512 + F.tid, tt = e >> 8, ch = e & 255, hh = ch >> 6, dv = ch & 63;
            const int sl = tt < 32 ? tt : 63 - tt; const float v = E[((2 * hh + (tt < 32 ? 0 : 1)) * 32 + sl) * 64 + 4 * (((dv >> 2) ^ sl) & 15) + (dv & 3)];
            float y;
            if (MIX == 0) { const float rs = 1.0f / sqrtf(SSQ[hh * 64 + tt] * (1.f / 64.f) + EPS); const float gr = bf2f(P[(size_t)tt * NP + C_G + ch]); y = v * rs * nwp[dv] * siluf_(gr); }
            else { const int g2 = hh >> 1; const float rs = 1.0f / sqrtf((SSQ[(2 * g2) * 64 + tt] + SSQ[(2 * g2 + 1) * 64 + tt]) * (1.f / 128.f) + EPS); y = v * rs * nwp[ch]; }
            P[(size_t)tt * NP + (MIX == 0 ? C_Q : C_Z) + ch] = (bf16)f2bf(y); }
        __syncthreads();
    }
}
__device__ __forceinline__ void state_scan(Fr& F, int mix) { KA_DECL;
    for (int e = F.bid * 512 + F.tid; e < NB * 8 * 2048; e += F.G * 512) {
    const int bh = e >> 11, ip = e & 2047, idx = 2 * ip, dk = 16 * (idx >> 10) + 4 * ((idx >> 6) & 3) + (idx & 3), dir = bh & 1;
    unsigned* ST = (unsigned*)(KA->ws + (mix ? BG_ST2 : BG_ST)) + (size_t)bh * SPB * 2048 + ip; const float* DC = WSP(const float, SM_DEC) + (size_t)bh * SPB * 64 + dk;
    float st0 = 0.f, st1 = 0.f;
    const GAS unsigned* STg = (const GAS unsigned*)ST; const GAS float* DCg = (const GAS float*)DC;
    unsigned nl[12]; f32x2 nd[12];
#pragma unroll
    for (int j = 0; j < 12; ++j) { const int sx = dir ? (j < 4 ? 3 - j : 135 - j) : j; nl[j] = STg[(size_t)sx * 2048]; nd[j] = *(const GAS f32x2*)(DCg + sx * 64); }
    for (int p0 = 0; p0 < SPB; p0 += 12) {
        unsigned loc[12]; f32x2 d[12];
#pragma unroll
        for (int j = 0; j < 12; ++j) { loc[j] = nl[j]; d[j] = nd[j]; }
        if (p0 + 12 < SPB) {
#pragma unroll
            for (int j = 0; j < 12; ++j) { const int p = p0 + 12 + j, sx = dir ? (p < 4 ? 3 - p : 135 - p) : p; nl[j] = STg[(size_t)sx * 2048]; nd[j] = *(const GAS f32x2*)(DCg + sx * 64); } }
#pragma unroll
        for (int j = 0; j < 12; ++j) { const int p = p0 + j, sx = dir ? (p < 4 ? 3 - p : 135 - p) : p; if (DBG_NOCTX && p == 4) { st0 = 0.f; st1 = 0.f; }
            ST[(size_t)sx * 2048] = pk2(st0, st1); st0 = d[j].x * st0 + bflo(loc[j]); st1 = d[j].y * st1 + bfhi(loc[j]); }
    }
    }
}

__device__ __forceinline__ void lds_load_f32(Fr& F, const float* src, int n) {
    __syncthreads();
    int t_ = F.tid; asm volatile("" : "+v"(t_));
    for (int e = t_ * 4; e < n; e += 2048) *(LAS f32x4*)((LAS float*)F.lds + e) = *(const f32x4*)(src + e);
    __syncthreads();
}
constexpr int FFT_MAT = 69632;
template <int K>
__device__ __forceinline__ void lds_load_mat(Fr& F, const bf16* src) {
    __syncthreads();
    int t_ = F.tid; asm volatile("" : "+v"(t_));
    for (int c = t_; c < 128 * (K / 8); c += 512) { const int row = c / (K / 8), cc = c % (K / 8);
        *(LAS u32x4*)(F.lds + FFT_MAT + row * (K * 2 + 16) + cc * 16) = *(const u32x4*)(src + (size_t)row * K + cc * 8); }
    __syncthreads();
}
template <int STRIDE>
__device__ __forceinline__ bf16x8 fft_bop(const LAS unsigned short* dp) {
    u32x4 q;
    q.x = (unsigned)dp[0] | ((unsigned)dp[STRIDE / 2] << 16); q.y = (unsigned)dp[2 * (STRIDE / 2)] | ((unsigned)dp[3 * (STRIDE / 2)] << 16);
    q.z = (unsigned)dp[4 * (STRIDE / 2)] | ((unsigned)dp[5 * (STRIDE / 2)] << 16); q.w = (unsigned)dp[6 * (STRIDE / 2)] | ((unsigned)dp[7 * (STRIDE / 2)] << 16);
    return __builtin_bit_cast(bf16x8, q);
}
__device__ __forceinline__ void fft_stage_a(Fr& F, int unit) { KA_DECL;
    int t_ = F.tid; asm volatile("" : "+v"(t_));
    const int b = unit >> 7, t2 = unit & 127, lane = t_ & 63, w = __builtin_amdgcn_readfirstlane(t_ >> 6), n = lane & 31, ch = 32 * w + n, kh = lane >> 5;
    {   const GAS bf16* U = (const GAS bf16*)(WSP(const bf16, BG_PROJ) + ((size_t)b * RPB + CTXL + t2) * NP + C_UR);
        u32x4 v[8];
#pragma unroll
        for (int q = 0; q < 8; ++q) { const int c = t_ + 512 * q, k = c >> 5, cc = c & 31; v[q] = *(const GAS u32x4*)(U + (size_t)(128 * (k & 63)) * NP + (k >> 6) * 256 + cc * 8); }
        __syncthreads();
#pragma unroll
        for (int q = 0; q < 8; ++q) { const int c = t_ + 512 * q, k = c >> 5, cc = c & 31; *(LAS u32x4*)(F.lds + k * 528 + cc * 16) = v[q]; }
        __syncthreads(); }
    f32x16 acc[4];
#pragma unroll
    for (int m = 0; m < 4; ++m)
#pragma unroll
        for (int q = 0; q < 16; ++q) acc[m][q] = 0.f;
    const LAS unsigned short* dp = (const LAS unsigned short*)(F.lds + (8 * kh) * 528 + ch * 2);
    const LAS char* mp = (const LAS char*)(F.lds + FFT_MAT + n * 272 + 16 * kh);
#pragma unroll 2
    for (int s = 0; s < 8; ++s) { const bf16x8 bq = fft_bop<528>(dp + s * (16 * 264));
#pragma unroll
        for (int m = 0; m < 4; ++m) acc[m] = __builtin_amdgcn_mfma_f32_32x32x16_bf16(*(const LAS bf16x8*)(mp + (32 * m) * 272 + 32 * s), bq, acc[m], 0, 0, 0); }
    bf16* AP = WSP(bf16, BG_AP) + (size_t)b * 64 * 2 * 128 * 256;
    const float* TW = WSP(const float, SM_TW) + (size_t)t2 * 128;
#pragma unroll
    for (int m = 0; m < 2; ++m)
#pragma unroll
        for (int q = 0; q < 16; ++q) { const int k1 = 32 * m + (q & 3) + 8 * (q >> 2) + 4 * kh; const float c = TW[2 * k1], s = TW[2 * k1 + 1];
            const float ar = acc[m][q], ai = acc[m + 2][q];
            bf16* dst = AP + ((size_t)(k1 * 2) * 128 + t2) * 256 + ch;
            dst[0] = (bf16)f2bf(ar * c + ai * s); dst[128 * 256] = (bf16)f2bf(ai * c - ar * s); }
}
__device__ __forceinline__ void fft_stage_b(Fr& F, int unit) { KA_DECL;
    int t_ = F.tid; asm volatile("" : "+v"(t_));
    const int chh = unit & 1, k1 = (unit >> 1) & 63, b = unit >> 7, lane = t_ & 63, w = __builtin_amdgcn_readfirstlane(t_ >> 6), n = lane & 31, kh = lane >> 5, cbk = w & 3, mh = w >> 2;
    {   const GAS bf16* AP = (const GAS bf16*)(WSP(const bf16, BG_AP) + ((size_t)(b * 64 + k1) * 2) * 128 * 256 + chh * 128);
        u32x4 v[8];
#pragma unroll
        for (int q = 0; q < 8; ++q) { const int c = t_ + 512 * q, k = c >> 4, cc = c & 15; v[q] = *(const GAS u32x4*)(AP + (size_t)k * 256 + cc * 8); }
        __syncthreads();
#pragma unroll
        for (int q = 0; q < 8; ++q) { const int c = t_ + 512 * q, k = c >> 4, cc = c & 15; *(LAS u32x4*)(F.lds + k * 272 + cc * 16) = v[q]; }
        __syncthreads(); }
    f32x16 acc[2];
#pragma unroll
    for (int m = 0; m < 2; ++m)
#pragma unroll
        for (int q = 0; q < 16; ++q) acc[m][q] = 0.f;
    const LAS unsigned short* dp = (const LAS unsigned short*)(F.lds + (8 * kh) * 272 + (32 * cbk + n) * 2);
    const LAS char* mp = (const LAS char*)(F.lds + FFT_MAT + (64 * mh + n) * 528 + 16 * kh);
#pragma unroll 2
    for (int s = 0; s < 16; ++s) { const bf16x8 bq = fft_bop<272>(dp + s * (16 * 136));
#pragma unroll
        for (int m = 0; m < 2; ++m) acc[m] = __builtin_amdgcn_mfma_f32_32x32x16_bf16(*(const LAS bf16x8*)(mp + (32 * m) * 528 + 32 * s), bq, acc[m], 0, 0, 0); }
    bf16* P = WSP(bf16, BG_PROJ) + ((size_t)b * RPB + CTXL + k1) * NP + C_UR + chh * 128 + 32 * cbk + n;
    const float scale = 0.001381067932f;
#pragma unroll
    for (int m = 0; m < 2; ++m)
#pragma unroll
        for (int q = 0; q < 16; ++q) { const int k2 = 64 * mh + 32 * m + (q & 3) + 8 * (q >> 2) + 4 * kh; P[(size_t)(64 * k2) * NP] = (bf16)f2bf(acc[m][q] * scale); }
}
__device__ __forceinline__ void fft_ctx(Fr& F, int unit) { KA_DECL;
    const int b = unit >> 2, mq = unit & 3, lane = F.lane, w = F.wave, ch = 32 * w + (lane & 31), kh = lane >> 5;
    const bf16* U = WSP(const bf16, BG_PROJ) + ((size_t)b * RPB) * NP + C_UR + ch;
    const float* M3 = WSP(const float, SM_M3) + 64 * mq + (lane & 31);
    f32x16 acc[2];
#pragma unroll
    for (int m = 0; m < 2; ++m)
#pragma unroll
        for (int q = 0; q < 16; ++q) acc[m][q] = 0.f;
#pragma unroll 4
    for (int k0 = 0; k0 < 512; k0 += 2) { const int k = k0 + kh, ri = k >> 8, t = k & 255;
        const float bv = bf2f(U[(size_t)t * NP + ri * 256]);
#pragma unroll
        for (int m = 0; m < 2; ++m) acc[m] = __builtin_amdgcn_mfma_f32_32x32x2f32(M3[k * 256 + 32 * m], bv, acc[m], 0, 0, 0); }
    bf16* CY = WSP(bf16, SM_CY) + (size_t)b * 256 * 256 + ch;
#pragma unroll
    for (int m = 0; m < 2; ++m)
#pragma unroll
        for (int q = 0; q < 16; ++q) { const int tp = 64 * mq + 32 * m + (q & 3) + 8 * (q >> 2) + 4 * kh; CY[(size_t)tp * 256] = (bf16)f2bf(acc[m][q] * (1.0f / 128.0f)); }
}
__device__ __forceinline__ void ctx_y_copy(Fr& F) { KA_DECL;
    const int gt = F.bid * 512 + F.tid, NGT = F.G * 512;
    for (int e = gt; e < NB * 256 * 32; e += NGT) { const int b = e >> 13, t = (e >> 5) & 255, c0 = (e & 31) * 8;
        *(u32x4*)(WSP(bf16, BG_PROJ) + ((size_t)b * RPB + t) * NP + C_UR + c0) = *(const u32x4*)(WSP(const bf16, SM_CY) + ((size_t)b * 256 + t) * 256 + c0); }
}

__device__ __forceinline__ f32x4 ld_agent_f4(const float* p) {
    const unsigned long long a = __hip_atomic_load((const unsigned long long*)p, __ATOMIC_RELAXED, __HIP_MEMORY_SCOPE_AGENT), b = __hip_atomic_load((const unsigned long long*)p + 1, __ATOMIC_RELAXED, __HIP_MEMORY_SCOPE_AGENT);
    const f32x2 lo = __builtin_bit_cast(f32x2, a), hi = __builtin_bit_cast(f32x2, b); return (f32x4){lo.x, lo.y, hi.x, hi.y}; }
__device__ __forceinline__ void ctx_tile_finish(Fr& F, int l) { KA_DECL;
    const int task = F.bid, t16 = task >> 2, b = t16 >> 2, pn = t16 & 3;
    volatile LAS int* fl = (volatile LAS int*)(F.lds + MISC_OFF + 520);
    int t_ = F.tid; asm volatile("" : "+v"(t_));
    asm volatile("s_waitcnt vmcnt(0)" ::: "memory"); __builtin_amdgcn_fence(__ATOMIC_RELEASE, "workgroup"); __syncthreads();
    if (t_ == 0) fl[0] = (int)__hip_atomic_fetch_add(WSP(unsigned, WS_CTL) + CW_WQ + (l * 4 + 3) * 64 + t16, 1u, __ATOMIC_RELAXED, __HIP_MEMORY_SCOPE_AGENT);
    __syncthreads();
    if (fl[0] != 3) return;
    for (int e0 = t_; e0 < 256 * 32; e0 += 4 * 512) {
        f32x4 v[4][8];
#pragma unroll
        for (int i = 0; i < 4; ++i) { const int e = e0 + 512 * i, r = e >> 5, c8 = e & 31;
            const GAS float* s = (const GAS float*)(WSP(const float, BG_MF) + (size_t)(b * 256 + r) * D + pn * 256 + c8 * 8);
#pragma unroll
            for (int k = 0; k < 4; ++k) { v[i][2 * k] = ld_agent_f4((const float*)s + (size_t)k * (NB * CTXL * D)); v[i][2 * k + 1] = ld_agent_f4((const float*)s + (size_t)k * (NB * CTXL * D) + 4); } }
#pragma unroll
        for (int i = 0; i < 4; ++i) { const int e = e0 + 512 * i, r = e >> 5, c8 = e & 31;
            const f32x4 a = (v[i][0] + v[i][2]) + (v[i][4] + v[i][6]), d = (v[i][1] + v[i][3]) + (v[i][5] + v[i][7]);
            u32x4 w; w.x = pk2(a.x, a.y); w.y = pk2(a.z, a.w); w.z = pk2(d.x, d.y); w.w = pk2(d.z, d.w);
            *(u32x4*)(WSP(bf16, BG_MERGED) + ((size_t)b * RPB + r) * D + pn * 256 + c8 * 8) = w; } }
}
struct SchedGrid {
    const char* A; const char* B; unsigned lda, ldb; int nt, nM, nN, G, c; bool skip_ctx;
    __device__ __forceinline__ bool next(int i, ge::Unit& u) const {
        int pm, pn; if (!ge::tile_order((long)i * G + c, nM, nN, pm, pn)) return false;
        if (skip_ctx) pm = (pm >> 5) * 33 + 1 + (pm & 31);
        u.A = A + (size_t)pm * 256 * lda; u.B = B + (size_t)pn * 256 * ldb; u.rows = nullptr; u.lda = lda; u.ldb = ldb; u.nt = nt; u.kind = 0; u.pm = pm; u.pn = pn; u.aux = 256; return true; }
};
struct EpiStore {
    static constexpr bool PERM = true, DRAIN = false;
    bf16* O; int ldc;
    __device__ __forceinline__ void operator()(const f32x4 (&acc)[2][2][4][2], const ge::Unit& u, int wr, int wc, int fr, int fq, int tid) const {
        const int row0 = u.pm * 256 + wr * 64 + fr, col0 = u.pn * 256 + wc * 32 + 8 * fq;
#pragma unroll
        for (int ai = 0; ai < 2; ++ai)
#pragma unroll
            for (int m = 0; m < 4; ++m) { bf16* rowp = O + (size_t)(row0 + ai * 128 + m * 16) * ldc + col0;
#pragma unroll
                for (int bj = 0; bj < 2; ++bj) { const f32x4 v0 = acc[ai][bj][m][0], v1 = acc[ai][bj][m][1]; u32x4 w;
                    w.x = ge::cvt_pk_bf16(v0[0], v0[1]); w.y = ge::cvt_pk_bf16(v0[2], v0[3]); w.z = ge::cvt_pk_bf16(v1[0], v1[1]); w.w = ge::cvt_pk_bf16(v1[2], v1[3]);
                    *(u32x4*)(rowp + bj * 128) = w; } }
    }
};
struct SchedD1 {
    const char* H; const char* P; const char* Wg; const char* Wb; int nM, G, c, nlat; bool skip_ctx;
    __device__ __forceinline__ bool next(int i, ge::Unit& u) const {
        int ti = i >> 3, sub = i & 7, k = sub >> 1; int pm, pn; bool ctxu = false;
        if (ge::tile_order((long)ti * G + c, nM, 4, pm, pn)) pm = (pm >> 5) * 33 + 1 + (pm & 31);
        else { const int j = i - 8 * nlat;
            if (skip_ctx || c >= 64 || j < 0 || j >= 2) return false;
            pm = (c >> 4) * 33; pn = (c >> 2) & 3; k = c & 3; sub = j; ctxu = true; }
        u.rows = nullptr; u.pm = pm; u.pn = pn; u.aux = 256;
        if (!(sub & 1)) { u.A = H + (size_t)pm * 256 * 2048; u.lda = 2048; u.B = Wg + ((size_t)k * 1024 + pn * 256) * 2048; u.ldb = 2048; u.nt = 16; u.kind = 0; }
        else { const int colk = k == 0 ? C_AB : (k == 1 ? C_Q : (k == 2 ? C_UR : C_Z));
            u.A = P + (size_t)pm * 256 * (NP * 2) + colk * 2; u.lda = NP * 2; u.B = Wb + ((size_t)k * 1024 + pn * 256) * 512; u.ldb = 512; u.nt = 4; u.kind = (ctxu ? 5 : 1) + k; }
        return true; }
};
#ifndef DBG_L
#define DBG_L 0
#endif
#ifndef MOE_SCALE
#define MOE_SCALE 2.0f
#endif
#ifndef DBG_D1
#define DBG_D1 0
#endif
#ifndef BRMASK
#define BRMASK 15
#endif
struct EpiD1 {
    static constexpr bool PERM = true, DRAIN = false;
    bf16* M; unsigned char* scr; unsigned char* mscr; float* MF;
    __device__ __forceinline__ void operator()(const f32x4 (&acc)[2][2][4][2], const ge::Unit& u, int wr, int wc, int fr, int fq, int tid) const {
        const int row0 = u.pm * 256 + wr * 64 + fr, col0 = u.pn * 256 + wc * 32 + 8 * fq;
        u32x4* sp0 = (u32x4*)(scr + (size_t)(tid >> 6) * 16384 + (size_t)(tid & 63) * 16);
        u32x4* mq0 = (u32x4*)(mscr + (size_t)(tid >> 6) * 16384 + (size_t)(tid & 63) * 16);
        if (u.kind == 0) {
#pragma unroll
            for (int ai = 0; ai < 2; ++ai)
#pragma unroll
                for (int m = 0; m < 4; ++m)
#pragma unroll
                    for (int bj = 0; bj < 2; ++bj) { const int piece = (ai * 4 + m) * 2 + bj; const f32x4 v0 = acc[ai][bj][m][0], v1 = acc[ai][bj][m][1]; u32x4 w;
                        w.x = ge::cvt_pk_bf16(sigmoidf_(v0[0]), sigmoidf_(v0[1])); w.y = ge::cvt_pk_bf16(sigmoidf_(v0[2]), sigmoidf_(v0[3]));
                        w.z = ge::cvt_pk_bf16(sigmoidf_(v1[0]), sigmoidf_(v1[1])); w.w = ge::cvt_pk_bf16(sigmoidf_(v1[2]), sigmoidf_(v1[3])); sp0[piece * 64] = w; }
        } else {
#pragma unroll
            for (int b = 0; b < 4; ++b) {
                u32x4 gb[4], pb[4];
#pragma unroll
                for (int i = 0; i < 4; ++i) { gb[i] = sp0[(4 * b + i) * 64]; pb[i] = mq0[(4 * b + i) * 64]; }
#pragma unroll
                for (int i = 0; i < 4; ++i) { const int piece = 4 * b + i, ai = piece >> 3, m = (piece >> 1) & 3, bj = piece & 1;
                    const f32x4 v0 = acc[ai][bj][m][0], v1 = acc[ai][bj][m][1]; const u32x4 g = gb[i], p = pb[i];
                    float o[8] = {bflo(g.x) * v0[0], bfhi(g.x) * v0[1], bflo(g.y) * v0[2], bfhi(g.y) * v0[3], bflo(g.z) * v1[0], bfhi(g.z) * v1[1], bflo(g.w) * v1[2], bfhi(g.w) * v1[3]};
                    if (u.kind >= 5) {
                        float* mf = MF + (size_t)(u.kind - 5) * (NB * CTXL * D) + (size_t)((u.pm / 33) * 256 + wr * 64 + fr + ai * 128 + m * 16) * D + col0 + bj * 128;
#pragma unroll
                        for (int j = 0; j < 4; ++j) { const f32x2 pr = {o[2 * j], o[2 * j + 1]};
                            __hip_atomic_store((unsigned long long*)mf + j, __builtin_bit_cast(unsigned long long, pr), __ATOMIC_RELAXED, __HIP_MEMORY_SCOPE_AGENT); } }
                    else {
                        if (u.kind > 1) { o[0] += bflo(p.x); o[1] += bfhi(p.x); o[2] += bflo(p.y); o[3] += bfhi(p.y); o[4] += bflo(p.z); o[5] += bfhi(p.z); o[6] += bflo(p.w); o[7] += bfhi(p.w); }
                        u32x4 w; w.x = ge::cvt_pk_bf16(o[0], o[1]); w.y = ge::cvt_pk_bf16(o[2], o[3]); w.z = ge::cvt_pk_bf16(o[4], o[5]); w.w = ge::cvt_pk_bf16(o[6], o[7]);
                        if (u.kind == 4) *(u32x4*)(M + (size_t)(row0 + ai * 128 + m * 16) * D + col0 + bj * 128) = w; else mq0[piece * 64] = w; } }
                asm volatile("" ::: "memory");
            }
        }
    }
};
struct EpiResid {
    static constexpr bool PERM = false, DRAIN = false;
    const float* in_x; const float* in_ctx; float* X; const float* mod; int l;
    __device__ __forceinline__ void operator()(const f32x4 (&acc)[2][2][4][2], const ge::Unit& u, int wr, int wc, int fr, int fq, int tid) const {
        const int b = u.pm / 33, j = u.pm - b * 33;
        const float* src = l > 0 ? (const float*)X + (size_t)u.pm * 256 * D : (j == 0 ? in_ctx + (size_t)b * CTXL * D : in_x + ((size_t)b * SEQ + (size_t)(j - 1) * 256) * D);
        const float* gv = mod + (size_t)(j == 0 ? 4 : b) * 6144 + 2048;
        float* dst = X + (size_t)u.pm * 256 * D;
        const int col0 = u.pn * 256 + wc * 32 + 4 * fq;
        f32x4 gg[2][2];
#pragma unroll
        for (int bj = 0; bj < 2; ++bj)
#pragma unroll
            for (int n = 0; n < 2; ++n) gg[bj][n] = *(const f32x4*)(gv + col0 + bj * 128 + n * 16);
#pragma unroll
        for (int ai = 0; ai < 2; ++ai) {
            f32x4 xo[4][2][2];
#pragma unroll
            for (int m = 0; m < 4; ++m) { const GAS float* sp_ = (const GAS float*)(src + (size_t)(ai * 128 + wr * 64 + m * 16 + fr) * D + col0);
#pragma unroll
                for (int bj = 0; bj < 2; ++bj)
#pragma unroll
                    for (int n = 0; n < 2; ++n) xo[m][bj][n] = *(const GAS f32x4*)(sp_ + bj * 128 + n * 16); }
#pragma unroll
            for (int m = 0; m < 4; ++m) { float* dp_ = dst + (size_t)(ai * 128 + wr * 64 + m * 16 + fr) * D + col0;
#pragma unroll
                for (int bj = 0; bj < 2; ++bj)
#pragma unroll
                    for (int n = 0; n < 2; ++n) *(f32x4*)(dp_ + bj * 128 + n * 16) = xo[m][bj][n] + gg[bj][n] * acc[ai][bj][m][n]; } }
    }
};
__device__ __forceinline__ void moe_prefix(Fr& F, int l) { KA_DECL;
    LAS int* ts = (LAS int*)(F.lds + CTRL_OFF); LAS int* cn = (LAS int*)(F.lds + CTRL_OFF + 160);
    __syncthreads();
    if (F.tid < 64) {
        const unsigned* cnt = WSP(const unsigned, WS_CTL) + CW_CNT + l * 32 * 64; const int e = F.tid;
        const int c = e < NE ? (int)__hip_atomic_load(cnt + e * 64, RLX_AGENT) : 0; const int t = (c + 255) >> 8; int s = t;
#pragma unroll
        for (int o = 1; o < 32; o <<= 1) { const int n = __shfl_up(s, o); if (e >= o) s += n; }
        if (e < NE) { ts[e] = s - t; cn[e] = c; }
        if (e == NE - 1) ts[NE] = s; }
    __syncthreads();
}
struct SchedMoE {
    const LAS int* ts; const LAS int* cn; int stage; const char* A; const char* W; const int* list; int G, vc;
    __device__ __forceinline__ bool next(int i, ge::Unit& u) const {
        const int L = i * G + vc, T = L >> 2, pn = L & 3; if (T >= ts[NE] || T >= MAXT) return false;
        int e = 0;
#pragma unroll
        for (int s = 16; s >= 1; s >>= 1) if (ts[e + s] <= T) e += s;
        const int t = T - ts[e];
        u.pm = T; u.pn = pn; u.kind = 0;
        if (stage == 1) { u.A = A; u.rows = list + (size_t)e * R + t * 256; u.aux = min(256, cn[e] - t * 256); u.lda = 2048; u.B = W + (size_t)e * (D * D * 2) + (size_t)pn * 256 * 2048; u.ldb = 2048; u.nt = 16; }
        else { u.A = A + (size_t)T * 256 * 1024; u.rows = nullptr; u.aux = 256; u.lda = 1024; u.B = W + (size_t)e * (D * DFF * 2) + (size_t)pn * 256 * 1024; u.ldb = 1024; u.nt = 8; }
        return true; }
};
struct EpiAct {
    static constexpr bool PERM = true, DRAIN = false;
    bf16* O;
    __device__ __forceinline__ void operator()(const f32x4 (&acc)[2][2][4][2], const ge::Unit& u, int wr, int wc, int fr, int fq, int tid) const {
        const int row0 = u.pm * 256 + wr * 64 + fr, col0 = u.pn * 128 + wc * 32 + 8 * fq;
#pragma unroll
        for (int ai = 0; ai < 2; ++ai)
#pragma unroll
            for (int m = 0; m < 4; ++m) { const f32x4 a0 = acc[ai][0][m][0], a1 = acc[ai][0][m][1], b0 = acc[ai][1][m][0], b1 = acc[ai][1][m][1]; u32x4 w;
                w.x = ge::cvt_pk_bf16(siluf_(a0[0]) * b0[0], siluf_(a0[1]) * b0[1]); w.y = ge::cvt_pk_bf16(siluf_(a0[2]) * b0[2], siluf_(a0[3]) * b0[3]);
                w.z = ge::cvt_pk_bf16(siluf_(a1[0]) * b1[0], siluf_(a1[1]) * b1[1]); w.w = ge::cvt_pk_bf16(siluf_(a1[2]) * b1[2], siluf_(a1[3]) * b1[3]);
                *(u32x4*)(O + (size_t)(row0 + ai * 128 + m * 16) * DFF + col0) = w; }
    }
};

__device__ __forceinline__ int act_row(int l, int q) { return l == 0 ? q : (q >> 13) * RPB + CTXL + (q & 8191); }
__device__ __forceinline__ void pe1_router(Fr& F, int l) { KA_DECL;
    const int nrows = l == 0 ? R : NB * SEQ;
    const int gw = F.bid * 8 + F.wave, NGW = F.G * 8, lane = F.lane;
    const float* nw = KA->in[I_NFFN] + l * D;
    const float* rgw = KA->in[I_RGW] + (size_t)l * D * 4; const float* rew = KA->in[I_REW] + (size_t)l * D * 32;
    const float* rgb = KA->in[I_RGB] + l * 4; const float* reb = KA->in[I_REB] + l * 32;
    unsigned* cnt = WSP(unsigned, WS_CTL) + CW_CNT + l * 32 * 64;
    for (int q = gw; q < nrows; q += NGW) {
        float a[36];
#pragma unroll
        for (int j = 0; j < 36; ++j) a[j] = 0.f;
        f32x4 f[4];
        const int r = act_row(l, q);
        {   const float* mod = WSP(const float, SM_MOD) + ((size_t)l * 5 + row_cr(r)) * 6144;
            const f32x4* xr = (const f32x4*)(WSP(const float, WS_X) + (size_t)r * D) + lane; float s = 0.f;
#pragma unroll
            for (int j = 0; j < 4; ++j) { f[j] = xr[64 * j]; const f32x4 v = f[j]; s += (v.x * v.x + v.y * v.y) + (v.z * v.z + v.w * v.w); }
            const float rstd = 1.0f / sqrtf(wave_sum(s) * (1.f / D) + EPS);
            unsigned long long* o8 = (unsigned long long*)(WSP(bf16, WS_H) + (size_t)r * D) + lane;
#pragma unroll
            for (int j = 0; j < 4; ++j) { const int k = 4 * (lane + 64 * j);
                const f32x4 w4 = *(const f32x4*)(nw + k), sh = *(const f32x4*)(mod + 3072 + k), sc = *(const f32x4*)(mod + 4096 + k);
                const f32x4 h = (f[j] * rstd) * w4 * (sc + 1.0f) + sh; f[j] = h;
                o8[64 * j] = (unsigned long long)pk2(h.x, h.y) | ((unsigned long long)pk2(h.z, h.w) << 32); } }
#pragma unroll
        for (int j = 0; j < 4; ++j)
#pragma unroll
            for (int e = 0; e < 4; ++e) { const int k = 4 * (lane + 64 * j) + e;
                const f32x4 wg = *(const f32x4*)(rgw + (size_t)k * 4); const f32x4* wep = (const f32x4*)(rew + (size_t)k * 32);
                const float fv = f[j][e];
#pragma unroll
                for (int t = 0; t < 4; ++t) a[t] += fv * wg[t];
#pragma unroll
                for (int t = 0; t < 8; ++t) { const f32x4 we = wep[t]; a[4 + 4 * t] += fv * we.x; a[5 + 4 * t] += fv * we.y; a[6 + 4 * t] += fv * we.z; a[7 + 4 * t] += fv * we.w; }
                asm volatile("" ::: "memory"); }
        {
#pragma unroll
            for (int j = 0; j < 36; ++j) a[j] = wave_sum(a[j]) + (j < 4 ? rgb[j] : reb[j - 4]);
            int gt = 0; float gm = a[0];
#pragma unroll
            for (int j = 1; j < 4; ++j) if (a[j] > gm) { gm = a[j]; gt = j; }
            float gs = 0.f;
#pragma unroll
            for (int j = 0; j < 4; ++j) gs += __expf(a[j] - gm);
            const float pg = 1.0f / gs;
            float el[8];
#pragma unroll
            for (int i = 0; i < 8; ++i) el[i] = gt == 0 ? a[4 + i] : (gt == 1 ? a[12 + i] : (gt == 2 ? a[20 + i] : a[28 + i]));
            int i1 = 0; float m1 = el[0];
#pragma unroll
            for (int i = 1; i < 8; ++i) if (el[i] > m1) { m1 = el[i]; i1 = i; }
            int i2 = -1; float m2 = -3.0e38f;
#pragma unroll
            for (int i = 0; i < 8; ++i) if (i != i1 && el[i] > m2) { m2 = el[i]; i2 = i; }
            float one_ = 1.0f; asm volatile("" : "+s"(one_)); const float e2 = __expf(m2 - m1), den = __builtin_amdgcn_rcpf(one_ + e2);
            const float w1 = pg * den, w2 = pg * e2 * den;
            if (lane == 0) { const int x1 = gt * 8 + i1, x2 = gt * 8 + i2;
                const unsigned k1 = __hip_atomic_fetch_add(cnt + x1 * 64, 1u, RLX_AGENT), k2 = __hip_atomic_fetch_add(cnt + x2 * 64, 1u, RLX_AGENT);
                int* lst = WSP(int, SM_LIST); lst[(size_t)x1 * R + k1] = r; lst[(size_t)x2 * R + k2] = r;
                u32x4* tk = (u32x4*)(WSP(unsigned, SM_TOK) + (size_t)r * 8);
                tk[0] = (u32x4){(unsigned)x1, (unsigned)x2, k1, k2}; tk[1] = (u32x4){__builtin_bit_cast(unsigned, w1), __builtin_bit_cast(unsigned, w2), 0u, 0u}; }
        }
    }
}
__device__ __forceinline__ void router_fold(Fr& F, int l) { KA_DECL;
    const int gt = F.bid * 512 + F.tid, NGT = F.G * 512;
    const float* nw = KA->in[I_NFFN] + l * D; const float* rgw = KA->in[I_RGW] + (size_t)l * D * 4; const float* rew = KA->in[I_REW] + (size_t)l * D * 32;
    for (int e = gt; e < 5 * 1024 * 64; e += NGT) { const int cr = e >> 16, k = (e >> 6) & 1023, j = e & 63;
        const float a = nw[k] * (1.0f + WSP(const float, SM_MOD)[((size_t)l * 5 + cr) * 6144 + 4096 + k]);
        const float w = j < 32 ? rew[k * 32 + j] : (j < 36 ? rgw[k * 4 + (j - 32)] : 0.f);
        WSP(float, SM_WF)[e] = a * w; }
    const int gw = F.bid * 8 + F.wave, NGW = F.G * 8, lane = F.lane;
    for (int idx = gw; idx < 5 * 36; idx += NGW) { const int cr = idx / 36, j = idx % 36; const float* sh = WSP(const float, SM_MOD) + ((size_t)l * 5 + cr) * 6144 + 3072; float s = 0.f;
        for (int k = lane; k < 1024; k += 64) s += sh[k] * (j < 32 ? rew[k * 32 + j] : rgw[k * 4 + (j - 32)]);
        s = wave_sum(s);
        if (lane == 0) WSP(float, SM_RC)[cr * 64 + j] = s + (j < 32 ? KA->in[I_REB][l * 32 + j] : KA->in[I_RGB][l * 4 + (j - 32)]); }
}
__device__ __forceinline__ void pe1_router_mfma(Fr& F, int l) { KA_DECL;
    const int ntiles = (l == 0 ? R : NB * SEQ) / 32;
    const int gw = F.bid * 8 + F.wave, NGW = F.G * 8, lane = F.lane, ri = lane & 31, kh = lane >> 5;
    const float* nw = KA->in[I_NFFN] + l * D;
    unsigned* cnt = WSP(unsigned, WS_CTL) + CW_CNT + l * 32 * 64;
    LAS float* LG = (LAS float*)(F.lds + F.wave * 8448);
    LAS int* cntL = (LAS int*)(F.lds + 69632); LAS int* baseL = cntL + 32;
    if (F.tid < 32) cntL[F.tid] = 0;
    __syncthreads();
    const int tile = F.wave * F.G + F.bid;
    const bool has = tile < ntiles;
    int x1 = 0, x2 = 0, lr1 = 0, lr2 = 0; float w1 = 0.f, w2 = 0.f, rstd = 0.f; int row0 = 0, cr = 0;
    if (has) {
        row0 = act_row(l, tile * 32); cr = row_cr(row0);
        const float* xr = WSP(const float, WS_X) + (size_t)(row0 + ri) * D + 4 * kh;
        const float* wf = WSP(const float, SM_WF) + (size_t)cr * 65536 + (size_t)(4 * kh) * 64 + ri;
        f32x16 acc0, acc1;
#pragma unroll
        for (int q = 0; q < 16; ++q) { acc0[q] = 0.f; acc1[q] = 0.f; }
        float ss = 0.f;
        f32x4 xn_[4]; float wn0[16], wn1[16]; f32x4 xc_[4]; float wc0[16], wc1[16];
#define RT_LOAD(st) do { _Pragma("unroll") for (int u_ = 0; u_ < 4; ++u_) { const int t_ = (st) * 4 + u_; xn_[u_] = *(const f32x4*)(xr + 8 * t_); \
            _Pragma("unroll") for (int e_ = 0; e_ < 4; ++e_) { wn0[u_ * 4 + e_] = wf[(size_t)(8 * t_ + e_) * 64]; wn1[u_ * 4 + e_] = wf[(size_t)(8 * t_ + e_) * 64 + 32]; } } } while (0)
        RT_LOAD(0);
        for (int st = 0; st < (PROBE_RT == 1 ? 1 : 32); ++st) {
#pragma unroll
            for (int u_ = 0; u_ < 4; ++u_) xc_[u_] = xn_[u_];
#pragma unroll
            for (int u_ = 0; u_ < 16; ++u_) { wc0[u_] = wn0[u_]; wc1[u_] = wn1[u_]; }
            if (st < 31) RT_LOAD(st + 1);
#pragma unroll
            for (int u_ = 0; u_ < 4; ++u_) { const f32x4 xv = xc_[u_]; ss += (xv.x * xv.x + xv.y * xv.y) + (xv.z * xv.z + xv.w * xv.w);
#pragma unroll
                for (int e = 0; e < 4; ++e) { acc0 = __builtin_amdgcn_mfma_f32_32x32x2f32(xv[e], wc0[u_ * 4 + e], acc0, 0, 0, 0); acc1 = __builtin_amdgcn_mfma_f32_32x32x2f32(xv[e], wc1[u_ * 4 + e], acc1, 0, 0, 0); } }
        }
#undef RT_LOAD
        ss += __shfl_xor(ss, 32);
        rstd = 1.0f / sqrtf(ss * (1.f / D) + EPS);
        if (lane < 32) ((LAS float*)(F.lds + 131072))[F.wave * 32 + ri] = rstd;
#pragma unroll
        for (int q = 0; q < 16; ++q) { const int row = (q & 3) + 8 * (q >> 2) + 4 * kh; LG[row * 66 + ri] = acc0[q]; LG[row * 66 + 32 + ri] = acc1[q]; }
        LDS_WAIT(); asm volatile("" ::: "memory");
        if (lane < 32) {
            const float* rc = WSP(const float, SM_RC) + cr * 64; const LAS float* lg = LG + ri * 66;
            float g4[4];
#pragma unroll
            for (int j = 0; j < 4; ++j) g4[j] = lg[32 + j] * rstd + rc[32 + j];
            int gt = 0; float gm = g4[0];
#pragma unroll
            for (int j = 1; j < 4; ++j) if (g4[j] > gm) { gm = g4[j]; gt = j; }
            float gs = 0.f;
#pragma unroll
            for (int j = 0; j < 4; ++j) gs += __expf(g4[j] - gm);
            const float pg = 1.0f / gs;
            float el[8];
#pragma unroll
            for (int i = 0; i < 8; ++i) el[i] = lg[gt * 8 + i] * rstd + rc[gt * 8 + i];
            int i1 = 0; float m1 = el[0];
#pragma unroll
            for (int i = 1; i < 8; ++i) if (el[i] > m1) { m1 = el[i]; i1 = i; }
            int i2 = -1; float m2 = -3.0e38f;
#pragma unroll
            for (int i = 0; i < 8; ++i) if (i != i1 && el[i] > m2) { m2 = el[i]; i2 = i; }
            float one_ = 1.0f; asm volatile("" : "+s"(one_)); const float e2 = __expf(m2 - m1), den = __builtin_amdgcn_rcpf(one_ + e2);
            w1 = pg * den; w2 = pg * e2 * den; x1 = gt * 8 + i1; x2 = gt * 8 + i2;
            lr1 = __hip_atomic_fetch_add(cntL + x1, 1, __ATOMIC_RELAXED, __HIP_MEMORY_SCOPE_WORKGROUP); lr2 = __hip_atomic_fetch_add(cntL + x2, 1, __ATOMIC_RELAXED, __HIP_MEMORY_SCOPE_WORKGROUP);
        }
    }
    __syncthreads();
    if (F.tid < 32) { const int c = cntL[F.tid]; baseL[F.tid] = c ? (int)__hip_atomic_fetch_add(cnt + F.tid * 64, (unsigned)c, RLX_AGENT) : 0; }
    __syncthreads();
    if (has) {
        if (lane < 32) { const int r = row0 + ri; const unsigned k1 = (unsigned)(baseL[x1] + lr1), k2 = (unsigned)(baseL[x2] + lr2);
            int* lst = WSP(int, SM_LIST); lst[(size_t)x1 * R + k1] = r; lst[(size_t)x2 * R + k2] = r;
            unsigned* tk = WSP(unsigned, SM_TOK) + (size_t)r * 8;
            tk[0] = (unsigned)x1; tk[1] = (unsigned)x2; tk[2] = k1; tk[3] = k2; tk[4] = __builtin_bit_cast(unsigned, w1); tk[5] = __builtin_bit_cast(unsigned, w2);
        }
    }
    {   int w_ = F.wave; asm volatile("" : "+s"(w_));
        for (int t = 0; t * F.G + F.bid < ntiles; ++t) { const int trow0 = act_row(l, (t * F.G + F.bid) * 32), tcr = row_cr(trow0);
            const float* mod = WSP(const float, SM_MOD) + ((size_t)l * 5 + tcr) * 6144;
            f32x4 xv[4][4]; float rs[4];
#pragma unroll
            for (int i = 0; i < 4; ++i) { const int rr = w_ + 8 * i; const GAS f32x4* xq = (const GAS f32x4*)(WSP(const float, WS_X) + (size_t)(trow0 + rr) * D) + lane;
#pragma unroll
                for (int j = 0; j < 4; ++j) xv[i][j] = xq[64 * j];
                rs[i] = ((const LAS float*)(F.lds + 131072))[t * 32 + rr]; }
            f32x4 ca[4], cs[4];
#pragma unroll
            for (int j = 0; j < 4; ++j) { const int k = 4 * (lane + 64 * j); ca[j] = *(const f32x4*)(nw + k) * (*(const f32x4*)(mod + 4096 + k) + 1.0f); cs[j] = *(const f32x4*)(mod + 3072 + k); }
#pragma unroll
            for (int i = 0; i < 4; ++i) { unsigned long long* o8 = (unsigned long long*)(WSP(bf16, WS_H) + (size_t)(trow0 + w_ + 8 * i) * D) + lane;
#pragma unroll
                for (int j = 0; j < 4; ++j) { const f32x4 h = (xv[i][j] * rs[i]) * ca[j] + cs[j];
                    o8[64 * j] = (unsigned long long)pk2(h.x, h.y) | ((unsigned long long)pk2(h.z, h.w) << 32); } } }
        LDS_WAIT(); asm volatile("" ::: "memory"); }
}
__device__ __forceinline__ void pe4_combine(Fr& F, int l) { KA_DECL;
    const LAS int* ts = (const LAS int*)(F.lds + CTRL_OFF);
    LAS float* wdt = (LAS float*)F.lds;
    if (l < DEPTH - 1) { const float* win2 = KA->in[I_WIN] + (size_t)(l + 1) * D * NIN; for (int e = F.tid; e < D * 8; e += 512) wdt[e] = win2[(size_t)(e >> 3) * NIN + 3072 + (e & 7)]; __syncthreads(); }
    const int nrows = l == 0 ? R : NB * SEQ;
    const int gw = F.bid * 8 + F.wave, NGW = F.G * 8, lane = F.lane;
    const bf16* YO = WSP(const bf16, BG_YO);
    unsigned nt0 = 0, nt1 = 0, nt2 = 0, nt3 = 0, nt4 = 0, nt5 = 0;
    f32x4 px[4]; u32x2 pa[4], pb[4]; float pw1 = 0.f, pw2 = 0.f;
#pragma unroll
    for (int j = 0; j < 4; ++j) { px[j] = (f32x4){0.f, 0.f, 0.f, 0.f}; pa[j] = (u32x2){0u, 0u}; pb[j] = (u32x2){0u, 0u}; }
#define E4_REC(qq) do { const unsigned* tkp = WSP(const unsigned, SM_TOK) + (size_t)act_row(l, (qq)) * 8; nt0 = tkp[0]; nt1 = tkp[1]; nt2 = tkp[2]; nt3 = tkp[3]; nt4 = tkp[4]; nt5 = tkp[5]; } while (0)
#define E4_ROWS(qq) do { const size_t s1_ = (size_t)ts[nt0] * 256 + nt2, s2_ = (size_t)ts[nt1] * 256 + nt3; pw1 = __builtin_bit_cast(float, nt4); pw2 = __builtin_bit_cast(float, nt5); \
        const GAS f32x4* xr_ = (const GAS f32x4*)(WSP(float, WS_X) + (size_t)act_row(l, (qq)) * D) + lane; const GAS u32x2* y1_ = (const GAS u32x2*)(YO + s1_ * D) + lane; const GAS u32x2* y2_ = (const GAS u32x2*)(YO + s2_ * D) + lane; \
        _Pragma("unroll") for (int j_ = 0; j_ < 4; ++j_) { px[j_] = xr_[64 * j_]; pa[j_] = y1_[64 * j_]; pb[j_] = y2_[64 * j_]; } } while (0)
    f32x4 wl4[4];
#pragma unroll
    for (int j = 0; j < 4; ++j) wl4[j] = *(const f32x4*)((l < DEPTH - 1 ? KA->in[I_NMIX] + (l + 1) * D : KA->in[I_FNW]) + 4 * (lane + 64 * j));
    if (gw < nrows) { E4_REC(gw); E4_ROWS(gw); if (gw + NGW < nrows) E4_REC(gw + NGW); }
    for (int q = gw; q < nrows; q += NGW) { const int r = act_row(l, q);
        f32x4 cx[4]; u32x2 ca[4], cb[4]; const float w1 = pw1, w2 = pw2;
#pragma unroll
        for (int j = 0; j < 4; ++j) { cx[j] = px[j]; ca[j] = pa[j]; cb[j] = pb[j]; }
        if (q + NGW < nrows) { E4_ROWS(q + NGW); if (q + 2 * NGW < nrows) E4_REC(q + 2 * NGW); }
        const GAS float* mod = (const GAS float*)(WSP(const float, SM_MOD) + ((size_t)l * 5 + row_cr(r)) * 6144 + 5120);
        f32x4* xr = (f32x4*)(WSP(float, WS_X) + (size_t)r * D) + lane;
        f32x4 xn[4]; float ss = 0.f;
        f32x4 gg4[4], sh4[4], sc4[4];
#pragma unroll
        for (int j = 0; j < 4; ++j) { const int k = 4 * (lane + 64 * j); gg4[j] = *(const GAS f32x4*)(mod + k);
            if (l < DEPTH - 1) { const GAS float* m2 = (const GAS float*)(WSP(const float, SM_MOD) + ((size_t)(l + 1) * 5 + row_cr(r)) * 6144); sh4[j] = *(const GAS f32x4*)(m2 + k); sc4[j] = *(const GAS f32x4*)(m2 + 1024 + k); } }
#pragma unroll
        for (int j = 0; j < 4; ++j) { const f32x4 x = cx[j], gg = gg4[j]; const u32x2 a = ca[j], b = cb[j];
            const f32x4 ya = {bflo(a.x), bfhi(a.x), bflo(a.y), bfhi(a.y)}, yb = {bflo(b.x), bfhi(b.x), bflo(b.y), bfhi(b.y)};
            xn[j] = x + gg * (ya * w1 + yb * w2) * DBG_E4S; const f32x4 v = xn[j]; ss += (v.x * v.x + v.y * v.y) + (v.z * v.z + v.w * v.w); }
        if (l == DEPTH - 1) { const float rstd = 1.0f / sqrtf(wave_sum(ss) * (1.f / D) + EPS);
            const int b = r / RPB, s = r - b * RPB; f32x4* orow = (f32x4*)(KA->out + ((size_t)b * SEQ + (s - CTXL)) * D) + lane;
#pragma unroll
            for (int j = 0; j < 4; ++j) orow[64 * j] = xn[j] * rstd * wl4[j]; }
        else {
            const float rstd = 1.0f / sqrtf(wave_sum(ss) * (1.f / D) + EPS);
            unsigned long long* o8 = (unsigned long long*)(WSP(bf16, WS_H) + (size_t)r * D) + lane;
            float d8[8] = {0, 0, 0, 0, 0, 0, 0, 0};
#pragma unroll
            for (int j = 0; j < 4; ++j) { xr[64 * j] = xn[j]; const int k = 4 * (lane + 64 * j);
                const f32x4 w4 = wl4[j], sh = sh4[j], sc = sc4[j];
                const f32x4 h = (xn[j] * rstd) * w4 * (sc + 1.0f) + sh;
                o8[64 * j] = (unsigned long long)pk2(h.x, h.y) | ((unsigned long long)pk2(h.z, h.w) << 32);
#pragma unroll
                for (int e = 0; e < 4; ++e) { const f32x4 wa = *(const LAS f32x4*)(wdt + (k + e) * 8), wb = *(const LAS f32x4*)(wdt + (k + e) * 8 + 4); const float hv = h[e];
                    d8[0] += hv * wa.x; d8[1] += hv * wa.y; d8[2] += hv * wa.z; d8[3] += hv * wa.w; d8[4] += hv * wb.x; d8[5] += hv * wb.y; d8[6] += hv * wb.z; d8[7] += hv * wb.w; } }
#pragma unroll
            for (int e = 0; e < 8; ++e) d8[e] = wave_sum(d8[e]);
            if (lane == 0) { float* dt = WSP(float, SM_DT) + (size_t)r * 8; *(f32x4*)dt = (f32x4){d8[0], d8[1], d8[2], d8[3]}; *(f32x4*)(dt + 4) = (f32x4){d8[4], d8[5], d8[6], d8[7]}; } }
    }
}

constexpr int PH_PER_L = 14, N_PHASES = 2 + DEPTH * PH_PER_L;
#ifndef USE_CG
#define USE_CG 1
#endif
#ifndef PHMASK
#define PHMASK 0xFFFFFFFFu
#endif
#define PON(x) ((PHSEL < 0 && ((PHMASK >> ((x) >= 100 ? (x) - 86 : (x))) & 1u)) || PHSEL == (x))

template <bool COOP, int PHSEL>
__global__ void __launch_bounds__(512, 2) mk(Args a) {
    extern __shared__ __attribute__((aligned(16))) unsigned char lds_raw[];
    Fr F;
    F.lds = (LAS unsigned char*)lds_raw;
    {   const int t0 = threadIdx.x;
        for (int u = t0; u < (LDS_BYTES - CTRL_OFF) / 4; u += 512) ((LAS unsigned*)(F.lds + CTRL_OFF))[u] = 0u;
        __syncthreads();
        if ((t0 & 63) == 0) ((volatile LAS int*)(F.lds + MISC_OFF + 128))[(unsigned)__builtin_amdgcn_s_getreg((6 << 11) | 4) & 63u] = t0 >> 6;
        __syncthreads();
        if (COOP) { KA_DECL; (void)xcd_barrier_post(WSP(unsigned, WS_CTL) + CW_BAR, (volatile LAS unsigned*)(F.lds + MISC_OFF) + 8); } }
    for (int ph = a.ph_lo; ; ++ph) {
        { KA_DECL; if (ph >= KA->ph_hi) break; }
#define PHASE_ENTER(tag) do { int bid_ = blockIdx.x, g_ = gridDim.x; asm volatile("; enter " tag : "+s"(bid_), "+s"(g_)); \
            const unsigned hw_ = (unsigned)__builtin_amdgcn_s_getreg((6 << 11) | 4) & 63u; int wv_ = __builtin_amdgcn_readfirstlane(((volatile LAS int*)(F.lds + MISC_OFF + 128))[hw_]); \
            unsigned z_ = 0u; asm volatile("; z " tag : "+s"(z_)); int lane_ = (int)__builtin_amdgcn_mbcnt_hi(~0u, __builtin_amdgcn_mbcnt_lo(~0u, z_)) & 63; int tid_ = wv_ * 64 + lane_; asm volatile("; tid " tag : "+v"(tid_)); \
            F.tid = tid_; F.lane = tid_ & 63; F.wave = __builtin_amdgcn_readfirstlane(tid_ >> 6); F.bid = bid_; F.G = g_; } while (0)
        if (ph >= 2 + PH_PER_L && (ph - 2) % PH_PER_L == 0) continue;
        if (ph >= 2 && (ph - 2) % PH_PER_L == 5) continue;
        PHASE_ENTER("top");
        const int vc = (F.G % 8 == 0) ? (F.bid % 8) * (F.G / 8) + F.bid / 8 : F.bid;
        if (ph == 0) { if (PON(100)) { PHASE_ENTER("p100"); p0_prologue(F, -1); } }
        else if (ph == 1) { if (PON(101)) { PHASE_ENTER("p101"); p1_mod(F); } }
        else {
            const int l = (ph - 2) / PH_PER_L, p = (ph - 2) % PH_PER_L; const bool last = (l == DEPTH - 1);
            KA_DECL;
            const char* wt_in = (const char*)(WSP(bf16, WT_IN) + (size_t)l * NWIN * D);
            if (p == 0) { if (PON(0)) { PHASE_ENTER("p0"); pa_hrows(F, l); router_fold(F, l); } }
            else if (p == 1) { if (PON(1)) { PHASE_ENTER("p1");
                SchedGrid S{(const char*)WSP(bf16, WS_H), wt_in, 2048u, 2048u, 16, R / 256, NP / 256, F.G, F.bid, false};
                EpiStore E{WSP(bf16, BG_PROJ), NP};
                ge::gemm_engine<EpiStore, SchedGrid, false>(F.lds, S, E, F.tid);
            } }
            else if (p == 2) { if (PON(2)) { PHASE_ENTER("p2");
                const bool ctx_static = !last && F.G >= 48;
                if (ctx_static && F.bid >= F.G - 16) { fft_ctx(F, F.bid - (F.G - 16)); __syncthreads(); }
                for (int t = F.bid; t < NSPAN; t += F.G) span_task_mfma<0, false>(F, l, t);
                bool mat = false; const int nctx = (last || ctx_static) ? 0 : 16;
                {   KA_DECL; unsigned* wq = WSP(unsigned, WS_CTL) + CW_WQ + (l * 4 + 0) * 64;
                    dyn_tickets(F, wq, nctx + 512 + R / 64, [&](int c) {
                        if (c < nctx) fft_ctx(F, c);
                        else if (c < nctx + 512) { if (!mat) { KA_DECL; lds_load_mat<128>(F, WSP(const bf16, SM_M1B)); mat = true; } fft_stage_a(F, c - nctx); }
                        else conv_a_chunk(F, l, c - nctx - 512); }); }
            } }
            else if (p == 3 || p == 6) { if (PON(3)) { PHASE_ENTER("p3"); state_scan(F, p == 6); } }
            else if (p == 4) { if (PON(4)) { PHASE_ENTER("p4");
                if (PROBE_P4 != 1) for (int t = F.bid; t < NSPAN; t += F.G) { if (last && (t % SPB) < 4) continue; span_task_mfma<0, true>(F, l, t); }
                {   KA_DECL; unsigned* wq = WSP(unsigned, WS_CTL) + CW_WQ + (l * 4 + 1) * 64; dyn_tickets(F, wq, R / 64, [&](int c) {
                        conv_xbc_chunk(F, l, c); __builtin_amdgcn_fence(__ATOMIC_SEQ_CST, "workgroup"); __syncthreads(); span_task_mfma<1, false>(F, l, c); }); }
            } }
            else if (p == 5) { }
            else if (p == 7) { if (PON(7)) { PHASE_ENTER("p7");
                for (int t = F.bid; t < NSPAN; t += F.G) { if (last && (t % SPB) < 4) continue; span_task_mfma<1, true>(F, l, t); }
                bool mat = false;
                {   KA_DECL; unsigned* wq = WSP(unsigned, WS_CTL) + CW_WQ + (l * 4 + 2) * 64;
                    dyn_tickets(F, wq, 512, [&](int c) { if (!mat) { KA_DECL; lds_load_mat<256>(F, WSP(const bf16, SM_M2B)); mat = true; } fft_stage_b(F, c); }); }
                if (!last) ctx_y_copy(F);
            } }
            else if (p == 8) { if (PON(8)) { PHASE_ENTER("p8");
                SchedD1 S{(const char*)WSP(bf16, WS_H), (const char*)WSP(bf16, BG_PROJ), wt_in + (size_t)NP * 2048, (const char*)(WSP(bf16, WT_BR) + (size_t)l * 4 * D * 256), 128, F.G, F.bid, (512 + F.G - 1 - F.bid) / F.G, last};
                EpiD1 E{WSP(bf16, BG_MERGED), KA->ws + BG_GSCR + (size_t)F.bid * 131072, KA->ws + BG_MSCR + (size_t)F.bid * 131072, WSP(float, BG_MF)};
                ge::gemm_engine<EpiD1, SchedD1, false, false>(F.lds, S, E, F.tid);
                if (!last && F.bid < 64) ctx_tile_finish(F, l);
                if (l == 0 && DEPTH > 1) {
                    KA_DECL; unsigned* wq = WSP(unsigned, WS_CTL) + CW_WQ + 12 * 64; __syncthreads();
                    dyn_tickets(F, wq, PRO_L1_TICKETS, [&](int c) { p0_prologue(F, c); }); }
            } }
            else if (p == 9) { if (PON(9)) { PHASE_ENTER("p9");
                SchedGrid S{(const char*)WSP(bf16, BG_MERGED), (const char*)(WSP(bf16, WT_OUT) + (size_t)l * D * D), 2048u, 2048u, 16, last ? 128 : 132, 4, F.G, F.bid, last};
                EpiResid E{KA->in[I_X], KA->in[I_CTX], WSP(float, WS_X), WSP(const float, SM_MOD) + (size_t)l * 5 * 6144, l};
                ge::gemm_engine<EpiResid, SchedGrid, false>(F.lds, S, E, F.tid);
                if (!last) moe_convert_tickets(F, l, 0);
            } }
            else if (p == 10) { if (PON(10)) { PHASE_ENTER("p10"); pe1_router_mfma(F, l); moe_convert_tickets(F, l, 0); } }
            else if (p == 11) { if (PON(11)) { PHASE_ENTER("p11");
                moe_prefix(F, l);
                SchedMoE S{(const LAS int*)(F.lds + CTRL_OFF), (const LAS int*)(F.lds + CTRL_OFF + 160), 1, (const char*)WSP(bf16, WS_H), (const char*)WSP(bf16, BG_W13), WSP(const int, SM_LIST), F.G, vc};
                EpiAct E{WSP(bf16, BG_ACT)};
                ge::gemm_engine<EpiAct, SchedMoE, true>(F.lds, S, E, F.tid);
                moe_convert_tickets(F, l, 1);
            } }
            else if (p == 12) { if (PON(12)) { PHASE_ENTER("p12");
                moe_prefix(F, l);
                SchedMoE S{(const LAS int*)(F.lds + CTRL_OFF), (const LAS int*)(F.lds + CTRL_OFF + 160), 2, (const char*)WSP(bf16, BG_ACT), (const char*)WSP(bf16, BG_W2), nullptr, F.G, vc};
                EpiStore E{WSP(bf16, BG_YO), D};
                ge::gemm_engine<EpiStore, SchedMoE, false>(F.lds, S, E, F.tid);
            } }
            else { if (PON(13)) { PHASE_ENTER("p13"); moe_prefix(F, l); pe4_combine(F, l); if (l < DEPTH - 1) router_fold(F, l + 1); } }
        }
        { KA_DECL; if (ph + 1 >= KA->ph_hi) break; }
        {
            if (COOP) { if (USE_CG && ph == 0) cg::this_grid().sync(); else { KA_DECL; XcdBarrier bar; bar.bar = WSP(unsigned, WS_CTL) + CW_BAR; bar.x = xb_xcc_id(); bar.st = (volatile LAS unsigned*)(F.lds + MISC_OFF) + 8; xcd_barrier(bar, F.tid); } }
        }
    }
}

#ifndef PROFILE_P
#define PROFILE_P 2
#endif
#ifndef PROFILE_SEL
#define PROFILE_SEL 0
#endif
#ifndef PROFILE_UNIT_US
#define PROFILE_UNIT_US 20.f
#endif
#ifndef PROFILE_GROUPS
#define PROFILE_GROUPS 0
#endif
#ifndef ONE_LAUNCH
#define ONE_LAUNCH 1
#endif
#ifndef DBG_STOP
#define DBG_STOP 0
#endif
#ifndef DBG_K
#define DBG_K 30.f
#endif
__global__ void __launch_bounds__(256) dbg_gemm(const bf16* A, int lda, const bf16* Bt, int ldb, int K, const bf16* C, int ldc, int c0, float* out) {
    const int q = blockIdx.x, r = (q >> 13) * RPB + CTXL + (q & 8191);
    __shared__ float arow[1024];
    for (int k = threadIdx.x; k < K; k += 256) arow[k] = bf2f(A[(size_t)r * lda + k]);
    __syncthreads();
    for (int c = threadIdx.x; c < 1024; c += 256) { const bf16* b = Bt + (size_t)(c0 + c) * ldb; float s = 0.f;
        for (int k = 0; k < K; k += 8) { const u32x4 w = *(const u32x4*)(b + k);
            s += arow[k] * bflo(w.x) + arow[k + 1] * bfhi(w.x) + arow[k + 2] * bflo(w.y) + arow[k + 3] * bfhi(w.y) + arow[k + 4] * bflo(w.z) + arow[k + 5] * bfhi(w.z) + arow[k + 6] * bflo(w.w) + arow[k + 7] * bfhi(w.w); }
        out[(size_t)q * D + c] = DBG_K * (bf2f(C[(size_t)r * ldc + c0 + c]) - s); }
}
__global__ void __launch_bounds__(256) dbg_merged(const bf16* H, const bf16* P, const bf16* Wg, const bf16* Wb, const bf16* M, float* out) {
    const int q = blockIdx.x, r = (q >> 13) * RPB + CTXL + (q & 8191);
    __shared__ float hrow[1024]; __shared__ float yrow[1024];
    for (int k = threadIdx.x; k < 1024; k += 256) { hrow[k] = bf2f(H[(size_t)r * D + k]); const int br = k >> 8, kk = k & 255; const int colk = br == 0 ? C_AB : (br == 1 ? C_Q : (br == 2 ? C_UR : C_Z)); yrow[k] = bf2f(P[(size_t)r * NP + colk + kk]); }
    __syncthreads();
    for (int c = threadIdx.x; c < 1024; c += 256) { float tot = 0.f;
        for (int br = 0; br < 4; ++br) { if (!((BRMASK >> br) & 1)) continue; const bf16* wg = Wg + (size_t)(br * 1024 + c) * D; float g = 0.f; for (int k = 0; k < 1024; ++k) g += hrow[k] * bf2f(wg[k]);
            const bf16* wb = Wb + ((size_t)br * 1024 + c) * 256; float p = 0.f; for (int k = 0; k < 256; ++k) p += yrow[br * 256 + k] * bf2f(wb[k]);
            tot += DBG_D1 == 1 ? 1.f / (1.f + expf(-g)) : (DBG_D1 == 2 ? p : p / (1.f + expf(-g))); }
        out[(size_t)q * D + c] = DBG_K * (bf2f(M[(size_t)r * D + c]) - tot); }
}
__global__ void __launch_bounds__(256) dbg_d2(const bf16* M, const bf16* Wo, const float* X, const float* xin, const float* mod, float* out) {
    const int q = blockIdx.x, b = q >> 13, r = b * RPB + CTXL + (q & 8191);
    __shared__ float mrow[1024];
    for (int k = threadIdx.x; k < 1024; k += 256) mrow[k] = bf2f(M[(size_t)r * D + k]);
    __syncthreads();
    for (int c = threadIdx.x; c < 1024; c += 256) { const bf16* w = Wo + (size_t)c * D; float s = 0.f; for (int k = 0; k < 1024; ++k) s += mrow[k] * bf2f(w[k]);
        out[(size_t)q * D + c] = DBG_K * (X[(size_t)r * D + c] - (xin[(size_t)q * D + c] + mod[(size_t)b * 6144 + 2048 + c] * s)); }
}
__global__ void __launch_bounds__(256) dbg_moe(const bf16* F, const unsigned* TOK, const unsigned* CNT, const bf16* YO, const float* W1, const float* W3, const float* W2, float* out) {
    const int q = blockIdx.x, r = (q >> 13) * RPB + CTXL + (q & 8191), tid = threadIdx.x;
    __shared__ float frow[1024]; __shared__ float act[512]; __shared__ int ts[33];
    if (tid == 0) { int a = 0; for (int e = 0; e < 32; ++e) { ts[e] = a; a += ((int)CNT[e] + 255) >> 8; } ts[32] = a; }
    for (int k = tid; k < 1024; k += 256) frow[k] = bf2f(F[(size_t)r * D + k]);
    __syncthreads();
    const unsigned* tk = TOK + (size_t)r * 8; const int ex[2] = {(int)tk[0], (int)tk[1]}; const unsigned rk[2] = {tk[2], tk[3]}; const float ww[2] = {__builtin_bit_cast(float, tk[4]), __builtin_bit_cast(float, tk[5])};
    float y[4] = {0, 0, 0, 0}, mine[4] = {0, 0, 0, 0};
    for (int s = 0; s < 2; ++s) { const int e = ex[s];
        const float* w1 = W1 + (size_t)e * D * DFF; const float* w3 = W3 + (size_t)e * D * DFF; const float* w2 = W2 + (size_t)e * DFF * D;
        for (int j = tid; j < 512; j += 256) { float a = 0.f, b = 0.f; for (int k = 0; k < 1024; ++k) { a += frow[k] * w1[(size_t)k * DFF + j]; b += frow[k] * w3[(size_t)k * DFF + j]; } act[j] = a / (1.f + expf(-a)) * b; }
        __syncthreads();
        const size_t slot = (size_t)ts[e] * 256 + rk[s];
        for (int i = 0; i < 4; ++i) { const int c = tid + 256 * i; float o = 0.f; for (int j = 0; j < 512; ++j) o += act[j] * w2[(size_t)j * D + c]; y[i] += ww[s] * o; mine[i] += ww[s] * bf2f(YO[slot * D + c]); }
        __syncthreads(); }
    for (int i = 0; i < 4; ++i) out[(size_t)q * D + tid + 256 * i] = DBG_K * (mine[i] - y[i]);
}
__global__ void __launch_bounds__(256) dbg_router(const float* X, const float* mod, const float* nw, const float* rgw, const float* rgb, const float* rew, const float* reb, const unsigned* TOK, float* out) {
    const int q = blockIdx.x, b = q >> 13, r = b * RPB + CTXL + (q & 8191), tid = threadIdx.x;
    __shared__ float f[1024]; __shared__ float red[256]; __shared__ float lg[36];
    float ss = 0.f; for (int k = tid; k < 1024; k += 256) { const float v = X[(size_t)r * D + k]; ss += v * v; }
    red[tid] = ss; __syncthreads(); for (int s = 128; s > 0; s >>= 1) { if (tid < s) red[tid] += red[tid + s]; __syncthreads(); }
    const float rstd = 1.0f / sqrtf(red[0] / 1024.f + EPS);
    for (int k = tid; k < 1024; k += 256) f[k] = X[(size_t)r * D + k] * rstd * nw[k] * (1.f + mod[(size_t)b * 6144 + 4096 + k]) + mod[(size_t)b * 6144 + 3072 + k];
    __syncthreads();
    if (tid < 36) { float s = 0.f; if (tid < 4) { for (int k = 0; k < 1024; ++k) s += f[k] * rgw[k * 4 + tid]; s += rgb[tid]; } else { for (int k = 0; k < 1024; ++k) s += f[k] * rew[k * 32 + tid - 4]; s += reb[tid - 4]; } lg[tid] = s; }
    __syncthreads();
    for (int c = tid; c < 1024; c += 256) out[(size_t)q * D + c] = 0.f;
    __syncthreads();
    if (tid == 0) { int gt = 0; for (int j = 1; j < 4; ++j) if (lg[j] > lg[gt]) gt = j; float gs = 0.f; for (int j = 0; j < 4; ++j) gs += expf(lg[j] - lg[gt]); const float pg = 1.f / gs;
        const float* el = lg + 4 + gt * 8; int i1 = 0; for (int i = 1; i < 8; ++i) if (el[i] > el[i1]) i1 = i; int i2 = -1; for (int i = 0; i < 8; ++i) if (i != i1 && (i2 < 0 || el[i] > el[i2])) i2 = i;
        const float e2 = expf(el[i2] - el[i1]), w1 = pg / (1.f + e2), w2 = pg * e2 / (1.f + e2);
        const unsigned* tk = TOK + (size_t)r * 8;
        out[(size_t)q * D + 0] = 1000.f * ((float)tk[0] - (float)(gt * 8 + i1)); out[(size_t)q * D + 1] = 1000.f * ((float)tk[1] - (float)(gt * 8 + i2));
        out[(size_t)q * D + 2] = 1000.f * (__builtin_bit_cast(float, tk[4]) - w1); out[(size_t)q * D + 3] = 1000.f * (__builtin_bit_cast(float, tk[5]) - w2); }
}
__device__ __forceinline__ float dbg_conv_silu(const bf16* P, int r, int c, const float* cw, const float* cb) {
    bool vp, vn; nbr_valid(r, vp, vn); const bf16* row = P + (size_t)r * NP + C_XBC + c;
    const float a = vp ? bf2f(row[-NP]) : 0.f, b = bf2f(row[0]), n = vn ? bf2f(row[NP]) : 0.f; const float v = cb[c] + cw[c] * a + cw[512 + c] * b + cw[1024 + c] * n; return v / (1.f + expf(-v)); }
__global__ void __launch_bounds__(64) dbg_naive_scan(const bf16* P, const float* DT, float* XO, const float* scw, const float* scb, const float* alog, const float* dtb, const float* sd, const float* hlb, int mix) {
    const int b = blockIdx.x >> 3, h = (blockIdx.x >> 1) & 3, dir = blockIdx.x & 1, lane = threadIdx.x, g = h >> 1;
    __shared__ float Ssh[64][64];
#define S_(k) Ssh[k][lane]
    for (int k = 0; k < 64; ++k) S_(k) = 0.f;
    const float A = expf(alog[dir * 4 + h]), bias = dtb[dir * 4 + h], Dh = sd[h];
    __shared__ float lbs[64]; lbs[lane] = DBG_L ? 1.f / (1.f + expf(hlb[(dir * DEPTH + 0) * 256 + h * 64 + lane] - hlb[(dir * DEPTH + DBG_L) * 256 + h * 64 + lane])) : 0.f; __syncthreads();
    for (int p = 0; p < RPB; ++p) {
        int s; if (!dir) s = p; else s = p < CTXL ? CTXL - 1 - p : RPB - 1 - (p - CTXL);
        const int r = b * RPB + s; const bf16* row = P + (size_t)r * NP; float o = 0.f;
        if (mix == 0) { const float vv = bf2f(row[C_I + h * 64 + lane]);
            for (int k = 0; k < 64; ++k) { const float fr = bf2f(row[C_FF + dir * 256 + h * 64 + k]), qr = bf2f(row[C_Q + h * 64 + k]); const float f = lbs[k] + (1.f - lbs[k]) / (1.f + expf(-fr)), q = qr / (1.f + expf(-qr));
                S_(k) = f * S_(k) + (1.f - f) * vv; o += q * S_(k); }
            if (s >= CTXL) XO[((size_t)b * SEQ + (s - CTXL)) * D + (dir ? 0 : 256) + h * 64 + lane] = o;
        } else { const float xv = dbg_conv_silu(P, r, h * 64 + lane, scw, scb); const float dtr = DT[(size_t)r * 8 + dir * 4 + h] + bias; const float dt = dtr > 20.f ? dtr : log1pf(expf(dtr)); const float a = expf(-dt * A);
            for (int k = 0; k < 64; ++k) { const float Bv = dbg_conv_silu(P, r, 256 + g * 64 + k, scw, scb), Cv = dbg_conv_silu(P, r, 384 + g * 64 + k, scw, scb);
                S_(k) = a * S_(k) + Bv * dt * xv; o += Cv * S_(k); }
            if (s >= CTXL) XO[((size_t)b * SEQ + (s - CTXL)) * D + (dir ? 512 : 768) + h * 64 + lane] = dir ? o : o + Dh * xv;
        }
    }
}
__global__ void __launch_bounds__(256) dbg_scan_cmp(const bf16* P, const float* XO, const bf16* GZ, const float* hnw, const float* snw, float* out) {
    const int q = blockIdx.x, r = (q >> 13) * RPB + CTXL + (q & 8191), c = threadIdx.x; __shared__ float red[256];
    {   const float o = XO[(size_t)q * D + 256 + c] + XO[(size_t)q * D + c]; red[c] = o * o; __syncthreads();
        for (int s = 32; s > 0; s >>= 1) { if ((c & 63) < s) red[c] += red[c + s]; __syncthreads(); }
        const float rs = 1.f / sqrtf(red[c & ~63] / 64.f + EPS); const float gr = bf2f(P[(size_t)r * NP + C_G + c]); const float y = o * rs * hnw[c & 63] * gr / (1.f + expf(-gr));
        out[(size_t)q * D + 256 + c] = DBG_K * (bf2f(P[(size_t)r * NP + C_Q + c]) - y); __syncthreads(); }
    {   const float zr = bf2f(GZ[(size_t)r * 256 + c]); const float v = (XO[(size_t)q * D + 768 + c] + XO[(size_t)q * D + 512 + c]) * zr / (1.f + expf(-zr)); red[c] = v * v; __syncthreads();
        for (int s = 64; s > 0; s >>= 1) { if ((c & 127) < s) red[c] += red[c + s]; __syncthreads(); }
        const float rs = 1.f / sqrtf(red[c & ~127] / 128.f + EPS); const float y = v * rs * snw[c];
        out[(size_t)q * D + 768 + c] = DBG_K * (bf2f(P[(size_t)r * NP + C_Z + c]) - y); }
    out[(size_t)q * D + c] = 0.f; out[(size_t)q * D + 512 + c] = 0.f;
}
__global__ void dbg_save_gz(const bf16* P, bf16* GZ) {
    const int r = blockIdx.x, c = threadIdx.x; GZ[(size_t)r * 256 + c] = P[(size_t)r * NP + C_Z + c];
}
__global__ void __launch_bounds__(256) dbg_four(const bf16* H, const float* win, const bf16* P, float* out) {
    const int q = blockIdx.x, r = (q >> 13) * RPB + CTXL + (q & 8191), c = threadIdx.x; __shared__ float hrow[1024]; __shared__ float four[256];
    for (int k = c; k < 1024; k += 256) hrow[k] = bf2f(H[(size_t)r * D + k]);
    __syncthreads();
    { float s = 0.f; for (int k = 0; k < 1024; ++k) s += hrow[k] * win[(size_t)k * NIN + 2048 + c]; four[c] = s; }
    __syncthreads();
    const int g = c >> 6, cp = c & 63; float ur = 0.f, ui = 0.f;
    for (int i = 0; i < 64; ++i) { float sn, cs; sincospif(2.0f * (float)((i * cp) & 63) / 64.0f, &sn, &cs); ur += four[g * 64 + i] * cs; ui -= four[g * 64 + i] * sn; }
    out[(size_t)q * D + c] = DBG_K * (bf2f(P[(size_t)r * NP + C_UR + c]) - ur); out[(size_t)q * D + 256 + c] = DBG_K * (bf2f(P[(size_t)r * NP + C_UI + c]) - ui);
    out[(size_t)q * D + 512 + c] = 0.f; out[(size_t)q * D + 768 + c] = 0.f;
}
__global__ void dbg_save_u(const bf16* P, bf16* U) { const int r = blockIdx.x, c = threadIdx.x; U[(size_t)r * 512 + c] = P[(size_t)r * NP + C_UR + c]; U[(size_t)r * 512 + 256 + c] = P[(size_t)r * NP + C_UI + c]; }
__global__ void __launch_bounds__(256) dbg_dft(const bf16* U, const bf16* P, float* out) {
    const int q = blockIdx.x, b = q >> 13, tp = q & 8191, ch = threadIdx.x; __shared__ float ct[8192]; __shared__ float st[8192];
    for (int i = ch; i < 8192; i += 256) { float sn, cs; sincospif(2.0f * (float)i / 8192.0f, &sn, &cs); ct[i] = cs; st[i] = sn; }
    __syncthreads();
    float acc = 0.f; const bf16* u = U + ((size_t)b * RPB + CTXL) * 512 + ch;
    for (int t = 0; t < 8192; ++t) { const int idx = (t * tp) & 8191; acc += bf2f(u[(size_t)t * 512]) * ct[idx] + bf2f(u[(size_t)t * 512 + 256]) * st[idx]; }
    const int r = b * RPB + CTXL + tp;
    out[(size_t)q * D + 512 + ch] = DBG_K * (bf2f(P[(size_t)r * NP + C_UR + ch]) - acc * 0.001381067932f);
    out[(size_t)q * D + ch] = 0.f; out[(size_t)q * D + 256 + ch] = 0.f; out[(size_t)q * D + 768 + ch] = 0.f;
}
__global__ void dbg_mod(const float* c, const float* cctx, const float* adaw, const float* adab, float* MN) {
    const int j = blockIdx.x * 256 + threadIdx.x, cr = blockIdx.y; if (j >= 6144) return; const float* cv = cr < 4 ? c + cr * D : cctx; float s = adab[j];
    for (int k = 0; k < 1024; ++k) { const float x = cv[k]; s += x / (1.f + expf(-x)) * adaw[(size_t)k * 6144 + j]; } MN[cr * 6144 + j] = s; }
__global__ void __launch_bounds__(256) dbg_h(const float* xin, const float* MN, const float* nw, const float* win, const bf16* H, const float* DT, float* out) {
    const int q = blockIdx.x, b = q >> 13, r = b * RPB + CTXL + (q & 8191), tid = threadIdx.x; __shared__ float red[256]; __shared__ float hrow[1024];
    float ss = 0.f; for (int k = tid; k < 1024; k += 256) { const float v = xin[(size_t)q * D + k]; ss += v * v; } red[tid] = ss; __syncthreads();
    for (int s = 128; s > 0; s >>= 1) { if (tid < s) red[tid] += red[tid + s]; __syncthreads(); }
    const float rstd = 1.f / sqrtf(red[0] / 1024.f + EPS);
    for (int k = tid; k < 1024; k += 256) { const float h = xin[(size_t)q * D + k] * rstd * nw[k] * (1.f + MN[b * 6144 + 1024 + k]) + MN[b * 6144 + k]; hrow[k] = h; out[(size_t)q * D + k] = DBG_K * (bf2f(H[(size_t)r * D + k]) - h); }
    __syncthreads();
    if (tid < 8) { float s = 0.f; for (int k = 0; k < 1024; ++k) s += hrow[k] * win[(size_t)k * NIN + 3072 + tid]; out[(size_t)q * D + tid] = 100.f * DBG_K * (DT[(size_t)r * 8 + tid] - s); }
}
__global__ void __launch_bounds__(256) dbg_wt(const float* win, const float* wbr, const float* wout, const bf16* WTI, const bf16* WTB, const bf16* WTO, float* out) {
    const int q = blockIdx.x, tid = threadIdx.x;
    for (int k = tid; k < 1024; k += 256) { float d = 0.f;
        if (q < 7424) { int src = -1; if (q < 2048) src = q; else if (q >= 2560 && q < 2816) src = 2304 + (q - 2560); else if (q >= 2816 && q < 3328) src = 2560 + (q - 2816); else if (q >= 3328) src = 3080 + (q - 3328);
            if (src >= 0) d = bf2f(WTI[(size_t)q * D + k]) - win[(size_t)k * NIN + src]; }
        else if (q >= 8192 && q < 12288) { const int n = q - 8192, br = n >> 10, nn = n & 1023; if (k < 256) d = bf2f(WTB[((size_t)br * 1024 + nn) * 256 + k]) - wbr[((size_t)br * 256 + k) * D + nn]; }
        else if (q >= 12288 && q < 13312) { const int n = q - 12288; d = bf2f(WTO[(size_t)n * D + k]) - wout[(size_t)k * D + n]; }
        out[(size_t)q * D + k] = 1000.f * d; }
}
__global__ void dbg_save_a(const bf16* P, bf16* S) { const int r = blockIdx.x, c = threadIdx.x; for (int j = 0; j < 3; ++j) S[(size_t)r * 768 + j * 256 + c] = P[(size_t)r * NP + j * 256 + c]; }
__global__ void __launch_bounds__(256) dbg_conva(const bf16* S, const bf16* P, const float* cw, const float* cb, float* out) {
    const int q = blockIdx.x, r = (q >> 13) * RPB + CTXL + (q & 8191), t = q & 8191, c = threadIdx.x;
    const bf16* s0 = S + (size_t)r * 768; const float u0 = bf2f(s0[256 + c]) * bf2f(s0[512 + c]);
    const float up = t > 0 ? bf2f(s0[-768 + 256 + c]) * bf2f(s0[-768 + 512 + c]) : 0.f, un = t < 8191 ? bf2f(s0[768 + 256 + c]) * bf2f(s0[768 + 512 + c]) : 0.f;
    const float y = bf2f(s0[c]) * (cb[c] + cw[c] * up + cw[256 + c] * u0 + cw[512 + c] * un);
    out[(size_t)q * D + c] = DBG_K * (bf2f(P[(size_t)r * NP + C_AB + c]) - y); out[(size_t)q * D + 256 + c] = 0.f; out[(size_t)q * D + 512 + c] = 0.f; out[(size_t)q * D + 768 + c] = 0.f;
}
__global__ void __launch_bounds__(256) dbg_final(const float* X, const float* mod, const unsigned* TOK, const unsigned* CNT, const bf16* YO, const float* fnw, float* out) {
    const int q = blockIdx.x, b = q >> 13, r = b * RPB + CTXL + (q & 8191), tid = threadIdx.x; __shared__ int ts[33]; __shared__ float red[256];
    if (tid == 0) { int a = 0; for (int e = 0; e < 32; ++e) { ts[e] = a; a += ((int)CNT[e - (DBG_VAR == 3 ? 32 : 0)] + 255) >> 8; } ts[32] = a; }
    __syncthreads();
    const unsigned* tk = TOK + (size_t)r * 8; const size_t s1 = (size_t)ts[tk[0]] * 256 + tk[2], s2 = (size_t)ts[tk[1]] * 256 + tk[3]; float w1 = __builtin_bit_cast(float, tk[4]), w2 = __builtin_bit_cast(float, tk[5]); if (DBG_VAR == 1) { const float t_ = w1; w1 = w2; w2 = t_; } if (DBG_VAR == 2) mod -= 5 * 6144;
    float xn[4]; float ss = 0.f;
    for (int i = 0; i < 4; ++i) { const int c = tid + 256 * i; xn[i] = X[(size_t)r * D + c] + DBG_E4S * mod[(size_t)b * 6144 + 5120 + c] * (w1 * bf2f(YO[s1 * D + c]) + w2 * bf2f(YO[s2 * D + c])); ss += xn[i] * xn[i]; }
    red[tid] = ss; __syncthreads(); for (int s = 128; s > 0; s >>= 1) { if (tid < s) red[tid] += red[tid + s]; __syncthreads(); }
    const float rstd = 1.f / sqrtf(red[0] / 1024.f + EPS);
    for (int i = 0; i < 4; ++i) { const int c = tid + 256 * i; out[(size_t)q * D + c] = DBG_K * (out[(size_t)q * D + c] - xn[i] * rstd * fnw[c]) + 1e-3f; }
}
#ifndef DBG_MODE
#define DBG_MODE -6
#define DBG_C0 2304
#endif
__global__ void __launch_bounds__(512) dbg_dump(Args a) {
    const int gw = blockIdx.x * 8 + (threadIdx.x >> 6), lane = threadIdx.x & 63;
    for (int q = gw; q < NB * SEQ; q += gridDim.x * 8) { const int r = (q >> 13) * RPB + CTXL + (q & 8191);
        float* orow = a.out + (size_t)q * D;
        if (DBG_MODE == 1) {
            const f32x4* xr = (DBG_STOP <= 2 ? (const f32x4*)(a.in[I_X] + (size_t)q * D) : (const f32x4*)((const float*)(a.ws + WS_X) + (size_t)r * D)) + lane; f32x4 v[4]; float ss = 0.f;
            for (int j = 0; j < 4; ++j) { v[j] = xr[64 * j]; ss += v[j].x * v[j].x + v[j].y * v[j].y + v[j].z * v[j].z + v[j].w * v[j].w; }
            const float rstd = 1.0f / sqrtf(wave_sum(ss) * (1.f / D) + EPS);
            for (int j = 0; j < 4; ++j) ((f32x4*)orow)[lane + 64 * j] = v[j] * rstd * ((const f32x4*)a.in[I_FNW])[lane + 64 * j];
        } else if (DBG_MODE == 2) {
            const bf16* m = (const bf16*)(a.ws + BG_MERGED) + (size_t)r * D; for (int j = 0; j < 16; ++j) orow[lane + 64 * j] = bf2f(m[lane + 64 * j]);
        } else if (DBG_MODE == 3) {
            const bf16* p = (const bf16*)(a.ws + BG_PROJ) + (size_t)r * NP;
            for (int j = 0; j < 4; ++j) { orow[lane + 64 * j] = bf2f(p[C_AB + lane + 64 * j]); orow[256 + lane + 64 * j] = bf2f(p[C_Q + lane + 64 * j]); orow[512 + lane + 64 * j] = bf2f(p[C_UR + lane + 64 * j]); orow[768 + lane + 64 * j] = bf2f(p[C_Z + lane + 64 * j]); }
        } else if (DBG_MODE == 4) {
            const bf16* m = (const bf16*)(a.ws + WS_H) + (size_t)r * D; for (int j = 0; j < 16; ++j) orow[lane + 64 * j] = bf2f(m[lane + 64 * j]);
        } else {
            const bf16* p = (const bf16*)(a.ws + BG_PROJ) + (size_t)r * NP + DBG_MODE; for (int j = 0; j < 16; ++j) orow[lane + 64 * j] = bf2f(p[lane + 64 * j]);
        }
    }
}
template <int PHSEL> static void launch_phase(const Args& a, int grid, hipStream_t stream) {
    static bool attr = false;
    if (!attr) { (void)hipFuncSetAttribute((const void*)mk<false, PHSEL>, hipFuncAttributeMaxDynamicSharedMemorySize, LDS_BYTES); attr = true; }
    hipLaunchKernelGGL((mk<false, PHSEL>), dim3(grid), dim3(512), LDS_BYTES, stream, a);
}
__global__ void dbg_nop() {}
static void launch_any(const Args& a, int ph, int grid, hipStream_t stream) {
        if (ph == 0) launch_phase<100>(a, grid, stream);
        else if (ph == 1) launch_phase<101>(a, grid, stream);
        else switch ((ph - 2) % PH_PER_L) {
            case 0: launch_phase<0>(a, grid, stream); break;
            case 1: launch_phase<1>(a, grid, stream); break;
            case 2: launch_phase<2>(a, grid, stream); break;
            case 3: case 6: launch_phase<3>(a, grid, stream); break;
            case 4: launch_phase<4>(a, grid, stream); break;
            case 5: launch_phase<5>(a, grid, stream); break;
            case 7: launch_phase<7>(a, grid, stream); break;
            case 8: launch_phase<8>(a, grid, stream); break;
            case 9: launch_phase<9>(a, grid, stream); break;
            case 10: launch_phase<10>(a, grid, stream); break;
            case 11: launch_phase<11>(a, grid, stream); break;
            case 12: launch_phase<12>(a, grid, stream); break;
            default: launch_phase<13>(a, grid, stream); break;
        }
}
extern "C" void kernel_launch(void* const* d_in, const int* in_sizes, int n_in, void* d_out, int out_size, void* d_ws, size_t ws_size, hipStream_t stream) {
    static int grid = 0;
    if (grid == 0) {
        if (n_in != 29 || ws_size < WS_END || out_size != NB * SEQ * D) { fprintf(stderr, "kernel_launch: unexpected shapes (n_in %d, ws %zu, out %d)\n", n_in, ws_size, out_size); grid = -1; }
        else {
            int dev = 0, cus = 0; (void)hipGetDevice(&dev); (void)hipDeviceGetAttribute(&cus, hipDeviceAttributeMultiprocessorCount, dev);
            grid = cus;
            if (grid != 256) { fprintf(stderr, "kernel_launch: %d CUs: expected 256\n", cus); if (grid <= 0 || grid % 8) grid = -1; }
        }
    }
    if (grid < 0) { (void)hipMemsetAsync(d_out, 0, (size_t)out_size * 4, stream); return; }
    (void)hipMemsetAsync((char*)d_ws + WS_CTL, 0, 1 * MiB, stream);
    Args a{};
    for (int i = 0; i < 29; ++i) a.in[i] = (const float*)d_in[i];
    a.out = (float*)d_out; a.ws = (unsigned char*)d_ws; a.coop = 0; a.pad = 0;
#if PROFILE_GROUPS
    {
        static int extra_k = -1, extra_m = -1;
        hipStreamCaptureStatus cs = hipStreamCaptureStatusNone; (void)hipStreamIsCapturing(stream, &cs);
        if (extra_k < 0 && cs == hipStreamCaptureStatusNone) {
            hipEvent_t ev[N_PHASES + 1]; for (int i = 0; i <= N_PHASES; ++i) (void)hipEventCreate(&ev[i]);
            for (int rep = 0; rep < 2; ++rep) {
                (void)hipMemsetAsync((char*)d_ws + WS_CTL, 0, 1 * MiB, stream);
                for (int ph = 0; ph < N_PHASES; ++ph) { (void)hipEventRecord(ev[ph], stream); a.ph_lo = ph; a.ph_hi = ph + 1; launch_any(a, ph, grid, stream); }
                (void)hipEventRecord(ev[N_PHASES], stream); (void)hipStreamSynchronize(stream); }
            float g[4] = {0, 0, 0, 0};
            for (int ph = 0; ph < N_PHASES; ++ph) { float ms = 0.f; (void)hipEventElapsedTime(&ms, ev[ph], ev[ph + 1]); const int p = ph < 2 ? 100 + ph : (ph - 2) % PH_PER_L;
                const int grp = PROFILE_GROUPS == 7 ? (p == 101 ? 0 : -1) : PROFILE_GROUPS == 6 ? (p == 100 ? 0 : -1) : PROFILE_GROUPS == 5 ? (p == PROFILE_P ? 0 : -1) : PROFILE_GROUPS == 1 ? ((p == 10) ? 0 : ((p == 2 || p == 4 || p == 5 || p == 7) ? 1 : -1)) : PROFILE_GROUPS == 2 ? ((p == 1 || p == 8 || p == 9 || p == 11 || p == 12) ? 0 : ((p == 3 || p == 6 || p == 0 || p == 13) ? 1 : -1)) : PROFILE_GROUPS == 3 ? ((p == 8) ? 0 : (p == 1 ? 1 : -1)) : ((p == 11 || p == 12) ? 0 : (p >= 100 ? 1 : -1));
                if (grp >= 0) g[grp] += ms; }
            extra_k = (int)(g[PROFILE_SEL] * 1000.f / PROFILE_UNIT_US + 0.5f); extra_m = 0; if (extra_k > 33) extra_k = 33;
        }
        (void)hipMemsetAsync((char*)d_ws + WS_CTL, 0, 1 * MiB, stream);
        for (int ph = 0; ph < N_PHASES; ++ph) { a.ph_lo = ph; a.ph_hi = ph + 1; launch_any(a, ph, grid, stream); }
        for (int i = 0; i < (extra_k > 0 ? extra_k : 0); ++i) hipLaunchKernelGGL(dbg_nop, dim3(1), dim3(64), 0, stream);
        for (int i = 0; i < (extra_m > 0 ? extra_m : 0); ++i) (void)hipMemsetAsync((char*)d_ws + WS_CTL + 512 * 1024, 0, 4, stream);
        return;
    }
#endif
#if ONE_LAUNCH
    {   static bool attr = false;
        if (!attr) { (void)hipFuncSetAttribute((const void*)mk<true, -1>, hipFuncAttributeMaxDynamicSharedMemorySize, LDS_BYTES); attr = true; }
        a.ph_lo = 0; a.ph_hi = N_PHASES; a.coop = 1;
        void* args[] = {&a};
        hipError_t e = hipLaunchCooperativeKernel((const void*)mk<true, -1>, dim3(grid), dim3(512), args, LDS_BYTES, stream);
        if (e != hipSuccess) fprintf(stderr, "cooperative launch failed: %s\n", hipGetErrorString(e));
        return;
    }
#endif
    for (int ph = 0; ph < (DBG_STOP ? DBG_STOP : N_PHASES); ++ph) {
        a.ph_lo = ph; a.ph_hi = ph + 1;
        if (DBG_STOP && DBG_MODE == -8 && ph == 4) hipLaunchKernelGGL(dbg_save_u, dim3(R), dim3(256), 0, stream, (const bf16*)((char*)d_ws + BG_PROJ), (bf16*)((char*)d_ws + WS_X));
        if (DBG_STOP && DBG_MODE == -11 && ph == 4) hipLaunchKernelGGL(dbg_save_a, dim3(R), dim3(256), 0, stream, (const bf16*)((char*)d_ws + BG_PROJ), (bf16*)((char*)d_ws + WS_X));
        if (DBG_STOP && DBG_MODE == -6 && ph == 4 + DBG_L * PH_PER_L) {
            hipLaunchKernelGGL(dbg_save_gz, dim3(R), dim3(256), 0, stream, (const bf16*)((char*)d_ws + BG_PROJ), (bf16*)((char*)d_ws + BG_MIX_END));
            for (int mix = 0; mix < 2; ++mix) hipLaunchKernelGGL(dbg_naive_scan, dim3(32), dim3(64), 0, stream, (const bf16*)((char*)d_ws + BG_PROJ), (const float*)((char*)d_ws + SM_DT), (float*)d_out, (const float*)d_in[13] + DBG_L * 3 * 512, (const float*)d_in[14] + DBG_L * 512, (const float*)d_in[15] + DBG_L * 8, (const float*)d_in[16] + DBG_L * 8, (const float*)d_in[17] + DBG_L * 4, (const float*)d_in[11], mix);
        }
        launch_any(a, ph, grid, stream);
    }
    if (DBG_STOP && DBG_MODE == -1) hipLaunchKernelGGL(dbg_gemm, dim3(NB * SEQ), dim3(256), 0, stream, (const bf16*)((char*)d_ws + WS_H), D, (const bf16*)((char*)d_ws + WT_IN), D, D, (const bf16*)((char*)d_ws + BG_PROJ), NP, DBG_C0, (float*)d_out);
    else if (DBG_STOP && DBG_MODE == -2) hipLaunchKernelGGL(dbg_merged, dim3(NB * SEQ), dim3(256), 0, stream, (const bf16*)((char*)d_ws + WS_H), (const bf16*)((char*)d_ws + BG_PROJ), (const bf16*)((char*)d_ws + WT_IN) + (size_t)DBG_L * NWIN * D + (size_t)NP * D, (const bf16*)((char*)d_ws + WT_BR) + (size_t)DBG_L * 4 * D * 256, (const bf16*)((char*)d_ws + BG_MERGED), (float*)d_out);
    else if (DBG_STOP && DBG_MODE == -4) hipLaunchKernelGGL(dbg_moe, dim3(NB * SEQ), dim3(256), 0, stream, (const bf16*)((char*)d_ws + WS_H), (const unsigned*)((char*)d_ws + SM_TOK), (const unsigned*)((char*)d_ws + WS_CTL) + CW_CNT + DBG_L * 32, (const bf16*)((char*)d_ws + BG_YO), (const float*)d_in[25] + (size_t)DBG_L * NE * D * DFF, (const float*)d_in[26] + (size_t)DBG_L * NE * D * DFF, (const float*)d_in[27] + (size_t)DBG_L * NE * D * DFF, (float*)d_out);
    else if (DBG_STOP && DBG_MODE == -5) hipLaunchKernelGGL(dbg_router, dim3(NB * SEQ), dim3(256), 0, stream, (const float*)((char*)d_ws + WS_X), (const float*)((char*)d_ws + SM_MOD) + DBG_L * 5 * 6144, (const float*)d_in[7] + DBG_L * D, (const float*)d_in[21] + DBG_L * D * 4, (const float*)d_in[22] + DBG_L * 4, (const float*)d_in[23] + DBG_L * D * 32, (const float*)d_in[24] + DBG_L * 32, (const unsigned*)((char*)d_ws + SM_TOK), (float*)d_out);
    else if (DBG_STOP && DBG_MODE == -6) hipLaunchKernelGGL(dbg_scan_cmp, dim3(NB * SEQ), dim3(256), 0, stream, (const bf16*)((char*)d_ws + BG_PROJ), (const float*)d_out, (const bf16*)((char*)d_ws + BG_MIX_END), (const float*)d_in[12] + DBG_L * 64, (const float*)d_in[18] + DBG_L * 256, (float*)d_out);
    else if (DBG_STOP && DBG_MODE == -7) hipLaunchKernelGGL(dbg_four, dim3(NB * SEQ), dim3(256), 0, stream, (const bf16*)((char*)d_ws + WS_H), (const float*)d_in[8], (const bf16*)((char*)d_ws + BG_PROJ), (float*)d_out);
    else if (DBG_STOP && DBG_MODE == -8) hipLaunchKernelGGL(dbg_dft, dim3(NB * SEQ), dim3(256), 0, stream, (const bf16*)((char*)d_ws + WS_X), (const bf16*)((char*)d_ws + BG_PROJ), (float*)d_out);
    else if (DBG_STOP && DBG_MODE == -9) { float* MN = (float*)((char*)d_ws + BG_MIX_END);
        hipLaunchKernelGGL(dbg_mod, dim3(24, 5), dim3(256), 0, stream, (const float*)d_in[1], (const float*)d_in[3], (const float*)d_in[4], (const float*)d_in[5], MN);
        hipLaunchKernelGGL(dbg_h, dim3(NB * SEQ), dim3(256), 0, stream, (const float*)d_in[0], MN, (const float*)d_in[6], (const float*)d_in[8], (const bf16*)((char*)d_ws + WS_H), (const float*)((char*)d_ws + SM_DT), (float*)d_out); }
    else if (DBG_STOP && DBG_MODE == -10) hipLaunchKernelGGL(dbg_wt, dim3(NB * SEQ), dim3(256), 0, stream, (const float*)d_in[8] + (size_t)DBG_L * D * NIN, (const float*)d_in[19] + (size_t)DBG_L * 4 * 256 * D, (const float*)d_in[20] + (size_t)DBG_L * D * D,
        (const bf16*)((char*)d_ws + WT_IN) + (size_t)DBG_L * NWIN * D, (const bf16*)((char*)d_ws + WT_BR) + (size_t)DBG_L * 4 * D * 256, (const bf16*)((char*)d_ws + WT_OUT) + (size_t)DBG_L * D * D, (float*)d_out);
    else if (DBG_STOP && DBG_MODE == -11) hipLaunchKernelGGL(dbg_conva, dim3(NB * SEQ), dim3(256), 0, stream, (const bf16*)((char*)d_ws + WS_X), (const bf16*)((char*)d_ws + BG_PROJ), (const float*)d_in[9], (const float*)d_in[10], (float*)d_out);
    else if (DBG_STOP && DBG_MODE == -12) hipLaunchKernelGGL(dbg_final, dim3(NB * SEQ), dim3(256), 0, stream, (const float*)((char*)d_ws + WS_X), (const float*)((char*)d_ws + SM_MOD) + 5 * 6144, (const unsigned*)((char*)d_ws + SM_TOK), (const unsigned*)((char*)d_ws + WS_CTL) + CW_CNT + 32, (const bf16*)((char*)d_ws + BG_YO), (const float*)d_in[28], (float*)d_out);
    else if (DBG_STOP && DBG_MODE == -3) hipLaunchKernelGGL(dbg_d2, dim3(NB * SEQ), dim3(256), 0, stream, (const bf16*)((char*)d_ws + BG_MERGED), (const bf16*)((char*)d_ws + WT_OUT), (const float*)((char*)d_ws + WS_X), (const float*)d_in[0], (const float*)((char*)d_ws + SM_MOD), (float*)d_out);
    else if (DBG_STOP) hipLaunchKernelGGL(dbg_dump, dim3(256), dim3(512), 0, stream, a);
}
```

```cpp
#include <hip/hip_runtime.h>
#include <hip/hip_cooperative_groups.h>
#include <cstdio>
#include <cstdint>
namespace cg = cooperative_groups;

#define GAS __attribute__((address_space(1)))
#define LAS __attribute__((address_space(3)))
typedef unsigned short bf16;
typedef short bf16x8 __attribute__((ext_vector_type(8)));
typedef float f32x4 __attribute__((ext_vector_type(4)));
typedef float f32x2 __attribute__((ext_vector_type(2)));
typedef float f32x16 __attribute__((ext_vector_type(16)));
typedef unsigned u32x4 __attribute__((ext_vector_type(4)));
typedef unsigned u32x2 __attribute__((ext_vector_type(2)));
typedef GAS unsigned gu32;
#define RLX_AGENT __ATOMIC_RELAXED, __HIP_MEMORY_SCOPE_AGENT

#ifndef DBG_VAR
#define DBG_VAR 3
#endif
#ifndef DBG_E4S
#define DBG_E4S 1.0f
#endif
#ifndef PROBE_RT
#define PROBE_RT 0
#endif
#ifndef PROBE_P4
#define PROBE_P4 0
#endif
#ifndef PROBE_P2
#define PROBE_P2 0
#endif
#ifndef PROBE_P0
#define PROBE_P0 0
#endif
#ifndef PROBE_NOCONV
#define PROBE_NOCONV 0
#endif
#ifndef DBG_NOCTX
#define DBG_NOCTX 0
#endif
constexpr int D = 1024, NB = 4, SEQ = 8192, CTXL = 256, DEPTH = 2;
constexpr int RPB = CTXL + SEQ;
constexpr int R = NB * RPB;
constexpr int NIN = 7176;
constexpr int NP = 3328;
constexpr int NWIN = 7424;
constexpr int SPB = RPB / 64;
constexpr int NSPAN = NB * SPB;
constexpr float EPS = 1e-6f;
constexpr int C_AB = 0, C_AC = 256, C_AX = 512, C_Q = 768, C_FF = 1024, C_I = 1536, C_G = 1792, C_UR = 2048, C_UI = 2304, C_Z = 2560, C_XBC = 2816;
constexpr int C_XS = C_AC, C_BC = C_UI;
constexpr int NE = 32, DFF = 512;
constexpr int MAXT = 300;

constexpr size_t MiB = 1u << 20;
constexpr size_t WS_CTL = 0;
constexpr size_t WS_SMALL = 1 * MiB;
constexpr size_t WS_WT = 17 * MiB;
constexpr size_t WS_X = 57 * MiB;
constexpr size_t WS_H = 189 * MiB;
constexpr size_t WS_BIG = 255 * MiB;
constexpr size_t WS_END = 617 * MiB;
constexpr size_t SM_PART = WS_SMALL;
constexpr size_t SM_MOD = SM_PART + 2 * 8 * 5 * 6144 * 4;
constexpr size_t SM_M1 = SM_MOD + 2 * 5 * 6144 * 4;
constexpr size_t SM_M2 = SM_M1 + 128 * 128 * 4;
constexpr size_t SM_M3 = SM_M2 + 256 * 128 * 4;
constexpr size_t SM_TW = SM_M3 + 512 * 256 * 4;
constexpr size_t SM_DT = SM_TW + 128 * 64 * 2 * 4;
constexpr size_t SM_TOK = SM_DT + (size_t)R * 8 * 4;
constexpr size_t SM_LIST = SM_TOK + (size_t)R * 8 * 4;
constexpr size_t SM_CY = SM_LIST + (size_t)NE * R * 4;
constexpr size_t SM_DEC = SM_CY + 4 * 256 * 256 * 2;
constexpr size_t SM_WF = SM_DEC + 4 * 8 * 132 * 64 * 4;
constexpr size_t SM_RC = SM_WF + 5 * 1024 * 64 * 4;
constexpr size_t SM_M1B = SM_RC + 5 * 64 * 4;
constexpr size_t SM_M2B = SM_M1B + 128 * 128 * 2;
constexpr size_t SM_END = SM_M2B + 128 * 256 * 2;
static_assert(SM_END <= WS_WT, "small region");
constexpr size_t WT_IN = WS_WT;
constexpr size_t WT_BR = WT_IN + (size_t)2 * NWIN * D * 2;
constexpr size_t WT_OUT = WT_BR + (size_t)2 * 4 * D * 256 * 2;
static_assert(WT_OUT + (size_t)2 * D * D * 2 <= WS_X, "wt region");
constexpr size_t BG_PROJ = WS_BIG;
constexpr size_t BG_ST = BG_PROJ + (size_t)R * NP * 2;
constexpr size_t BG_ST2 = BG_ST + (size_t)NB * 8 * SPB * 4096 * 2;
constexpr size_t BG_AP = BG_ST + (size_t)NB * 8 * SPB * 4096 * 4;
constexpr size_t BG_MIX_END = BG_AP + (size_t)NB * 64 * 2 * 128 * 256 * 2;
constexpr size_t BG_MERGED = BG_ST;
constexpr size_t BG_GSCR = BG_MERGED + (size_t)R * D * 2;
constexpr size_t BG_MSCR = BG_GSCR + 256 * 131072;
static_assert(BG_MSCR + 256 * 131072 <= WS_END && BG_MIX_END + (size_t)R * 256 * 2 <= WS_END, "big region");
constexpr size_t BG_MF = 600 * MiB;
static_assert(BG_MSCR + 256 * 131072 <= BG_MF && BG_MF + (size_t)4 * NB * CTXL * D * 4 <= WS_END, "ctx branch slabs");
constexpr size_t BG_W13 = WS_BIG;
constexpr size_t BG_W2 = BG_W13 + (size_t)NE * D * D * 2;
constexpr size_t BG_ACT = BG_W2 + (size_t)NE * D * DFF * 2;
constexpr size_t BG_YO = BG_ACT + (size_t)MAXT * 256 * DFF * 2;
static_assert(BG_YO + (size_t)MAXT * 256 * D * 2 <= BG_MF, "moe region");
static_assert(BG_W2 + (size_t)NE * D * DFF * 2 <= BG_MERGED, "moe weights may be converted while merged is live");
constexpr int CW_BAR = 4096;
constexpr int CW_WQ = 32768;
constexpr int CW_CNT = 16384;

constexpr int RING_BYTES = 131072;
constexpr int CTRL_OFF = 139264;
constexpr int MISC_OFF = CTRL_OFF + 320;
constexpr int LDS_BYTES = 147456;

__device__ __forceinline__ unsigned f2bf(float f) { unsigned u = __builtin_bit_cast(unsigned, f); return (u + 0x7fffu + ((u >> 16) & 1u)) >> 16; }
__device__ __forceinline__ unsigned pk2(float lo, float hi) { return f2bf(lo) | (f2bf(hi) << 16); }
__device__ __forceinline__ float bf2f(unsigned short h) { return __builtin_bit_cast(float, (unsigned)h << 16); }
__device__ __forceinline__ float bflo(unsigned u) { return __builtin_bit_cast(float, u << 16); }
__device__ __forceinline__ float bfhi(unsigned u) { return __builtin_bit_cast(float, u & 0xffff0000u); }
__device__ __forceinline__ float wave_sum(float v) {
#pragma unroll
    for (int o = 1; o < 64; o <<= 1) v += __shfl_xor(v, o);
    return v;
}
__device__ __forceinline__ float sigmoidf_(float x) { return __builtin_amdgcn_rcpf(1.0f + __expf(-x)); }
__device__ __forceinline__ float siluf_(float x) { return x * __builtin_amdgcn_rcpf(1.0f + __expf(-x)); }
__device__ __forceinline__ float softplusf_(float x) { return x > 20.f ? x : log1pf(__expf(x)); }
#define LDS_WAIT() asm volatile("s_waitcnt lgkmcnt(0)" ::: "memory")
#define VM_WAIT() asm volatile("s_waitcnt vmcnt(0)" ::: "memory")

__device__ __forceinline__ int row_cr(int r) { const int b = r / RPB, s = r - b * RPB; return s < CTXL ? 4 : b; }

#define XB_TMO      128
#define XB_XCNT(j)  (256  + 64 * (j))
#define XB_XSUB(j)  (1280 + 64 * (j))
#define XB_XGEN(j)  (2304 + 64 * (j))
#define XB_TOP      3328
#define XB_TOPGEN   3392
#define XCD_BAR_WORDS 3456
#define XB_SPIN_CAP (1u << 20)
__device__ __forceinline__ unsigned xb_ld(unsigned* p)              { return __hip_atomic_load(p, __ATOMIC_RELAXED, __HIP_MEMORY_SCOPE_AGENT); }
__device__ __forceinline__ unsigned xb_add(unsigned* p, unsigned v) { return __hip_atomic_fetch_add(p, v, __ATOMIC_RELAXED, __HIP_MEMORY_SCOPE_AGENT); }
__device__ __forceinline__ unsigned xb_xcc_id() { return (unsigned)__builtin_amdgcn_s_getreg((3 << 11) | 20) & 0xFu; }
#define XB_SPIN(cond, bar) do { unsigned _sp = 0; while (cond) { __builtin_amdgcn_s_sleep(1); \
    if ((++_sp & 255u) == 0u) { if (xb_ld(&(bar)[XB_TMO])) break; if (_sp > XB_SPIN_CAP) { atomicAdd(&(bar)[XB_TMO], 1u); break; } } } } while (0)
struct XcdBarrier { unsigned* bar; unsigned x; volatile LAS unsigned* st; };
__device__ __forceinline__ XcdBarrier xcd_barrier_post(unsigned* bar, volatile LAS unsigned* st) {
    XcdBarrier b; b.bar = bar; b.x = xb_xcc_id(); b.st = st;
    if (threadIdx.x == 0) (void)xb_add(&bar[XB_XCNT(b.x)], 1u);
    return b;
}
__device__ __forceinline__ void xcd_barrier_complete(unsigned* bar, unsigned x, unsigned& nloc, unsigned& nx) {
    const unsigned G = gridDim.x * gridDim.y * gridDim.z;
    unsigned sum, cnt, mine, sp = 0u;
    for (;;) {
        sum = 0u; cnt = 0u; mine = 0u;
#pragma unroll
        for (unsigned j = 0; j < 16; ++j) { const unsigned c = xb_ld(&bar[XB_XCNT(j)]); sum += c; cnt += (c > 0u) ? 1u : 0u; mine = (j == x) ? c : mine; }
        if (sum == G) break;
        __builtin_amdgcn_s_sleep(1);
        if ((++sp & 255u) == 0u) { if (xb_ld(&bar[XB_TMO])) break; if (sp > XB_SPIN_CAP) { atomicAdd(&bar[XB_TMO], 1u); break; } }
    }
    nloc = mine > 0u ? mine : 1u; nx = cnt > 0u ? cnt : 1u;
}
__device__ __forceinline__ void xcd_barrier(const XcdBarrier& b, const int tid) {
    asm volatile("s_waitcnt vmcnt(0)" ::: "memory");
    __syncthreads();
    if (tid == 0) {
        unsigned* bar = b.bar;
        __builtin_amdgcn_s_waitcnt(0);
        unsigned nloc = b.st[0], nx = b.st[1];
        if (nloc == 0u) { xcd_barrier_complete(bar, b.x, nloc, nx); b.st[0] = nloc; b.st[1] = nx; }
        const unsigned old = xb_add(&bar[XB_XSUB(b.x)], 1u);
        const unsigned gen = old / nloc;
        if (old + 1u == (gen + 1u) * nloc) {
            __builtin_amdgcn_fence(__ATOMIC_RELEASE, "agent");
            asm volatile("s_waitcnt vmcnt(0)" ::: "memory");
            const unsigned og = xb_add(&bar[XB_TOP], 1u);
            const unsigned tg = og / nx;
            if (og + 1u == (tg + 1u) * nx) xb_add(&bar[XB_TOPGEN], 1u);
            else XB_SPIN(xb_ld(&bar[XB_TOPGEN]) == tg, bar);
            __builtin_amdgcn_fence(__ATOMIC_ACQUIRE, "agent");
            xb_add(&bar[XB_XGEN(b.x)], 1u);
            asm volatile("s_waitcnt vmcnt(0)" ::: "memory");
        } else {
            XB_SPIN(xb_ld(&bar[XB_XGEN(b.x)]) == gen, bar);
            __builtin_amdgcn_fence(__ATOMIC_ACQUIRE, "agent");
            asm volatile("s_waitcnt vmcnt(0)" ::: "memory");
        }
    }
    __syncthreads();
}

namespace ge {
constexpr int BM = 256, BK = 64, HALF = 128, HTB = HALF * BK * 2, NXCD = 8, WGM = 8;
__device__ __forceinline__ int lds_byte(int r, int c) { const int st = (r >> 4) * 2 + (c >> 5), rr = r & 15, cc = c & 31, ob = rr * 64 + cc * 2; return st * 1024 + (ob ^ (((ob >> 9) & 1) << 5)); }
__device__ __forceinline__ void stage_rc(int b, int& R_, int& C_) { const int st = b / 1024, sb = b % 1024, swz = sb ^ (((sb >> 9) & 1) << 5); R_ = (st >> 1) * 16 + swz / 64; C_ = (st & 1) * 32 + (swz % 64) / 2; }
__device__ __forceinline__ int perm32(int rho) { const int n = rho >> 4, i = rho & 15; return 8 * (i >> 2) + 4 * n + (i & 3); }

struct Unit { const char* A; const char* B; const int* rows; unsigned lda, ldb; int nt, kind, pm, pn, aux; };

__device__ __forceinline__ bool tile_order(long L, int nM, int nN, int& pm, int& pn) {
    const int nwg = nM * nN; if (L >= nwg) return false;
    int wgid = (int)L; { const int q = nwg / NXCD, r = nwg % NXCD, xcd = wgid % NXCD, off = wgid / NXCD; wgid = (xcd < r ? xcd * (q + 1) : r * (q + 1) + (xcd - r) * q) + off; }
    const int nig = WGM * nN, gid = wgid / nig, fm = gid * WGM, gsz = (nM - fm) < WGM ? (nM - fm) : WGM;
    pm = fm + ((wgid % nig) % gsz); pn = (wgid % nig) / gsz; return true;
}

template <class Epi, class Sched, bool GATHER, bool ALIGN_EPI = true>
__device__ __forceinline__ void gemm_engine(LAS unsigned char* lds, const Sched& S, const Epi& E, const int tid) {
    const int wid = __builtin_amdgcn_readfirstlane(tid >> 6), lane = tid & 63, wr = wid >> 2, wc = wid & 3, fr = lane & 15, fq = lane >> 4;
    unsigned voffA[2][2], voffB[2];
    const size_t kstep = (size_t)(BK * 2);
    const unsigned ldsw = (unsigned)wid * 1024u;
    const int aoff = lds_byte(wr * 64 + fr, fq * 8), boff = lds_byte(wc * 32 + fr, fq * 8);
#define GE_SETV(u) do { int t_ = tid; asm volatile("" : "+v"(t_)); _Pragma("unroll") for (int _i = 0; _i < 2; ++_i) { int R_, C_; stage_rc(t_ * 16 + _i * 8192, R_, C_); const int Rb_ = Epi::PERM ? ((R_ & ~31) + perm32(R_ & 31)) : R_; \
        if (GATHER) { const int i0_ = R_ < (u).aux ? (u).rows[R_] : 0, i1_ = (HALF + R_) < (u).aux ? (u).rows[HALF + R_] : 0; \
            voffA[0][_i] = (unsigned)i0_ * (u).lda + (unsigned)C_ * 2u; voffA[1][_i] = (unsigned)i1_ * (u).lda + (unsigned)C_ * 2u; } \
        else { voffA[0][_i] = (unsigned)R_ * (u).lda + (unsigned)C_ * 2u; voffA[1][_i] = voffA[0][_i]; } \
        voffB[_i] = (unsigned)Rb_ * (u).ldb + (unsigned)C_ * 2u; } hstepB = (size_t)HALF * (u).ldb; hstepA = GATHER ? (size_t)0 : (size_t)HALF * (u).lda; } while (0)
#define GE_SA(b, h) (((b) * 2 + (h)) * HTB)
#define GE_SB(b, h) ((4 + (b) * 2 + (h)) * HTB)
#define GE_STAGE(bufoff, gbase, voff) do { _Pragma("unroll") for (int _i = 0; _i < 2; ++_i) \
        __builtin_amdgcn_global_load_lds((const unsigned*)((const char*)(gbase) + (voff)[_i]), (LAS unsigned*)(lds + (bufoff) + ldsw + _i * 8192), 16, 0, 0); } while (0)
#define GE_LDA(dst, b, h) do { _Pragma("unroll") for (int m = 0; m < 4; ++m) _Pragma("unroll") for (int k = 0; k < 2; ++k) dst[m][k] = *(const LAS bf16x8*)(lds + GE_SA(b, h) + aoff + m * 2048 + k * 1024); } while (0)
#define GE_LDB(dst, b, h) do { _Pragma("unroll") for (int n = 0; n < 2; ++n) _Pragma("unroll") for (int k = 0; k < 2; ++k) dst[n][k] = *(const LAS bf16x8*)(lds + GE_SB(b, h) + boff + n * 2048 + k * 1024); } while (0)
#define GE_MMA(ai, bj, At, Bt) do { __builtin_amdgcn_s_setprio(1); _Pragma("unroll") for (int m = 0; m < 4; ++m) _Pragma("unroll") for (int n = 0; n < 2; ++n) _Pragma("unroll") for (int k = 0; k < 2; ++k) \
        acc[ai][bj][m][n] = __builtin_amdgcn_mfma_f32_16x16x32_bf16(Bt[n][k], At[m][k], acc[ai][bj][m][n], 0, 0, 0); __builtin_amdgcn_s_setprio(0); } while (0)
#define GE_WAIT_V(n) asm volatile("s_waitcnt vmcnt(" #n ")" ::: "memory")
#define GE_WAIT_L(n) asm volatile("s_waitcnt lgkmcnt(" #n ")" ::: "memory")
#define GE_BAR __builtin_amdgcn_s_barrier()
#define GE_SCHED __builtin_amdgcn_sched_barrier(0)
    Unit cur, nxt; int ui = 0;
    if (!S.next(0, cur)) return;
    f32x4 acc[2][2][4][2];
#pragma unroll
    for (int a = 0; a < 2; ++a)
#pragma unroll
        for (int b = 0; b < 2; ++b)
#pragma unroll
            for (int m = 0; m < 4; ++m)
#pragma unroll
                for (int n = 0; n < 2; ++n) acc[a][b][m][n] = (f32x4){0.f, 0.f, 0.f, 0.f};
    bf16x8 At[4][2], B0[2][2], B1[2][2];
    size_t hstepB, hstepA;
    GE_SETV(cur);
    if (GATHER) { VM_WAIT(); }
    const char* cA = cur.A; const char* cB = cur.B;
    GE_STAGE(GE_SB(0, 0), cB, voffB); GE_STAGE(GE_SB(0, 1), cB + hstepB, voffB); GE_STAGE(GE_SA(0, 0), cA, voffA[0]); GE_STAGE(GE_SA(0, 1), cA + hstepA, voffA[1]);
    if (wr == 1) GE_BAR;
    GE_WAIT_V(2); GE_BAR;
    GE_STAGE(GE_SB(1, 0), cB + kstep, voffB); GE_STAGE(GE_SA(1, 0), cA + kstep, voffA[0]); GE_STAGE(GE_SB(1, 1), cB + hstepB + kstep, voffB);
    GE_WAIT_V(6); GE_BAR;
    for (;;) {
        const bool has_next = S.next(ui + 1, nxt);
        const char* nA = has_next ? nxt.A : cA; const char* nB = has_next ? nxt.B : cB;
        const int nt = cur.nt;
        for (int t = 0; t < nt; t += 2) {
            const bool last = (t == nt - 2);
            const char* a1 = cA + (size_t)(t + 1) * kstep;
            const char* a2 = last ? nA : cA + (size_t)(t + 2) * kstep; const char* b2 = last ? nB : cB + (size_t)(t + 2) * kstep;
            const char* a3 = a2 + kstep; const char* b3 = b2 + kstep;
            GE_LDB(B0, 0, 0); GE_LDB(B1, 0, 1); GE_SCHED; GE_LDA(At, 0, 0); GE_STAGE(GE_SA(1, 1), a1 + hstepA, voffA[1]);
            GE_WAIT_V(8); GE_WAIT_L(0); GE_BAR; GE_MMA(0, 0, At, B0); GE_MMA(0, 1, At, B1); GE_BAR; GE_SCHED;
            if (last && has_next) { GE_SETV(nxt); if (GATHER) { VM_WAIT(); } }
            GE_LDA(At, 0, 1); GE_STAGE(GE_SB(0, 0), b2, voffB); GE_STAGE(GE_SB(0, 1), b2 + hstepB, voffB); GE_STAGE(GE_SA(0, 0), a2, voffA[0]);
            GE_WAIT_V(8); GE_WAIT_L(0); GE_BAR; GE_MMA(1, 0, At, B0); GE_MMA(1, 1, At, B1); GE_BAR; GE_SCHED;
            GE_LDB(B0, 1, 0); GE_LDB(B1, 1, 1); GE_SCHED; GE_LDA(At, 1, 0); GE_STAGE(GE_SA(0, 1), a2 + hstepA, voffA[1]);
            GE_WAIT_V(8); GE_WAIT_L(0); GE_BAR; GE_MMA(0, 0, At, B0); GE_MMA(0, 1, At, B1); GE_BAR; GE_SCHED;
            GE_LDA(At, 1, 1); GE_STAGE(GE_SB(1, 0), b3, voffB); GE_STAGE(GE_SB(1, 1), b3 + hstepB, voffB); GE_STAGE(GE_SA(1, 0), a3, voffA[0]);
            GE_WAIT_V(8); GE_WAIT_L(0); GE_BAR; GE_MMA(1, 0, At, B0); GE_MMA(1, 1, At, B1); GE_BAR; GE_SCHED;
        }
        if (ALIGN_EPI) { if (wr == 0) GE_BAR; }
        { int tid_o = tid, fr_o = fr, fq_o = fq; asm volatile("" : "+v"(tid_o), "+v"(fr_o), "+v"(fq_o)); E(acc, cur, wr, wc, fr_o, fq_o, tid_o); }
        if (!has_next) break;
        if (Epi::DRAIN) GE_WAIT_V(0);
#pragma unroll
        for (int a = 0; a < 2; ++a)
#pragma unroll
            for (int b = 0; b < 2; ++b)
#pragma unroll
                for (int m = 0; m < 4; ++m)
#pragma unroll
                    for (int n = 0; n < 2; ++n) acc[a][b][m][n] = (f32x4){0.f, 0.f, 0.f, 0.f};
        cur = nxt; cA = nA; cB = nB; ++ui;
        if (ALIGN_EPI) { if (wr == 1) GE_BAR; }
    }
    GE_WAIT_V(0);
    if (!ALIGN_EPI) { if (wr == 0) GE_BAR; }
    GE_BAR;
#undef GE_SETV
#undef GE_SA
#undef GE_SB
#undef GE_STAGE
#undef GE_LDA
#undef GE_LDB
#undef GE_MMA
#undef GE_WAIT_V
#undef GE_WAIT_L
#undef GE_BAR
#undef GE_SCHED
}
typedef float cvt_f32x2 __attribute__((ext_vector_type(2)));
typedef __bf16 cvt_bf16x2 __attribute__((ext_vector_type(2)));
__device__ __forceinline__ unsigned cvt_pk_bf16(float lo, float hi) { const cvt_f32x2 v = {lo, hi}; return __builtin_bit_cast(unsigned, __builtin_convertvector(v, cvt_bf16x2)); }
}

struct Args { const float* in[29]; float* out; unsigned char* ws; int ph_lo, ph_hi, coop, pad; };
typedef __attribute__((address_space(4))) const Args CArgs;
__device__ __forceinline__ CArgs* kargs() { unsigned long long p = (unsigned long long)__builtin_amdgcn_kernarg_segment_ptr(); asm volatile("" : "+s"(p)); return (CArgs*)p; }
#define KA_DECL CArgs* const KA = kargs()
struct Fr {
    LAS unsigned char* lds;
    int tid, lane, wave, G, bid;
};
enum { I_X = 0, I_C, I_CTX, I_CCTX, I_ADAW, I_ADAB, I_NMIX, I_NFFN, I_WIN, I_CAW, I_CAB, I_HLB, I_HNW, I_SCW, I_SCB, I_ALOG, I_DTB, I_SD, I_SNW, I_WBR, I_WOUT, I_RGW, I_RGB, I_REW, I_REB, I_W1, I_W3, I_W2, I_FNW };

#define WSP(T, off) ((T*)(KA->ws + (off)))

__device__ __forceinline__ const float* xrow_ptr(CArgs* KA, int l, int r) {
    if (l > 0) return WSP(const float, WS_X) + (size_t)r * D;
    const int b = r / RPB, s = r - b * RPB;
    return s < CTXL ? KA->in[I_CTX] + ((size_t)b * CTXL + s) * D : KA->in[I_X] + ((size_t)b * SEQ + (s - CTXL)) * D;
}

__device__ __forceinline__ void transpose_item(const float* W, int ldw, int k0, int n0, bf16* WT, int ldt, int drow0, LAS float* scr, int lane) {
#pragma unroll 8
    for (int i = 0; i < 32; ++i) { const int kk = 2 * i + (lane >> 5); scr[kk * 33 + (lane & 31)] = W[(size_t)(k0 + kk) * ldw + n0 + (lane & 31)]; }
    LDS_WAIT(); asm volatile("" ::: "memory");
    const int c = lane & 7;
#pragma unroll
    for (int j = 0; j < 4; ++j) { const int n = (lane >> 3) + 8 * j; const LAS float* s = scr + (8 * c) * 33 + n;
        u32x4 o; o.x = pk2(s[0 * 33], s[1 * 33]); o.y = pk2(s[2 * 33], s[3 * 33]); o.z = pk2(s[4 * 33], s[5 * 33]); o.w = pk2(s[6 * 33], s[7 * 33]);
        *(u32x4*)(WT + (size_t)(drow0 + n) * ldt + k0 + 8 * c) = o; }
    LDS_WAIT(); asm volatile("" ::: "memory");
}
__device__ __forceinline__ void transpose_item64(const float* W, int ldw, int k0, int n0, bf16* WT, int ldt, int drow0, LAS unsigned char* scr, int lane) {
    f32x4 v[16];
#pragma unroll
    for (int i = 0; i < 16; ++i) v[i] = *(const f32x4*)(W + (size_t)(k0 + 4 * i + (lane >> 4)) * ldw + n0 + 4 * (lane & 15));
    LAS bf16* img = (LAS bf16*)scr;
#pragma unroll
    for (int i = 0; i < 16; ++i) { const int kk = 4 * i + (lane >> 4), n = 4 * (lane & 15);
        img[(n + 0) * 72 + kk] = (bf16)f2bf(v[i].x); img[(n + 1) * 72 + kk] = (bf16)f2bf(v[i].y); img[(n + 2) * 72 + kk] = (bf16)f2bf(v[i].z); img[(n + 3) * 72 + kk] = (bf16)f2bf(v[i].w); }
    LDS_WAIT(); asm volatile("" ::: "memory");
#pragma unroll
    for (int j = 0; j < 8; ++j) { const int n = 8 * j + (lane >> 3), c = lane & 7;
        *(u32x4*)(WT + (size_t)(drow0 + n) * ldt + k0 + 8 * c) = *(const LAS u32x4*)(img + n * 72 + 8 * c); }
    LDS_WAIT(); asm volatile("" ::: "memory");
}
constexpr int PRO_L1_ITEMS = 16 * 108 + 512 + 256 + 256, PRO_L1_TICKETS = PRO_L1_ITEMS / 8;
__device__ __forceinline__ void p0_prologue(Fr& F, int ticket) { KA_DECL;
    LAS float* scr = (LAS float*)(F.lds + F.wave * 16384);
    const int gw = F.bid * 8 + F.wave, NGW = F.G * 8, lane = F.lane;
    LAS float* ctab = scr + 2400; LAS float* stab = scr + 2464;
    { float s, c; sincospif(2.0f * (float)lane / 64.0f, &s, &c); ctab[lane] = c; stab[lane] = s; }
    LDS_WAIT();
    constexpr int I_INN = 16 * 108, I_DFT = 512, I_BR = 256, I_OUT = 256, I_ADA = 96 * 8;
    constexpr int PER_L = I_INN + I_DFT + I_BR + I_OUT + I_ADA;
    static_assert(PRO_L1_ITEMS == I_INN + I_DFT + I_BR + I_OUT && PRO_L1_ITEMS % 8 == 0, "layer-1 conversion items");
    const int it_lo = ticket < 0 ? gw : PER_L + I_ADA + 8 * ticket + F.wave, it_hi = ticket < 0 ? 2 * PER_L : it_lo + 1, it_st = ticket < 0 ? NGW : 1;
    for (int it = it_lo; it < it_hi; it += it_st) {
        const int l = it / PER_L; int r = it % PER_L;
        if (l == 1) r = (r + PER_L - I_ADA) % PER_L;
        if (ticket < 0 && l == 1 && r < PRO_L1_ITEMS) continue;
        const float* win = KA->in[I_WIN] + (size_t)l * D * NIN;
        bf16* wt_in = WSP(bf16, WT_IN) + (size_t)l * NWIN * D;
        if (PROBE_P0 && PROBE_P0 != 1 && r < I_INN + I_DFT + I_BR + I_OUT && !(r >= I_INN && r < I_INN + I_DFT)) continue;
        if (PROBE_P0 && PROBE_P0 != 2 && r >= I_INN && r < I_INN + I_DFT) continue;
        if (PROBE_P0 && PROBE_P0 != 3 && r >= I_INN + I_DFT + I_BR + I_OUT) continue;
        if (r < I_INN) {
            const int kb = r / 108, q = r % 108; int dst, src;
            if (q < 32) { dst = 64 * q; src = 64 * q; } else if (q < 36) { dst = 2560 + 64 * (q - 32); src = 2304 + 64 * (q - 32); }
            else if (q < 44) { dst = 2816 + 64 * (q - 36); src = 2560 + 64 * (q - 36); } else { dst = 3328 + 64 * (q - 44); src = 3080 + 64 * (q - 44); }
            transpose_item64(win, NIN, 64 * kb, src, wt_in, D, dst, F.lds + F.wave * 16384, lane); continue; }
        r -= I_INN;
        if (r < I_DFT) {
            const int kb = r >> 5, g = (r >> 3) & 3, cpb = r & 7; const int k = 64 * kb + lane;
            float w[64];
            const f32x4* src = (const f32x4*)(win + (size_t)k * NIN + 2048 + g * 64);
#pragma unroll
            for (int j = 0; j < 16; ++j) { const f32x4 v = src[j]; w[4 * j] = v.x; w[4 * j + 1] = v.y; w[4 * j + 2] = v.z; w[4 * j + 3] = v.w; }
            for (int cp = 8 * cpb; cp < 8 * cpb + 8; ++cp) {
                float ur = 0.f, ui = 0.f;
#pragma unroll
                for (int c = 0; c < 64; ++c) { const int m = (c * cp) & 63; ur += w[c] * ctab[m]; ui -= w[c] * stab[m]; }
                wt_in[(size_t)(C_UR + g * 64 + cp) * D + k] = (bf16)f2bf(ur);
                wt_in[(size_t)(C_UI + g * 64 + cp) * D + k] = (bf16)f2bf(ui);
            }
            continue; }
        r -= I_DFT;
        if (r < I_BR) { const int kbr = r >> 6, q = r & 63, kb = q >> 4, nb = q & 15;
            transpose_item64(KA->in[I_WBR] + ((size_t)l * 4 + kbr) * 256 * D, D, 64 * kb, 64 * nb, WSP(bf16, WT_BR) + ((size_t)l * 4 + kbr) * D * 256, 256, 64 * nb, F.lds + F.wave * 16384, lane); continue; }
        r -= I_BR;
        if (r < I_OUT) { const int kb = r >> 4, nb = r & 15;
            transpose_item64(KA->in[I_WOUT] + (size_t)l * D * D, D, 64 * kb, 64 * nb, WSP(bf16, WT_OUT) + (size_t)l * D * D, D, 64 * nb, F.lds + F.wave * 16384, lane); continue; }
        r -= I_OUT;
        {
            const int jb = r >> 3, ks = r & 7, j = jb * 64 + lane;
            const float* aw = KA->in[I_ADAW] + (size_t)l * D * 6144;
            LAS float* sv = scr + 2560;
#pragma unroll
            for (int q = 0; q < 10; ++q) { const int e = q * 64 + lane, cr = e >> 7, kk = e & 127; const float cv = cr < 4 ? KA->in[I_C][cr * D + ks * 128 + kk] : KA->in[I_CCTX][ks * 128 + kk]; sv[e] = siluf_(cv); }
            LDS_WAIT(); asm volatile("" ::: "memory");
            float a0 = 0.f, a1 = 0.f, a2 = 0.f, a3 = 0.f, a4 = 0.f;
#pragma unroll 8
            for (int kk = 0; kk < 128; ++kk) { const float wv = aw[(size_t)(ks * 128 + kk) * 6144 + j];
                a0 += sv[kk] * wv; a1 += sv[128 + kk] * wv; a2 += sv[256 + kk] * wv; a3 += sv[384 + kk] * wv; a4 += sv[512 + kk] * wv; }
            float* part = WSP(float, SM_PART) + ((size_t)(l * 8 + ks) * 5) * 6144 + j;
            part[0] = a0; part[6144] = a1; part[2 * 6144] = a2; part[3 * 6144] = a3; part[4 * 6144] = a4;
            LDS_WAIT(); asm volatile("" ::: "memory");
        }
    }
    if (ticket >= 0) return;
    if (PROBE_P0 && PROBE_P0 != 4) return;
    const int gt = F.bid * 512 + F.tid, NGT = F.G * 512;
    float* M1 = WSP(float, SM_M1); float* M2 = WSP(float, SM_M2); float* M3 = WSP(float, SM_M3); float* TW = WSP(float, SM_TW);
    for (int e = gt; e < 128 * 128; e += NGT) {
        const int k = e >> 7, m = e & 127, ri = k >> 6, t1 = k & 63, ro = m >> 6, k1 = m & 63; float s, c; sincospif(2.0f * (float)((t1 * k1) & 63) / 64.0f, &s, &c);
        M1[e] = ro == 0 ? (ri == 0 ? c : s) : (ri == 0 ? -s : c); }
    for (int e = gt; e < 256 * 128; e += NGT) {
        const int k = e >> 7, k2 = e & 127, ri = k >> 7, t2 = k & 127; float s, c; sincospif(2.0f * (float)((t2 * k2) & 127) / 128.0f, &s, &c);
        M2[e] = ri == 0 ? c : s; }
    for (int e = gt; e < 128 * 128; e += NGT) {
        const int m = e >> 7, k = e & 127, ri = k >> 6, t1 = k & 63, ro = m >> 6, k1 = m & 63; float s, c; sincospif(2.0f * (float)((t1 * k1) & 63) / 64.0f, &s, &c);
        WSP(bf16, SM_M1B)[e] = (bf16)f2bf(ro == 0 ? (ri == 0 ? c : s) : (ri == 0 ? -s : c)); }
    for (int e = gt; e < 128 * 256; e += NGT) {
        const int k2 = e >> 8, k = e & 255, ri = k >> 7, t2 = k & 127; float s, c; sincospif(2.0f * (float)((t2 * k2) & 127) / 128.0f, &s, &c);
        WSP(bf16, SM_M2B)[e] = (bf16)f2bf(ri == 0 ? c : s); }
    for (int e = gt; e < 512 * 256; e += NGT) {
        const int k = e >> 8, tp = e & 255, ri = k >> 8, t = k & 255; float s, c; sincospif(2.0f * (float)((t * tp) & 255) / 256.0f, &s, &c);
        M3[e] = ri == 0 ? c : s; }
    for (int e = gt; e < 128 * 64; e += NGT) {
        const int t2 = e >> 6, k1 = e & 63; float s, c; sincospif(2.0f * (float)(t2 * k1) / 8192.0f, &s, &c); TW[2 * e] = c; TW[2 * e + 1] = s; }
}
__device__ __forceinline__ void p1_mod(Fr& F) { KA_DECL;
    const int gt = F.bid * 512 + F.tid, NGT = F.G * 512;
    for (int e = gt; e < 2 * 5 * 6144; e += NGT) { const int l = e / (5 * 6144), rem = e % (5 * 6144), cr = rem / 6144, j = rem % 6144;
        float s = KA->in[I_ADAB][l * 6144 + j];
#pragma unroll
        for (int ks = 0; ks < 8; ++ks) s += WSP(const float, SM_PART)[((size_t)(l * 8 + ks) * 5 + cr) * 6144 + j];
        WSP(float, SM_MOD)[e] = s; }
}
__device__ __forceinline__ void moe_convert_item(Fr& F, int l, int it) { KA_DECL;
    LAS unsigned char* scr = F.lds + F.wave * 16384; const int lane = F.lane;
    {   const int which = it >> 12, r = it & 4095, e = r >> 7, q = r & 127;
        if (which < 2) { const int kb = q >> 3, nb = q & 7; const float* W = KA->in[which == 0 ? I_W1 : I_W3] + ((size_t)l * NE + e) * D * DFF;
            transpose_item64(W, DFF, 64 * kb, 64 * nb, WSP(bf16, BG_W13) + (size_t)e * D * D, D, (nb >> 1) * 256 + which * 128 + (nb & 1) * 64, scr, lane); }
        else { const int kb = q >> 4, nb = q & 15; const float* W = KA->in[I_W2] + ((size_t)l * NE + e) * DFF * D;
            transpose_item64(W, D, 64 * kb, 64 * nb, WSP(bf16, BG_W2) + (size_t)e * D * DFF, DFF, 64 * nb, scr, lane); }
    }
}

__device__ __forceinline__ void pa_hrows(Fr& F, int l) { KA_DECL;
    LAS float* wdt = (LAS float*)F.lds;
    const float* win = KA->in[I_WIN] + (size_t)l * D * NIN;
    for (int e = F.tid; e < D * 8; e += 512) wdt[e] = win[(size_t)(e >> 3) * NIN + 3072 + (e & 7)];
    __syncthreads();
    const int gw = F.bid * 8 + F.wave, NGW = F.G * 8, lane = F.lane;
    const float* nw = KA->in[I_NMIX] + l * D;
    f32x4 nw4[4];
#pragma unroll
    for (int j = 0; j < 4; ++j) nw4[j] = *(const f32x4*)(nw + 4 * (lane + 64 * j));
    f32x4 p1[4], p2[4];
#pragma unroll
    for (int j = 0; j < 4; ++j) { p1[j] = (f32x4){0.f, 0.f, 0.f, 0.f}; p2[j] = p1[j]; }
#define PA_LOAD(dst, rr) do { const GAS f32x4* xr_ = (const GAS f32x4*)xrow_ptr(KA, l, (rr)) + lane; _Pragma("unroll") for (int j_ = 0; j_ < 4; ++j_) dst[j_] = xr_[64 * j_]; } while (0)
    if (gw < R) PA_LOAD(p1, gw);
    if (gw + NGW < R) PA_LOAD(p2, gw + NGW);
    for (int r = gw; r < R; r += NGW) {
        const int cr = row_cr(r);
        const float* mod = WSP(const float, SM_MOD) + ((size_t)l * 5 + cr) * 6144;
        f32x4 v[4]; float s = 0.f;
#pragma unroll
        for (int j = 0; j < 4; ++j) { v[j] = p1[j]; p1[j] = p2[j]; }
        if (r + 2 * NGW < R) PA_LOAD(p2, r + 2 * NGW);
#pragma unroll
        for (int j = 0; j < 4; ++j) s += (v[j].x * v[j].x + v[j].y * v[j].y) + (v[j].z * v[j].z + v[j].w * v[j].w);
        f32x4 sh4[4], sc4[4];
#pragma unroll
        for (int j = 0; j < 4; ++j) { const int k = 4 * (lane + 64 * j); sh4[j] = *(const GAS f32x4*)((const GAS float*)mod + k); sc4[j] = *(const GAS f32x4*)((const GAS float*)mod + 1024 + k); }
        const float rstd = 1.0f / sqrtf(wave_sum(s) * (1.f / D) + EPS);
        float d8[8] = {0, 0, 0, 0, 0, 0, 0, 0};
        unsigned long long* o8 = (unsigned long long*)(WSP(bf16, WS_H) + (size_t)r * D) + lane;
#pragma unroll
        for (int j = 0; j < 4; ++j) { const int k = 4 * (lane + 64 * j);
            const f32x4 w4 = nw4[j], sh = sh4[j], sc = sc4[j];
            f32x4 h = (v[j] * rstd) * w4 * (sc + 1.0f) + sh;
            o8[64 * j] = (unsigned long long)pk2(h.x, h.y) | ((unsigned long long)pk2(h.z, h.w) << 32);
#pragma unroll
            for (int e = 0; e < 4; ++e) { const f32x4 wa = *(const LAS f32x4*)(wdt + (k + e) * 8), wb = *(const LAS f32x4*)(wdt + (k + e) * 8 + 4); const float hv = h[e];
                d8[0] += hv * wa.x; d8[1] += hv * wa.y; d8[2] += hv * wa.z; d8[3] += hv * wa.w; d8[4] += hv * wb.x; d8[5] += hv * wb.y; d8[6] += hv * wb.z; d8[7] += hv * wb.w; } }
#pragma unroll
        for (int e = 0; e < 8; ++e) d8[e] = wave_sum(d8[e]);
        if (lane == 0) { float* dt = WSP(float, SM_DT) + (size_t)r * 8; *(f32x4*)dt = (f32x4){d8[0], d8[1], d8[2], d8[3]}; *(f32x4*)(dt + 4) = (f32x4){d8[4], d8[5], d8[6], d8[7]}; }
    }
    __syncthreads();
}

__device__ __forceinline__ void nbr_valid(int r, bool& vp, bool& vn) { const int s = r % RPB; vp = (s != 0) && (s != CTXL); vn = (s != CTXL - 1) && (s != RPB - 1); }

__device__ __forceinline__ void conv_a_pass(Fr& F, int l) { KA_DECL;
    const int gt = F.bid * 512 + F.tid, NGT = F.G * 512;
    bf16* P = WSP(bf16, BG_PROJ);
    const float* cw = KA->in[I_CAW] + l * 3 * 256; const float* cb = KA->in[I_CAB] + l * 256;
    for (int e = gt; e < R * 32; e += NGT) {
        const int r = e >> 5, c0 = (e & 31) * 8; bool vp, vn; nbr_valid(r, vp, vn);
        bf16* row = P + (size_t)r * NP;
        const u32x4 zc = {0, 0, 0, 0};
        const u32x4 ac0 = *(const u32x4*)(row + C_AC + c0), ax0 = *(const u32x4*)(row + C_AX + c0), ab = *(const u32x4*)(row + C_AB + c0);
        const u32x4 acp = vp ? *(const u32x4*)(row - NP + C_AC + c0) : zc, axp = vp ? *(const u32x4*)(row - NP + C_AX + c0) : zc;
        const u32x4 acn = vn ? *(const u32x4*)(row + NP + C_AC + c0) : zc, axn = vn ? *(const u32x4*)(row + NP + C_AX + c0) : zc;
        u32x4 o;
#pragma unroll
        for (int q = 0; q < 4; ++q) { float y[2];
#pragma unroll
            for (int hh = 0; hh < 2; ++hh) { const int c = c0 + 2 * q + hh;
                const float up = hh ? bfhi(acp[q]) * bfhi(axp[q]) : bflo(acp[q]) * bflo(axp[q]);
                const float u0 = hh ? bfhi(ac0[q]) * bfhi(ax0[q]) : bflo(ac0[q]) * bflo(ax0[q]);
                const float un = hh ? bfhi(acn[q]) * bfhi(axn[q]) : bflo(acn[q]) * bflo(axn[q]);
                const float b_ = hh ? bfhi(ab[q]) : bflo(ab[q]);
                y[hh] = b_ * (cb[c] + cw[c] * up + cw[256 + c] * u0 + cw[512 + c] * un); }
            o[q] = pk2(y[0], y[1]); }
        *(u32x4*)(row + C_AB + c0) = o;
    }
}
__device__ __forceinline__ void conv_xbc_pass(Fr& F, int l) { KA_DECL;
    const int gt = F.bid * 512 + F.tid, NGT = F.G * 512;
    bf16* P = WSP(bf16, BG_PROJ);
    const float* cw = KA->in[I_SCW] + l * 3 * 512; const float* cb = KA->in[I_SCB] + l * 512;
    for (int e = gt; e < R * 64; e += NGT) {
        const int r = e >> 6, c0 = (e & 63) * 8; bool vp, vn; nbr_valid(r, vp, vn);
        bf16* row = P + (size_t)r * NP;
        const u32x4 zc = {0, 0, 0, 0};
        const u32x4 x0 = *(const u32x4*)(row + C_XBC + c0);
        const u32x4 xp = vp ? *(const u32x4*)(row - NP + C_XBC + c0) : zc, xn = vn ? *(const u32x4*)(row + NP + C_XBC + c0) : zc;
        u32x4 o;
#pragma unroll
        for (int q = 0; q < 4; ++q) { float y[2];
#pragma unroll
            for (int hh = 0; hh < 2; ++hh) { const int c = c0 + 2 * q + hh;
                const float a = hh ? bfhi(xp[q]) : bflo(xp[q]), b_ = hh ? bfhi(x0[q]) : bflo(x0[q]), n_ = hh ? bfhi(xn[q]) : bflo(xn[q]);
                y[hh] = siluf_(cb[c] + cw[c] * a + cw[512 + c] * b_ + cw[1024 + c] * n_); }
            o[q] = pk2(y[0], y[1]); }
        *(u32x4*)(row + (c0 < 256 ? C_XS + c0 : C_BC + (c0 - 256))) = o;
    }
    for (int e = gt; e < R * 8; e += NGT) { float* p = WSP(float, SM_DT) + e; const float x = *p + KA->in[I_DTB][l * 8 + (e & 7)]; *p = x > 15.f ? x : __logf(1.0f + __expf(x)); }
}

template <class Fn>
__device__ __forceinline__ void dyn_tickets(Fr& F, unsigned* cnt, int nt, Fn fn) {
    volatile LAS int* tk = (volatile LAS int*)(F.lds + MISC_OFF + 512);
    int t_ = F.tid; asm volatile("" : "+v"(t_));
    if (t_ == 0) tk[0] = (int)__hip_atomic_fetch_add(cnt, 1u, __ATOMIC_RELAXED, __HIP_MEMORY_SCOPE_AGENT);
    __syncthreads();
    int c = __builtin_amdgcn_readfirstlane(tk[0]), it = 0;
    while (c < nt) {
        unsigned nxt = 0u; if (t_ == 0) nxt = __hip_atomic_fetch_add(cnt, 1u, __ATOMIC_RELAXED, __HIP_MEMORY_SCOPE_AGENT);
        fn(c);
        ++it; if (t_ == 0) tk[it & 1] = (int)nxt;
        __syncthreads();
        c = __builtin_amdgcn_readfirstlane(tk[it & 1]);
    }
}
__device__ __forceinline__ void moe_convert_tickets(Fr& F, int l, int w2) { KA_DECL;
    unsigned* wq = WSP(unsigned, WS_CTL) + CW_WQ + (8 + l * 2 + w2) * 64;
    __syncthreads();
    dyn_tickets(F, wq, w2 ? 512 : 1024, [&](int c) { moe_convert_item(F, l, (w2 ? 8192 : 0) + 8 * c + F.wave); });
}
__device__ __forceinline__ void conv_a_chunk(Fr& F, int l, int c) { KA_DECL;
    int t_ = F.tid; asm volatile("" : "+v"(t_));
    const int r0 = 64 * c + 4 * (t_ >> 5), c0 = (t_ & 31) * 8, s0 = r0 % RPB;
    const bool vp = (s0 != 0) && (s0 != CTXL), vn = (s0 + 4 != CTXL) && (s0 + 4 != RPB);
    GAS bf16* row = (GAS bf16*)(WSP(bf16, BG_PROJ) + (size_t)r0 * NP + c0);
    const float* cw = KA->in[I_CAW] + l * 3 * 256 + c0; const float* cb = KA->in[I_CAB] + l * 256 + c0;
    const u32x4 zc = {0, 0, 0, 0};
    u32x4 ac[6], ax[6], ab[4];
    ac[0] = vp ? *(const GAS u32x4*)(row - NP + C_AC) : zc; ax[0] = vp ? *(const GAS u32x4*)(row - NP + C_AX) : zc;
#pragma unroll
    for (int i = 0; i < 4; ++i) { ac[i + 1] = *(const GAS u32x4*)(row + (size_t)i * NP + C_AC); ax[i + 1] = *(const GAS u32x4*)(row + (size_t)i * NP + C_AX); ab[i] = *(const GAS u32x4*)(row + (size_t)i * NP + C_AB); }
    ac[5] = vn ? *(const GAS u32x4*)(row + (size_t)4 * NP + C_AC) : zc; ax[5] = vn ? *(const GAS u32x4*)(row + (size_t)4 * NP + C_AX) : zc;
    float wb[8], w0[8], w1[8], w2[8];
#pragma unroll
    for (int j = 0; j < 8; j += 4) { const f32x4 a = *(const f32x4*)(cb + j), b = *(const f32x4*)(cw + j), d = *(const f32x4*)(cw + 256 + j), e = *(const f32x4*)(cw + 512 + j);
#pragma unroll
        for (int i = 0; i < 4; ++i) { wb[j + i] = a[i]; w0[j + i] = b[i]; w1[j + i] = d[i]; w2[j + i] = e[i]; } }
    float u[6][8];
#pragma unroll
    for (int i = 0; i < 6; ++i)
#pragma unroll
        for (int q = 0; q < 4; ++q) { u[i][2 * q] = bflo(ac[i][q]) * bflo(ax[i][q]); u[i][2 * q + 1] = bfhi(ac[i][q]) * bfhi(ax[i][q]); }
#pragma unroll
    for (int i = 0; i < 4; ++i) { u32x4 o;
#pragma unroll
        for (int q = 0; q < 4; ++q) { const int j = 2 * q;
            const float y0 = bflo(ab[i][q]) * (wb[j] + w0[j] * u[i][j] + w1[j] * u[i + 1][j] + w2[j] * u[i + 2][j]);
            const float y1 = bfhi(ab[i][q]) * (wb[j + 1] + w0[j + 1] * u[i][j + 1] + w1[j + 1] * u[i + 1][j + 1] + w2[j + 1] * u[i + 2][j + 1]);
            o[q] = pk2(y0, y1); }
        *(GAS u32x4*)(row + (size_t)i * NP + C_AB) = o; }
}
__device__ __forceinline__ void conv_xbc_chunk(Fr& F, int l, int c) { KA_DECL;
    int t_ = F.tid; asm volatile("" : "+v"(t_));
    const int r0 = 64 * c + 8 * (t_ >> 6), c0 = (t_ & 63) * 8, s0 = r0 % RPB;
    const bool vp = (s0 != 0) && (s0 != CTXL), vn = (s0 + 8 != CTXL) && (s0 + 8 != RPB);
    GAS bf16* row = (GAS bf16*)(WSP(bf16, BG_PROJ) + (size_t)r0 * NP);
    const float* cw = KA->in[I_SCW] + l * 3 * 512 + c0; const float* cb = KA->in[I_SCB] + l * 512 + c0;
    const u32x4 zc = {0, 0, 0, 0};
    u32x4 x[10];
    x[0] = vp ? *(const GAS u32x4*)(row - NP + C_XBC + c0) : zc;
#pragma unroll
    for (int i = 0; i < 8; ++i) x[i + 1] = *(const GAS u32x4*)(row + (size_t)i * NP + C_XBC + c0);
    x[9] = vn ? *(const GAS u32x4*)(row + (size_t)8 * NP + C_XBC + c0) : zc;
    {   float* p = WSP(float, SM_DT) + (size_t)c * 512 + t_; const float xx = *p + KA->in[I_DTB][l * 8 + (t_ & 7)]; *p = xx > 15.f ? xx : __logf(1.0f + __expf(xx)); }
    float wb[8], w0[8], w1[8], w2[8];
#pragma unroll
    for (int j = 0; j < 8; j += 4) { const f32x4 a = *(const f32x4*)(cb + j), b = *(const f32x4*)(cw + j), d = *(const f32x4*)(cw + 512 + j), e = *(const f32x4*)(cw + 1024 + j);
#pragma unroll
        for (int i = 0; i < 4; ++i) { wb[j + i] = a[i]; w0[j + i] = b[i]; w1[j + i] = d[i]; w2[j + i] = e[i]; } }
    const int oc = c0 < 256 ? C_XS + c0 : C_BC + (c0 - 256);
#pragma unroll
    for (int i = 0; i < 8; ++i) { u32x4 o;
#pragma unroll
        for (int q = 0; q < 4; ++q) { const int j = 2 * q;
            const float y0 = siluf_(wb[j] + w0[j] * bflo(x[i][q]) + w1[j] * bflo(x[i + 1][q]) + w2[j] * bflo(x[i + 2][q]));
            const float y1 = siluf_(wb[j + 1] + w0[j + 1] * bfhi(x[i][q]) + w1[j + 1] * bfhi(x[i + 1][q]) + w2[j + 1] * bfhi(x[i + 2][q]));
            o[q] = pk2(y0, y1); }
        *(GAS u32x4*)(row + (size_t)i * NP + oc) = o; }
}

template <int MIX  , bool OUT>
__device__ __forceinline__ void span_task(Fr& F, int l, int span) { KA_DECL;
    const int b = span / SPB, sp = span - b * SPB, row0 = b * RPB + sp * 64;
    const int w = F.wave, h = w >> 1, dir = w & 1, lane = F.lane, g = h >> 1;
    bf16* P = WSP(bf16, BG_PROJ) + (size_t)row0 * NP;
    const float* DT = WSP(const float, SM_DT) + (size_t)row0 * 8 + dir * 4 + h;
    float* STp = WSP(float, BG_ST) + ((size_t)((b * 8 + w) * SPB + sp)) * 4096 + lane;
    LAS float* E = (LAS float*)F.lds;
    LAS float* SSQ = (LAS float*)(F.lds + 65536);
    float S[64];
    if (OUT) {
#pragma unroll
        for (int k = 0; k < 64; ++k) S[k] = STp[k * 64];
    } else {
#pragma unroll
        for (int k = 0; k < 64; ++k) S[k] = 0.f;
    }
    float lb = 0.f, dtb = 0.f, Aexp = 0.f, Dh = 0.f;
    if (MIX == 0) { if (l > 0) { const float a0 = KA->in[I_HLB][(dir * DEPTH + 0) * 256 + h * 64 + lane], a1 = KA->in[I_HLB][(dir * DEPTH + l) * 256 + h * 64 + lane]; lb = 1.0f / (1.0f + __expf(a0 - a1)); } }
    else { dtb = KA->in[I_DTB][(l * 2 + dir) * 4 + h]; Aexp = __expf(KA->in[I_ALOG][(l * 2 + dir) * 4 + h]); Dh = KA->in[I_SD][l * 4 + h]; }
    const float oml = 1.0f - lb;
    float dec = 1.0f;
    const int c1 = MIX == 0 ? C_FF + dir * 256 + h * 64 + lane : C_XS + h * 64 + lane;
    const int c2 = MIX == 0 ? C_I + h * 64 + lane : C_BC + g * 64 + lane;
    const int c3 = MIX == 0 ? C_Q + h * 64 + lane : C_BC + 128 + g * 64 + lane;
    const int c4 = C_Z + h * 64 + lane;
    constexpr int BS = (MIX == 1 && OUT) ? 4 : 8;
    unsigned short n1[BS], n2[BS], n3[BS], n4[BS]; float ndt[BS];
    unsigned short r1[BS], r2[BS], r3[BS], r4[BS]; float rdt[BS];
#pragma unroll
    for (int s_ = 0; s_ < BS; ++s_) { n1[s_] = 0; n2[s_] = 0; n3[s_] = 0; n4[s_] = 0; ndt[s_] = 0.f; }
    const int tstep = dir ? -1 : 1, t0 = dir ? 63 : 0;
#define SP_LOAD(blk) do { const bf16* rb_ = P + (long)(t0 + (blk) * BS * tstep) * NP; const float* db_ = DT + (long)(t0 + (blk) * BS * tstep) * 8; asm volatile("" : "+v"(rb_), "+v"(db_)); \
        _Pragma("unroll") for (int s_ = 0; s_ < BS; ++s_) { const bf16* rp_ = rb_ + (long)(s_ * tstep) * NP; \
        n1[s_] = rp_[c1]; n2[s_] = rp_[c2]; if (OUT || MIX == 1) n3[s_] = rp_[c3]; if (MIX == 1) { ndt[s_] = db_[(long)(s_ * tstep) * 8]; if (OUT) n4[s_] = rp_[c4]; } } } while (0)
    SP_LOAD(0);
    for (int blk = 0; blk < 64 / BS; ++blk) {
#pragma unroll
        for (int s_ = 0; s_ < BS; ++s_) { r1[s_] = n1[s_]; r2[s_] = n2[s_]; r3[s_] = n3[s_]; r4[s_] = n4[s_]; rdt[s_] = ndt[s_]; }
        if (blk < 64 / BS - 1) SP_LOAD(blk + 1);
        if (OUT && blk == 32 / BS) __syncthreads();
#pragma unroll
        for (int s = 0; s < BS; ++s) {
            const int i = blk * BS + s; const int tt = dir ? 63 - i : i;
            float o = 0.f, xv = 0.f;
            if (MIX == 0) {
                const float fr_ = bf2f(r1[s]), vv = bf2f(r2[s]);
                const float sg = sigmoidf_(fr_), fg = lb + oml * sg;
                float qq = 0.f; if (OUT) { const float qr = bf2f(r3[s]); qq = siluf_(qr); }
                dec *= fg;
                int fgi = __builtin_bit_cast(int, fg), qqi = __builtin_bit_cast(int, qq);
#pragma unroll
                for (int k = 0; k < 64; ++k) { const float f_ = __builtin_bit_cast(float, __builtin_amdgcn_readlane(fgi, k));
                    S[k] = vv + f_ * (S[k] - vv);
                    if (OUT) { const float q_ = __builtin_bit_cast(float, __builtin_amdgcn_readlane(qqi, k)); o += q_ * S[k]; }
                    if ((k & 7) == 7) asm volatile("" : "+v"(fgi), "+v"(qqi), "+v"(S[k - 7]), "+v"(S[k - 6]), "+v"(S[k - 5]), "+v"(S[k - 4]), "+v"(S[k - 3]), "+v"(S[k - 2]), "+v"(S[k - 1]), "+v"(S[k])); }
            } else {
                xv = bf2f(r1[s]); const float Bv = bf2f(r2[s]), Cv = bf2f(r3[s]);
                const float dt = softplusf_(rdt[s] + dtb), a = __expf(-dt * Aexp), bdt = Bv * dt;
                dec *= a;
                int bdi = __builtin_bit_cast(int, bdt), cvi = __builtin_bit_cast(int, Cv);
#pragma unroll
                for (int k = 0; k < 64; ++k) { const float b_ = __builtin_bit_cast(float, __builtin_amdgcn_readlane(bdi, k));
                    S[k] = a * S[k] + b_ * xv;
                    if (OUT) { const float c_ = __builtin_bit_cast(float, __builtin_amdgcn_readlane(cvi, k)); o += c_ * S[k]; }
                    if ((k & 7) == 7) asm volatile("" : "+v"(bdi), "+v"(cvi), "+v"(S[k - 7]), "+v"(S[k - 6]), "+v"(S[k - 5]), "+v"(S[k - 4]), "+v"(S[k - 3]), "+v"(S[k - 2]), "+v"(S[k - 1]), "+v"(S[k])); }
            }
            if (OUT) {
                if (i < 32) E[(w * 32 + i) * 64 + lane] = o;
                else { LAS float* slot = E + ((w ^ 1) * 32 + (63 - i)) * 64 + lane;
                    float tot = o + *slot;
                    if (MIX == 1) { const float z = bf2f(r4[s]); tot = (tot + Dh * xv) * siluf_(z); }
                    const float q2 = wave_sum(tot * tot);
                    if (lane == 0) SSQ[h * 64 + tt] = q2;
                    *slot = tot; }
            }
        }
    }
#undef SP_LOAD
    if (!OUT) {
#pragma unroll
        for (int k = 0; k < 64; ++k) STp[k * 64] = S[k];
        WSP(float, SM_DEC)[((size_t)((b * 8 + w) * SPB + sp)) * 64 + lane] = dec;
    } else {
        __syncthreads();
        const float* nwp = MIX == 0 ? KA->in[I_HNW] + l * 64 : KA->in[I_SNW] + l * 256;
        const float nwc = MIX == 0 ? nwp[F.tid & 63] : nwp[F.tid & 255];
#pragma unroll 4
        for (int it = 0; it < 32; ++it) { const int e = it * 512 + F.tid, tt = e >> 8, ch = e & 255, hh = ch >> 6, dv = ch & 63;
            const float v = tt < 32 ? E[((2 * hh) * 32 + tt) * 64 + dv] : E[((2 * hh + 1) * 32 + (63 - tt)) * 64 + dv];
            float y;
            if (MIX == 0) { const float rs = 1.0f / sqrtf(SSQ[hh * 64 + tt] * (1.f / 64.f) + EPS); const float gr = bf2f(P[(size_t)tt * NP + C_G + ch]); y = v * rs * nwc * siluf_(gr); }
            else { const int g2 = hh >> 1; const float rs = 1.0f / sqrtf((SSQ[(2 * g2) * 64 + tt] + SSQ[(2 * g2 + 1) * 64 + tt]) * (1.f / 128.f) + EPS); y = v * rs * nwc; }
            P[(size_t)tt * NP + (MIX == 0 ? C_Q : C_Z) + ch] = (bf16)f2bf(y); }
        __syncthreads();
    }
}
__device__ __forceinline__ bf16x8 pack8(float a0, float a1, float a2, float a3, float a4, float a5, float a6, float a7) {
    u32x4 w; w.x = pk2(a0, a1); w.y = pk2(a2, a3); w.z = pk2(a4, a5); w.w = pk2(a6, a7); return __builtin_bit_cast(bf16x8, w); }
template <int MIX  , bool OUT>
__device__ __forceinline__ void span_task_mfma(Fr& F, int l, int span) { KA_DECL;
    const int b = span / SPB, sp = span - b * SPB, row0 = b * RPB + sp * 64;
    const int w = F.wave, h = w >> 1, dir = w & 1, lane = F.lane, g = h >> 1, gq = lane >> 4, li = lane & 15;
    bf16* P = WSP(bf16, BG_PROJ) + (size_t)row0 * NP;
    const float* DT = WSP(const float, SM_DT) + (size_t)row0 * 8 + dir * 4 + h;
    bf16* STb = WSP(bf16, MIX ? BG_ST2 : BG_ST) + ((size_t)((b * 8 + w) * SPB + sp)) * 4096;
    LAS float* E = (LAS float*)F.lds;
    LAS float* SSQ = (LAS float*)(F.lds + 65536);
    LAS unsigned char* WL = F.lds + 66560 + w * 8960;
    LAS bf16* QT = (LAS bf16*)WL; LAS bf16* KT = (LAS bf16*)(WL + 2304); LAS bf16* KH = (LAS bf16*)(WL + 4608); LAS bf16* VT = (LAS bf16*)(WL + 6656); LAS float* DV = (LAS float*)(WL + 8704);
    f32x4 S[4][4];
#pragma unroll
    for (int kb = 0; kb < 4; ++kb)
#pragma unroll
        for (int m = 0; m < 4; ++m)
#pragma unroll
            for (int r = 0; r < 4; ++r) S[kb][m][r] = 0.f;
    if (OUT) {
#pragma unroll
        for (int kb = 0; kb < 4; ++kb)
#pragma unroll
            for (int m = 0; m < 4; ++m) { const u32x2 s2 = *(const u32x2*)(STb + ((kb * 4 + m) * 64 + lane) * 4); S[kb][m] = (f32x4){bflo(s2.x), bfhi(s2.x), bflo(s2.y), bfhi(s2.y)}; } }
    float lb = 0.f, dtb = 0.f, Aexp = 0.f, Dh = 0.f;
    if (MIX == 0) { if (l > 0) { const float a0 = KA->in[I_HLB][(dir * DEPTH + 0) * 256 + h * 64 + lane], a1 = KA->in[I_HLB][(dir * DEPTH + l) * 256 + h * 64 + lane]; lb = 1.0f / (1.0f + __expf(a0 - a1)); } }
    else { dtb = KA->in[I_DTB][(l * 2 + dir) * 4 + h]; Aexp = __expf(KA->in[I_ALOG][(l * 2 + dir) * 4 + h]); Dh = KA->in[I_SD][l * 4 + h]; }
    const float oml = 1.0f - lb;
    float dtot = 1.0f;
    const int c1 = MIX == 0 ? C_FF + dir * 256 + h * 64 + lane : C_XS + h * 64 + lane;
    const int c2 = MIX == 0 ? C_I + h * 64 + lane : C_BC + g * 64 + lane;
    const int c3 = MIX == 0 ? C_Q + h * 64 + lane : C_BC + 128 + g * 64 + lane;
    const int tstep = dir ? -1 : 1, t0 = dir ? 63 : 0;
    unsigned short n1[16], n2[16], n3[16]; float ndt[16];
#pragma unroll
    for (int i = 0; i < 16; ++i) { n1[i] = 0; n2[i] = 0; n3[i] = 0; ndt[i] = 0.f; }
#define SM_LOAD(c) do { unsigned long long rbi_ = (unsigned long long)(P + (long)(t0 + (c) * 16 * tstep) * NP), dbi_ = (unsigned long long)(DT + (long)(t0 + (c) * 16 * tstep) * 8); asm volatile("" : "+v"(rbi_), "+v"(dbi_)); \
        const GAS bf16* rb_ = (const GAS bf16*)rbi_; const GAS float* db_ = (const GAS float*)dbi_;     \
        _Pragma("unroll") for (int i_ = 0; i_ < 16; ++i_) { const GAS bf16* rp_ = rb_ + (long)(i_ * tstep) * NP; n1[i_] = rp_[c1]; n2[i_] = rp_[c2]; if (OUT || MIX == 1) n3[i_] = rp_[c3]; if (MIX == 1) ndt[i_] = db_[(long)(i_ * tstep) * 8]; } } while (0)
    constexpr bool PF = !(MIX == 1 && OUT);
    if (PF) SM_LOAD(0);
    for (int c = 0; c < 4; ++c) {
        if (!PF) SM_LOAD(c);
#define r1 n1
#define r2 n2
#define r3 n3
#define rdt ndt
        if (OUT && c == 2) __syncthreads();
        float cl = 0.f, clv[16], kkv[16];
#pragma unroll
        for (int i = 0; i < 16; ++i) { float lf, kk, qq = 0.f;
            if (MIX == 0) { const float fr_ = bf2f(r1[i]); const float sg = sigmoidf_(fr_), fg = lb + oml * sg; lf = __logf(fg); kk = 1.0f - fg; if (OUT) qq = siluf_(bf2f(r3[i])); }
            else { const float dt = rdt[i]; lf = -dt * Aexp; kk = bf2f(r2[i]) * dt; qq = bf2f(r3[i]); }
            cl += lf; clv[i] = cl; kkv[i] = kk;
            if (OUT) { QT[i * 72 + lane] = (bf16)f2bf(qq * __expf(cl)); KT[i * 72 + lane] = (bf16)f2bf(kk * __expf(fminf(-cl, 60.f))); } }
        {   float kh[16];
#pragma unroll
            for (int i = 0; i < 16; ++i) kh[i] = kkv[i] * __expf(cl - clv[i]);
            *(LAS bf16x8*)(KH + lane * 16) = pack8(kh[0], kh[1], kh[2], kh[3], kh[4], kh[5], kh[6], kh[7]); *(LAS bf16x8*)(KH + lane * 16 + 8) = pack8(kh[8], kh[9], kh[10], kh[11], kh[12], kh[13], kh[14], kh[15]);
            u32x4 v0, v1;
#define VR(i) ((unsigned)(MIX == 0 ? r2[i] : r1[i]))
            v0.x = VR(0) | (VR(1) << 16); v0.y = VR(2) | (VR(3) << 16); v0.z = VR(4) | (VR(5) << 16); v0.w = VR(6) | (VR(7) << 16);
            v1.x = VR(8) | (VR(9) << 16); v1.y = VR(10) | (VR(11) << 16); v1.z = VR(12) | (VR(13) << 16); v1.w = VR(14) | (VR(15) << 16);
#undef VR
            *(LAS u32x4*)(VT + lane * 16) = v0; *(LAS u32x4*)(VT + lane * 16 + 8) = v1;
            const float Dd = __expf(cl); DV[lane] = Dd; dtot *= Dd; }
#undef r1
#undef r2
#undef r3
#undef rdt
        if (PF && c < 3) SM_LOAD(c + 1);
        LDS_WAIT(); asm volatile("" ::: "memory");
        if (OUT) {
            const int tau = 16 * c + li, tt = dir ? 63 - tau : tau;
            u32x2 fx[4], fz[4];
#pragma unroll
            for (int m = 0; m < 4; ++m) { fx[m] = (u32x2){0u, 0u}; fz[m] = (u32x2){0u, 0u}; }
            if (c >= 2) { const GAS bf16* Pg = (const GAS bf16*)P + (size_t)tt * NP + h * 64 + 4 * gq;
#pragma unroll
                for (int m = 0; m < 4; ++m) { if (MIX == 1) { fx[m] = *(const GAS u32x2*)(Pg + C_XS + 16 * m); fz[m] = *(const GAS u32x2*)(Pg + C_Z + 16 * m); } else fx[m] = *(const GAS u32x2*)(Pg + C_G + 16 * m); } }
            f32x4 Pm = {0.f, 0.f, 0.f, 0.f};
#pragma unroll
            for (int ks = 0; ks < 2; ++ks) Pm = __builtin_amdgcn_mfma_f32_16x16x32_bf16(*(const LAS bf16x8*)(KT + li * 72 + 32 * ks + 8 * gq), *(const LAS bf16x8*)(QT + li * 72 + 32 * ks + 8 * gq), Pm, 0, 0, 0);
#pragma unroll
            for (int r = 0; r < 4; ++r) if (4 * gq + r > li) Pm[r] = 0.f;
            const bf16x8 pb = pack8(Pm[0], Pm[1], Pm[2], Pm[3], 0.f, 0.f, 0.f, 0.f);
            f32x4 oT[4];
#pragma unroll
            for (int m = 0; m < 4; ++m) { const u32x2 vv = *(const LAS u32x2*)(VT + (16 * m + li) * 16 + 4 * gq); const u32x4 av = {vv.x, vv.y, 0u, 0u};
                oT[m] = __builtin_amdgcn_mfma_f32_16x16x32_bf16(__builtin_bit_cast(bf16x8, av), pb, (f32x4){0.f, 0.f, 0.f, 0.f}, 0, 0, 0); }
#pragma unroll
            for (int ks = 0; ks < 2; ++ks) { const u32x2 q0 = *(const LAS u32x2*)(QT + li * 72 + 32 * ks + 4 * gq), q1 = *(const LAS u32x2*)(QT + li * 72 + 32 * ks + 16 + 4 * gq); const u32x4 bq = {q0.x, q0.y, q1.x, q1.y};
#pragma unroll
                for (int m = 0; m < 4; ++m) { const f32x4 s0 = S[2 * ks][m], s1 = S[2 * ks + 1][m];
                    oT[m] = __builtin_amdgcn_mfma_f32_16x16x32_bf16(pack8(s0[0], s0[1], s0[2], s0[3], s1[0], s1[1], s1[2], s1[3]), __builtin_bit_cast(bf16x8, bq), oT[m], 0, 0, 0); } }
            if (c < 2) {
#pragma unroll
                for (int m = 0; m < 4; ++m) *(LAS f32x4*)(E + (w * 32 + tau) * 64 + 4 * (((4 * m + gq) ^ tau) & 15)) = oT[m];
            } else { float q2 = 0.f;
#pragma unroll
                for (int m = 0; m < 4; ++m) { LAS f32x4* slot = (LAS f32x4*)(E + ((w ^ 1) * 32 + (63 - tau)) * 64 + 4 * (((4 * m + gq) ^ (63 - tau)) & 15));
                    f32x4 tot = oT[m] + *slot;
                    if (MIX == 1) { const u32x2 xx = fx[m], zz = fz[m];
                        const f32x4 xv = {bflo(xx.x), bfhi(xx.x), bflo(xx.y), bfhi(xx.y)}; const f32x4 zv = {bflo(zz.x), bfhi(zz.x), bflo(zz.y), bfhi(zz.y)};
                        tot = tot + xv * Dh; tot.x *= siluf_(zv.x); tot.y *= siluf_(zv.y); tot.z *= siluf_(zv.z); tot.w *= siluf_(zv.w); }
                    q2 += (tot.x * tot.x + tot.y * tot.y) + (tot.z * tot.z + tot.w * tot.w);
                    *slot = tot; }
                q2 += __shfl_xor(q2, 16); q2 += __shfl_xor(q2, 32);
                if (MIX == 1) { if (gq == 0) SSQ[h * 64 + tt] = q2; }
                else {
                    const float rs = 1.0f / sqrtf(q2 * (1.f / 64.f) + EPS); const float* nwp = KA->in[I_HNW] + l * 64;
#pragma unroll
                    for (int m = 0; m < 4; ++m) { LAS f32x4* slot = (LAS f32x4*)(E + ((w ^ 1) * 32 + (63 - tau)) * 64 + 4 * (((4 * m + gq) ^ (63 - tau)) & 15));
                        const f32x4 tot = *slot; const u32x2 gg = fx[m]; const f32x4 nw4 = *(const f32x4*)(nwp + 16 * m + 4 * gq);
                        const f32x4 gv = {bflo(gg.x), bfhi(gg.x), bflo(gg.y), bfhi(gg.y)};
                        u32x2 o; o.x = pk2(tot.x * rs * nw4.x * siluf_(gv.x), tot.y * rs * nw4.y * siluf_(gv.y)); o.y = pk2(tot.z * rs * nw4.z * siluf_(gv.z), tot.w * rs * nw4.w * siluf_(gv.w));
                        *(u32x2*)(P + (size_t)tt * NP + C_Q + h * 64 + 16 * m + 4 * gq) = o; } } }
        }
        if (!OUT || c < 3) {
#pragma unroll
            for (int kb = 0; kb < 4; ++kb) { const f32x4 dd = *(const LAS f32x4*)(DV + 16 * kb + 4 * gq);
                const u32x4 z4 = {0u, 0u, 0u, 0u};
                const bf16x8 ak = gq < 2 ? *(const LAS bf16x8*)(KH + (16 * kb + li) * 16 + 8 * gq) : __builtin_bit_cast(bf16x8, z4);
#pragma unroll
                for (int m = 0; m < 4; ++m) { const bf16x8 bv = gq < 2 ? *(const LAS bf16x8*)(VT + (16 * m + li) * 16 + 8 * gq) : __builtin_bit_cast(bf16x8, z4);
                    S[kb][m] = __builtin_amdgcn_mfma_f32_16x16x32_bf16(ak, bv, S[kb][m] * dd, 0, 0, 0); } }
        }
        LDS_WAIT(); asm volatile("" ::: "memory");
    }
#undef SM_LOAD
    if (!OUT) {
#pragma unroll
        for (int kb = 0; kb < 4; ++kb)
#pragma unroll
            for (int m = 0; m < 4; ++m) { u32x2 s2; s2.x = pk2(S[kb][m][0], S[kb][m][1]); s2.y = pk2(S[kb][m][2], S[kb][m][3]); *(u32x2*)(STb + ((kb * 4 + m) * 64 + lane) * 4) = s2; }
        WSP(float, SM_DEC)[((size_t)((b * 8 + w) * SPB + sp)) * 64 + lane] = dtot;
    } else if (MIX == 0) { __syncthreads(); }
    else {
        __syncthreads();
        const float* nwp = MIX == 0 ? KA->in[I_HNW] + l * 64 : KA->in[I_SNW] + l * 256;
#pragma unroll 4
        for (int it = 0; it < 32; ++it) { const int e = it * 512 + F.tid, tt = e >> 8, ch = e & 255, hh = ch >> 6, dv = ch & 63;
            const int sl = tt < 32 ? tt : 63 - tt; const float v = E[((2 * hh + (tt < 32 ? 0 : 1)) * 32 + sl) * 64 + 4 * (((dv >> 2) ^ sl) & 15) + (dv & 3)];
            float y;
            if (MIX == 0) { const float rs = 1.0f / sqrtf(SSQ[hh * 64 + tt] * (1.f / 64.f) + EPS); const float gr = bf2f(P[(size_t)tt * NP + C_G + ch]); y = v * rs * nwp[dv] * siluf_(gr); }
            else { const int g2 = hh >> 1; const float rs = 1.0f / sqrtf((SSQ[(2 * g2) * 64 + tt] + SSQ[(2 * g2 + 1) * 64 + tt]) * (1.f / 128.f) + EPS); y = v * rs * nwp[ch]; }
            P[(size_t)tt * NP + (MIX == 0 ? C_Q : C_Z) + ch] = (bf16)f2bf(y); }
        __syncthreads();
    }
}
constexpr int SCH = 22;
static_assert(SPB % SCH == 0, "scan rounds");
__device__ __forceinline__ void state_scan(Fr& F, int mix) { KA_DECL;
    if (F.tid < 256)
    for (int e = F.bid * 256 + F.tid; e < NB * 8 * 2048; e += F.G * 256) {
    const int bh = e >> 11, ip = e & 2047, idx = 2 * ip, dk = 16 * (idx >> 10) + 4 * ((idx >> 6) & 3) + (idx & 3), dir = bh & 1;
    unsigned* ST = (unsigned*)(KA->ws + (mix ? BG_ST2 : BG_ST)) + (size_t)bh * SPB * 2048 + ip; const float* DC = WSP(const float, SM_DEC) + (size_t)bh * SPB * 64 + dk;
    float st0 = 0.f, st1 = 0.f;
    const GAS unsigned* STg = (const GAS unsigned*)ST; const GAS float* DCg = (const GAS float*)DC;
    unsigned nl[SCH]; f32x2 nd[SCH];
#pragma unroll
    for (int j = 0; j < SCH; ++j) { const int sx = dir ? (j < 4 ? 3 - j : 135 - j) : j; nl[j] = STg[(size_t)sx * 2048]; nd[j] = *(const GAS f32x2*)(DCg + sx * 64); }
    for (int p0 = 0; p0 < SPB; p0 += SCH) {
        unsigned loc[SCH]; f32x2 d[SCH];
#pragma unroll
        for (int j = 0; j < SCH; ++j) { loc[j] = nl[j]; d[j] = nd[j]; }
        if (p0 + SCH < SPB) {
#pragma unroll
            for (int j = 0; j < SCH; ++j) { const int p = p0 + SCH + j, sx = dir ? (p < 4 ? 3 - p : 135 - p) : p; nl[j] = STg[(size_t)sx * 2048]; nd[j] = *(const GAS f32x2*)(DCg + sx * 64); } }
#pragma unroll
        for (int j = 0; j < SCH; ++j) { const int p = p0 + j, sx = dir ? (p < 4 ? 3 - p : 135 - p) : p; if (DBG_NOCTX && p == 4) { st0 = 0.f; st1 = 0.f; }
            ST[(size_t)sx * 2048] = pk2(st0, st1); st0 = d[j].x * st0 + bflo(loc[j]); st1 = d[j].y * st1 + bfhi(loc[j]); }
    }
    }
}

__device__ __forceinline__ void lds_load_f32(Fr& F, const float* src, int n) {
    __syncthreads();
    int t_ = F.tid; asm volatile("" : "+v"(t_));
    for (int e = t_ * 4; e < n; e += 2048) *(LAS f32x4*)((LAS float*)F.lds + e) = *(const f32x4*)(src + e);
    __syncthreads();
}
constexpr int FFT_MAT = 69632;
template <int K>
__device__ __forceinline__ void lds_load_mat(Fr& F, const bf16* src) {
    __syncthreads();
    int t_ = F.tid; asm volatile("" : "+v"(t_));
    for (int c = t_; c < 128 * (K / 8); c += 512) { const int row = c / (K / 8), cc = c % (K / 8);
        *(LAS u32x4*)(F.lds + FFT_MAT + row * (K * 2 + 16) + cc * 16) = *(const u32x4*)(src + (size_t)row * K + cc * 8); }
    __syncthreads();
}
template <int STRIDE>
__device__ __forceinline__ bf16x8 fft_bop(const LAS unsigned short* dp) {
    u32x4 q;
    q.x = (unsigned)dp[0] | ((unsigned)dp[STRIDE / 2] << 16); q.y = (unsigned)dp[2 * (STRIDE / 2)] | ((unsigned)dp[3 * (STRIDE / 2)] << 16);
    q.z = (unsigned)dp[4 * (STRIDE / 2)] | ((unsigned)dp[5 * (STRIDE / 2)] << 16); q.w = (unsigned)dp[6 * (STRIDE / 2)] | ((unsigned)dp[7 * (STRIDE / 2)] << 16);
    return __builtin_bit_cast(bf16x8, q);
}
__device__ __forceinline__ void fft_stage_a(Fr& F, int unit) { KA_DECL;
    int t_ = F.tid; asm volatile("" : "+v"(t_));
    const int b = unit >> 7, t2 = unit & 127, lane = t_ & 63, w = __builtin_amdgcn_readfirstlane(t_ >> 6), n = lane & 31, ch = 32 * w + n, kh = lane >> 5;
    {   const GAS bf16* U = (const GAS bf16*)(WSP(const bf16, BG_PROJ) + ((size_t)b * RPB + CTXL + t2) * NP + C_UR);
        u32x4 v[8];
#pragma unroll
        for (int q = 0; q < 8; ++q) { const int c = t_ + 512 * q, k = c >> 5, cc = c & 31; v[q] = *(const GAS u32x4*)(U + (size_t)(128 * (k & 63)) * NP + (k >> 6) * 256 + cc * 8); }
        __syncthreads();
#pragma unroll
        for (int q = 0; q < 8; ++q) { const int c = t_ + 512 * q, k = c >> 5, cc = c & 31; *(LAS u32x4*)(F.lds + k * 528 + cc * 16) = v[q]; }
        __syncthreads(); }
    f32x16 acc[4];
#pragma unroll
    for (int m = 0; m < 4; ++m)
#pragma unroll
        for (int q = 0; q < 16; ++q) acc[m][q] = 0.f;
    const LAS unsigned short* dp = (const LAS unsigned short*)(F.lds + (8 * kh) * 528 + ch * 2);
    const LAS char* mp = (const LAS char*)(F.lds + FFT_MAT + n * 272 + 16 * kh);
#pragma unroll 2
    for (int s = 0; s < 8; ++s) { const bf16x8 bq = fft_bop<528>(dp + s * (16 * 264));
#pragma unroll
        for (int m = 0; m < 4; ++m) acc[m] = __builtin_amdgcn_mfma_f32_32x32x16_bf16(*(const LAS bf16x8*)(mp + (32 * m) * 272 + 32 * s), bq, acc[m], 0, 0, 0); }
    bf16* AP = WSP(bf16, BG_AP) + (size_t)b * 64 * 2 * 128 * 256;
    const float* TW = WSP(const float, SM_TW) + (size_t)t2 * 128;
#pragma unroll
    for (int m = 0; m < 2; ++m)
#pragma unroll
        for (int q = 0; q < 16; ++q) { const int k1 = 32 * m + (q & 3) + 8 * (q >> 2) + 4 * kh; const float c = TW[2 * k1], s = TW[2 * k1 + 1];
            const float ar = acc[m][q], ai = acc[m + 2][q];
            bf16* dst = AP + ((size_t)(k1 * 2) * 128 + t2) * 256 + ch;
            dst[0] = (bf16)f2bf(ar * c + ai * s); dst[128 * 256] = (bf16)f2bf(ai * c - ar * s); }
}
__device__ __forceinline__ void fft_stage_b(Fr& F, int unit) { KA_DECL;
    int t_ = F.tid; asm volatile("" : "+v"(t_));
    const int chh = unit & 1, k1 = (unit >> 1) & 63, b = unit >> 7, lane = t_ & 63, w = __builtin_amdgcn_readfirstlane(t_ >> 6), n = lane & 31, kh = lane >> 5, cbk = w & 3, mh = w >> 2;
    {   const GAS bf16* AP = (const GAS bf16*)(WSP(const bf16, BG_AP) + ((size_t)(b * 64 + k1) * 2) * 128 * 256 + chh * 128);
        u32x4 v[8];
#pragma unroll
        for (int q = 0; q < 8; ++q) { const int c = t_ + 512 * q, k = c >> 4, cc = c & 15; v[q] = *(const GAS u32x4*)(AP + (size_t)k * 256 + cc * 8); }
        __syncthreads();
#pragma unroll
        for (int q = 0; q < 8; ++q) { const int c = t_ + 512 * q, k = c >> 4, cc = c & 15; *(LAS u32x4*)(F.lds + k * 272 + cc * 16) = v[q]; }
        __syncthreads(); }
    f32x16 acc[2];
#pragma unroll
    for (int m = 0; m < 2; ++m)
#pragma unroll
        for (int q = 0; q < 16; ++q) acc[m][q] = 0.f;
    const LAS unsigned short* dp = (const LAS unsigned short*)(F.lds + (8 * kh) * 272 + (32 * cbk + n) * 2);
    const LAS char* mp = (const LAS char*)(F.lds + FFT_MAT + (64 * mh + n) * 528 + 16 * kh);
#pragma unroll 2
    for (int s = 0; s < 16; ++s) { const bf16x8 bq = fft_bop<272>(dp + s * (16 * 136));
#pragma unroll
        for (int m = 0; m < 2; ++m) acc[m] = __builtin_amdgcn_mfma_f32_32x32x16_bf16(*(const LAS bf16x8*)(mp + (32 * m) * 528 + 32 * s), bq, acc[m], 0, 0, 0); }
    bf16* P = WSP(bf16, BG_PROJ) + ((size_t)b * RPB + CTXL + k1) * NP + C_UR + chh * 128 + 32 * cbk + n;
    const float scale = 0.001381067932f;
#pragma unroll
    for (int m = 0; m < 2; ++m)
#pragma unroll
        for (int q = 0; q < 16; ++q) { const int k2 = 64 * mh + 32 * m + (q & 3) + 8 * (q >> 2) + 4 * kh; P[(size_t)(64 * k2) * NP] = (bf16)f2bf(acc[m][q] * scale); }
}
__device__ __forceinline__ void fft_ctx(Fr& F, int unit) { KA_DECL;
    const int b = unit >> 2, mq = unit & 3, lane = F.lane, w = F.wave, ch = 32 * w + (lane & 31), kh = lane >> 5;
    const bf16* U = WSP(const bf16, BG_PROJ) + ((size_t)b * RPB) * NP + C_UR + ch;
    const float* M3 = WSP(const float, SM_M3) + 64 * mq + (lane & 31);
    f32x16 acc[2];
#pragma unroll
    for (int m = 0; m < 2; ++m)
#pragma unroll
        for (int q = 0; q < 16; ++q) acc[m][q] = 0.f;
#pragma unroll 4
    for (int k0 = 0; k0 < 512; k0 += 2) { const int k = k0 + kh, ri = k >> 8, t = k & 255;
        const float bv = bf2f(U[(size_t)t * NP + ri * 256]);
#pragma unroll
        for (int m = 0; m < 2; ++m) acc[m] = __builtin_amdgcn_mfma_f32_32x32x2f32(M3[k * 256 + 32 * m], bv, acc[m], 0, 0, 0); }
    bf16* CY = WSP(bf16, SM_CY) + (size_t)b * 256 * 256 + ch;
#pragma unroll
    for (int m = 0; m < 2; ++m)
#pragma unroll
        for (int q = 0; q < 16; ++q) { const int tp = 64 * mq + 32 * m + (q & 3) + 8 * (q >> 2) + 4 * kh; CY[(size_t)tp * 256] = (bf16)f2bf(acc[m][q] * (1.0f / 128.0f)); }
}
__device__ __forceinline__ void ctx_y_copy(Fr& F) { KA_DECL;
    const int gt = F.bid * 512 + F.tid, NGT = F.G * 512;
    for (int e = gt; e < NB * 256 * 32; e += NGT) { const int b = e >> 13, t = (e >> 5) & 255, c0 = (e & 31) * 8;
        *(u32x4*)(WSP(bf16, BG_PROJ) + ((size_t)b * RPB + t) * NP + C_UR + c0) = *(const u32x4*)(WSP(const bf16, SM_CY) + ((size_t)b * 256 + t) * 256 + c0); }
}

__device__ __forceinline__ f32x4 ld_agent_f4(const float* p) {
    const unsigned long long a = __hip_atomic_load((const unsigned long long*)p, __ATOMIC_RELAXED, __HIP_MEMORY_SCOPE_AGENT), b = __hip_atomic_load((const unsigned long long*)p + 1, __ATOMIC_RELAXED, __HIP_MEMORY_SCOPE_AGENT);
    const f32x2 lo = __builtin_bit_cast(f32x2, a), hi = __builtin_bit_cast(f32x2, b); return (f32x4){lo.x, lo.y, hi.x, hi.y}; }
__device__ __forceinline__ void ctx_tile_finish(Fr& F, int l) { KA_DECL;
    const int task = F.bid, t16 = task >> 2, b = t16 >> 2, pn = t16 & 3;
    volatile LAS int* fl = (volatile LAS int*)(F.lds + MISC_OFF + 520);
    int t_ = F.tid; asm volatile("" : "+v"(t_));
    asm volatile("s_waitcnt vmcnt(0)" ::: "memory"); __builtin_amdgcn_fence(__ATOMIC_RELEASE, "workgroup"); __syncthreads();
    if (t_ == 0) fl[0] = (int)__hip_atomic_fetch_add(WSP(unsigned, WS_CTL) + CW_WQ + (l * 4 + 3) * 64 + t16, 1u, __ATOMIC_RELAXED, __HIP_MEMORY_SCOPE_AGENT);
    __syncthreads();
    if (fl[0] != 3) return;
    for (int e0 = t_; e0 < 256 * 32; e0 += 4 * 512) {
        f32x4 v[4][8];
#pragma unroll
        for (int i = 0; i < 4; ++i) { const int e = e0 + 512 * i, r = e >> 5, c8 = e & 31;
            const GAS float* s = (const GAS float*)(WSP(const float, BG_MF) + (size_t)(b * 256 + r) * D + pn * 256 + c8 * 8);
#pragma unroll
            for (int k = 0; k < 4; ++k) { v[i][2 * k] = ld_agent_f4((const float*)s + (size_t)k * (NB * CTXL * D)); v[i][2 * k + 1] = ld_agent_f4((const float*)s + (size_t)k * (NB * CTXL * D) + 4); } }
#pragma unroll
        for (int i = 0; i < 4; ++i) { const int e = e0 + 512 * i, r = e >> 5, c8 = e & 31;
            const f32x4 a = (v[i][0] + v[i][2]) + (v[i][4] + v[i][6]), d = (v[i][1] + v[i][3]) + (v[i][5] + v[i][7]);
            u32x4 w; w.x = pk2(a.x, a.y); w.y = pk2(a.z, a.w); w.z = pk2(d.x, d.y); w.w = pk2(d.z, d.w);
            *(u32x4*)(WSP(bf16, BG_MERGED) + ((size_t)b * RPB + r) * D + pn * 256 + c8 * 8) = w; } }
}
struct SchedGrid {
    const char* A; const char* B; unsigned lda, ldb; int nt, nM, nN, G, c; bool skip_ctx;
    __device__ __forceinline__ bool next(int i, ge::Unit& u) const {
        int pm, pn; if (!ge::tile_order((long)i * G + c, nM, nN, pm, pn)) return false;
        if (skip_ctx) pm = (pm >> 5) * 33 + 1 + (pm & 31);
        u.A = A + (size_t)pm * 256 * lda; u.B = B + (size_t)pn * 256 * ldb; u.rows = nullptr; u.lda = lda; u.ldb = ldb; u.nt = nt; u.kind = 0; u.pm = pm; u.pn = pn; u.aux = 256; return true; }
};
struct EpiStore {
    static constexpr bool PERM = true, DRAIN = false;
    bf16* O; int ldc;
    __device__ __forceinline__ void operator()(const f32x4 (&acc)[2][2][4][2], const ge::Unit& u, int wr, int wc, int fr, int fq, int tid) const {
        const int row0 = u.pm * 256 + wr * 64 + fr, col0 = u.pn * 256 + wc * 32 + 8 * fq;
#pragma unroll
        for (int ai = 0; ai < 2; ++ai)
#pragma unroll
            for (int m = 0; m < 4; ++m) { bf16* rowp = O + (size_t)(row0 + ai * 128 + m * 16) * ldc + col0;
#pragma unroll
                for (int bj = 0; bj < 2; ++bj) { const f32x4 v0 = acc[ai][bj][m][0], v1 = acc[ai][bj][m][1]; u32x4 w;
                    w.x = ge::cvt_pk_bf16(v0[0], v0[1]); w.y = ge::cvt_pk_bf16(v0[2], v0[3]); w.z = ge::cvt_pk_bf16(v1[0], v1[1]); w.w = ge::cvt_pk_bf16(v1[2], v1[3]);
                    *(u32x4*)(rowp + bj * 128) = w; } }
    }
};
struct SchedD1 {
    const char* H; const char* P; const char* Wg; const char* Wb; int nM, G, c, nlat; bool skip_ctx;
    __device__ __forceinline__ bool next(int i, ge::Unit& u) const {
        int ti = i >> 3, sub = i & 7, k = sub >> 1; int pm, pn; bool ctxu = false;
        if (ge::tile_order((long)ti * G + c, nM, 4, pm, pn)) pm = (pm >> 5) * 33 + 1 + (pm & 31);
        else { const int j = i - 8 * nlat;
            if (skip_ctx || c >= 64 || j < 0 || j >= 2) return false;
            pm = (c >> 4) * 33; pn = (c >> 2) & 3; k = c & 3; sub = j; ctxu = true; }
        u.rows = nullptr; u.pm = pm; u.pn = pn; u.aux = 256;
        if (!(sub & 1)) { u.A = H + (size_t)pm * 256 * 2048; u.lda = 2048; u.B = Wg + ((size_t)k * 1024 + pn * 256) * 2048; u.ldb = 2048; u.nt = 16; u.kind = 0; }
        else { const int colk = k == 0 ? C_AB : (k == 1 ? C_Q : (k == 2 ? C_UR : C_Z));
            u.A = P + (size_t)pm * 256 * (NP * 2) + colk * 2; u.lda = NP * 2; u.B = Wb + ((size_t)k * 1024 + pn * 256) * 512; u.ldb = 512; u.nt = 4; u.kind = (ctxu ? 5 : 1) + k; }
        return true; }
};
#ifndef DBG_L
#define DBG_L 0
#endif
#ifndef MOE_SCALE
#define MOE_SCALE 2.0f
#endif
#ifndef DBG_D1
#define DBG_D1 0
#endif
#ifndef BRMASK
#define BRMASK 15
#endif
struct EpiD1 {
    static constexpr bool PERM = true, DRAIN = false;
    bf16* M; unsigned char* scr; unsigned char* mscr; float* MF;
    __device__ __forceinline__ void operator()(const f32x4 (&acc)[2][2][4][2], const ge::Unit& u, int wr, int wc, int fr, int fq, int tid) const {
        const int row0 = u.pm * 256 + wr * 64 + fr, col0 = u.pn * 256 + wc * 32 + 8 * fq;
        u32x4* sp0 = (u32x4*)(scr + (size_t)(tid >> 6) * 16384 + (size_t)(tid & 63) * 16);
        u32x4* mq0 = (u32x4*)(mscr + (size_t)(tid >> 6) * 16384 + (size_t)(tid & 63) * 16);
        if (u.kind == 0) {
#pragma unroll
            for (int ai = 0; ai < 2; ++ai)
#pragma unroll
                for (int m = 0; m < 4; ++m)
#pragma unroll
                    for (int bj = 0; bj < 2; ++bj) { const int piece = (ai * 4 + m) * 2 + bj; const f32x4 v0 = acc[ai][bj][m][0], v1 = acc[ai][bj][m][1]; u32x4 w;
                        w.x = ge::cvt_pk_bf16(sigmoidf_(v0[0]), sigmoidf_(v0[1])); w.y = ge::cvt_pk_bf16(sigmoidf_(v0[2]), sigmoidf_(v0[3]));
                        w.z = ge::cvt_pk_bf16(sigmoidf_(v1[0]), sigmoidf_(v1[1])); w.w = ge::cvt_pk_bf16(sigmoidf_(v1[2]), sigmoidf_(v1[3])); sp0[piece * 64] = w; }
        } else {
#pragma unroll
            for (int b = 0; b < 4; ++b) {
                u32x4 gb[4], pb[4];
#pragma unroll
                for (int i = 0; i < 4; ++i) { gb[i] = sp0[(4 * b + i) * 64]; pb[i] = mq0[(4 * b + i) * 64]; }
#pragma unroll
                for (int i = 0; i < 4; ++i) { const int piece = 4 * b + i, ai = piece >> 3, m = (piece >> 1) & 3, bj = piece & 1;
                    const f32x4 v0 = acc[ai][bj][m][0], v1 = acc[ai][bj][m][1]; const u32x4 g = gb[i], p = pb[i];
                    float o[8] = {bflo(g.x) * v0[0], bfhi(g.x) * v0[1], bflo(g.y) * v0[2], bfhi(g.y) * v0[3], bflo(g.z) * v1[0], bfhi(g.z) * v1[1], bflo(g.w) * v1[2], bfhi(g.w) * v1[3]};
                    if (u.kind >= 5) {
                        float* mf = MF + (size_t)(u.kind - 5) * (NB * CTXL * D) + (size_t)((u.pm / 33) * 256 + wr * 64 + fr + ai * 128 + m * 16) * D + col0 + bj * 128;
#pragma unroll
                        for (int j = 0; j < 4; ++j) { const f32x2 pr = {o[2 * j], o[2 * j + 1]};
                            __hip_atomic_store((unsigned long long*)mf + j, __builtin_bit_cast(unsigned long long, pr), __ATOMIC_RELAXED, __HIP_MEMORY_SCOPE_AGENT); } }
                    else {
                        if (u.kind > 1) { o[0] += bflo(p.x); o[1] += bfhi(p.x); o[2] += bflo(p.y); o[3] += bfhi(p.y); o[4] += bflo(p.z); o[5] += bfhi(p.z); o[6] += bflo(p.w); o[7] += bfhi(p.w); }
                        u32x4 w; w.x = ge::cvt_pk_bf16(o[0], o[1]); w.y = ge::cvt_pk_bf16(o[2], o[3]); w.z = ge::cvt_pk_bf16(o[4], o[5]); w.w = ge::cvt_pk_bf16(o[6], o[7]);
                        if (u.kind == 4) *(u32x4*)(M + (size_t)(row0 + ai * 128 + m * 16) * D + col0 + bj * 128) = w; else mq0[piece * 64] = w; } }
                asm volatile("" ::: "memory");
            }
        }
    }
};
struct EpiResid {
    static constexpr bool PERM = false, DRAIN = false;
    const float* in_x; const float* in_ctx; float* X; const float* mod; int l;
    __device__ __forceinline__ void operator()(const f32x4 (&acc)[2][2][4][2], const ge::Unit& u, int wr, int wc, int fr, int fq, int tid) const {
        const int b = u.pm / 33, j = u.pm - b * 33;
        const float* src = l > 0 ? (const float*)X + (size_t)u.pm * 256 * D : (j == 0 ? in_ctx + (size_t)b * CTXL * D : in_x + ((size_t)b * SEQ + (size_t)(j - 1) * 256) * D);
        const float* gv = mod + (size_t)(j == 0 ? 4 : b) * 6144 + 2048;
        float* dst = X + (size_t)u.pm * 256 * D;
        const int col0 = u.pn * 256 + wc * 32 + 4 * fq;
        f32x4 gg[2][2];
#pragma unroll
        for (int bj = 0; bj < 2; ++bj)
#pragma unroll
            for (int n = 0; n < 2; ++n) gg[bj][n] = *(const f32x4*)(gv + col0 + bj * 128 + n * 16);
#pragma unroll
        for (int ai = 0; ai < 2; ++ai) {
            f32x4 xo[4][2][2];
#pragma unroll
            for (int m = 0; m < 4; ++m) { const GAS float* sp_ = (const GAS float*)(src + (size_t)(ai * 128 + wr * 64 + m * 16 + fr) * D + col0);
#pragma unroll
                for (int bj = 0; bj < 2; ++bj)
#pragma unroll
                    for (int n = 0; n < 2; ++n) xo[m][bj][n] = *(const GAS f32x4*)(sp_ + bj * 128 + n * 16); }
#pragma unroll
            for (int m = 0; m < 4; ++m) { float* dp_ = dst + (size_t)(ai * 128 + wr * 64 + m * 16 + fr) * D + col0;
#pragma unroll
                for (int bj = 0; bj < 2; ++bj)
#pragma unroll
                    for (int n = 0; n < 2; ++n) *(f32x4*)(dp_ + bj * 128 + n * 16) = xo[m][bj][n] + gg[bj][n] * acc[ai][bj][m][n]; } }
    }
};
__device__ __forceinline__ void moe_prefix(Fr& F, int l) { KA_DECL;
    LAS int* ts = (LAS int*)(F.lds + CTRL_OFF); LAS int* cn = (LAS int*)(F.lds + CTRL_OFF + 160);
    __syncthreads();
    if (F.tid < 64) {
        const unsigned* cnt = WSP(const unsigned, WS_CTL) + CW_CNT + l * 32 * 64; const int e = F.tid;
        const int c = e < NE ? (int)__hip_atomic_load(cnt + e * 64, RLX_AGENT) : 0; const int t = (c + 255) >> 8; int s = t;
#pragma unroll
        for (int o = 1; o < 32; o <<= 1) { const int n = __shfl_up(s, o); if (e >= o) s += n; }
        if (e < NE) { ts[e] = s - t; cn[e] = c; }
        if (e == NE - 1) ts[NE] = s; }
    __syncthreads();
}
struct SchedMoE {
    const LAS int* ts; const LAS int* cn; int stage; const char* A; const char* W; const int* list; int G, vc;
    __device__ __forceinline__ bool next(int i, ge::Unit& u) const {
        const int L = i * G + vc, T = L >> 2, pn = L & 3; if (T >= ts[NE] || T >= MAXT) return false;
        int e = 0;
#pragma unroll
        for (int s = 16; s >= 1; s >>= 1) if (ts[e + s] <= T) e += s;
        const int t = T - ts[e];
        u.pm = T; u.pn = pn; u.kind = 0;
        if (stage == 1) { u.A = A; u.rows = list + (size_t)e * R + t * 256; u.aux = min(256, cn[e] - t * 256); u.lda = 2048; u.B = W + (size_t)e * (D * D * 2) + (size_t)pn * 256 * 2048; u.ldb = 2048; u.nt = 16; }
        else { u.A = A + (size_t)T * 256 * 1024; u.rows = nullptr; u.aux = 256; u.lda = 1024; u.B = W + (size_t)e * (D * DFF * 2) + (size_t)pn * 256 * 1024; u.ldb = 1024; u.nt = 8; }
        return true; }
};
struct EpiAct {
    static constexpr bool PERM = true, DRAIN = false;
    bf16* O;
    __device__ __forceinline__ void operator()(const f32x4 (&acc)[2][2][4][2], const ge::Unit& u, int wr, int wc, int fr, int fq, int tid) const {
        const int row0 = u.pm * 256 + wr * 64 + fr, col0 = u.pn * 128 + wc * 32 + 8 * fq;
#pragma unroll
        for (int ai = 0; ai < 2; ++ai)
#pragma unroll
            for (int m = 0; m < 4; ++m) { const f32x4 a0 = acc[ai][0][m][0], a1 = acc[ai][0][m][1], b0 = acc[ai][1][m][0], b1 = acc[ai][1][m][1]; u32x4 w;
                w.x = ge::cvt_pk_bf16(siluf_(a0[0]) * b0[0], siluf_(a0[1]) * b0[1]); w.y = ge::cvt_pk_bf16(siluf_(a0[2]) * b0[2], siluf_(a0[3]) * b0[3]);
                w.z = ge::cvt_pk_bf16(siluf_(a1[0]) * b1[0], siluf_(a1[1]) * b1[1]); w.w = ge::cvt_pk_bf16(siluf_(a1[2]) * b1[2], siluf_(a1[3]) * b1[3]);
                *(u32x4*)(O + (size_t)(row0 + ai * 128 + m * 16) * DFF + col0) = w; }
    }
};

__device__ __forceinline__ int act_row(int l, int q) { return l == 0 ? q : (q >> 13) * RPB + CTXL + (q & 8191); }
__device__ __forceinline__ void pe1_router(Fr& F, int l) { KA_DECL;
    const int nrows = l == 0 ? R : NB * SEQ;
    const int gw = F.bid * 8 + F.wave, NGW = F.G * 8, lane = F.lane;
    const float* nw = KA->in[I_NFFN] + l * D;
    const float* rgw = KA->in[I_RGW] + (size_t)l * D * 4; const float* rew = KA->in[I_REW] + (size_t)l * D * 32;
    const float* rgb = KA->in[I_RGB] + l * 4; const float* reb = KA->in[I_REB] + l * 32;
    unsigned* cnt = WSP(unsigned, WS_CTL) + CW_CNT + l * 32 * 64;
    for (int q = gw; q < nrows; q += NGW) {
        float a[36];
#pragma unroll
        for (int j = 0; j < 36; ++j) a[j] = 0.f;
        f32x4 f[4];
        const int r = act_row(l, q);
        {   const float* mod = WSP(const float, SM_MOD) + ((size_t)l * 5 + row_cr(r)) * 6144;
            const f32x4* xr = (const f32x4*)(WSP(const float, WS_X) + (size_t)r * D) + lane; float s = 0.f;
#pragma unroll
            for (int j = 0; j < 4; ++j) { f[j] = xr[64 * j]; const f32x4 v = f[j]; s += (v.x * v.x + v.y * v.y) + (v.z * v.z + v.w * v.w); }
            const float rstd = 1.0f / sqrtf(wave_sum(s) * (1.f / D) + EPS);
            unsigned long long* o8 = (unsigned long long*)(WSP(bf16, WS_H) + (size_t)r * D) + lane;
#pragma unroll
            for (int j = 0; j < 4; ++j) { const int k = 4 * (lane + 64 * j);
                const f32x4 w4 = *(const f32x4*)(nw + k), sh = *(const f32x4*)(mod + 3072 + k), sc = *(const f32x4*)(mod + 4096 + k);
                const f32x4 h = (f[j] * rstd) * w4 * (sc + 1.0f) + sh; f[j] = h;
                o8[64 * j] = (unsigned long long)pk2(h.x, h.y) | ((unsigned long long)pk2(h.z, h.w) << 32); } }
#pragma unroll
        for (int j = 0; j < 4; ++j)
#pragma unroll
            for (int e = 0; e < 4; ++e) { const int k = 4 * (lane + 64 * j) + e;
                const f32x4 wg = *(const f32x4*)(rgw + (size_t)k * 4); const f32x4* wep = (const f32x4*)(rew + (size_t)k * 32);
                const float fv = f[j][e];
#pragma unroll
                for (int t = 0; t < 4; ++t) a[t] += fv * wg[t];
#pragma unroll
                for (int t = 0; t < 8; ++t) { const f32x4 we = wep[t]; a[4 + 4 * t] += fv * we.x; a[5 + 4 * t] += fv * we.y; a[6 + 4 * t] += fv * we.z; a[7 + 4 * t] += fv * we.w; }
                asm volatile("" ::: "memory"); }
        {
#pragma unroll
            for (int j = 0; j < 36; ++j) a[j] = wave_sum(a[j]) + (j < 4 ? rgb[j] : reb[j - 4]);
            int gt = 0; float gm = a[0];
#pragma unroll
            for (int j = 1; j < 4; ++j) if (a[j] > gm) { gm = a[j]; gt = j; }
            float gs = 0.f;
#pragma unroll
            for (int j = 0; j < 4; ++j) gs += __expf(a[j] - gm);
            const float pg = 1.0f / gs;
            float el[8];
#pragma unroll
            for (int i = 0; i < 8; ++i) el[i] = gt == 0 ? a[4 + i] : (gt == 1 ? a[12 + i] : (gt == 2 ? a[20 + i] : a[28 + i]));
            int i1 = 0; float m1 = el[0];
#pragma unroll
            for (int i = 1; i < 8; ++i) if (el[i] > m1) { m1 = el[i]; i1 = i; }
            int i2 = -1; float m2 = -3.0e38f;
#pragma unroll
            for (int i = 0; i < 8; ++i) if (i != i1 && el[i] > m2) { m2 = el[i]; i2 = i; }
            float one_ = 1.0f; asm volatile("" : "+s"(one_)); const float e2 = __expf(m2 - m1), den = __builtin_amdgcn_rcpf(one_ + e2);
            const float w1 = pg * den, w2 = pg * e2 * den;
            if (lane == 0) { const int x1 = gt * 8 + i1, x2 = gt * 8 + i2;
                const unsigned k1 = __hip_atomic_fetch_add(cnt + x1 * 64, 1u, RLX_AGENT), k2 = __hip_atomic_fetch_add(cnt + x2 * 64, 1u, RLX_AGENT);
                int* lst = WSP(int, SM_LIST); lst[(size_t)x1 * R + k1] = r; lst[(size_t)x2 * R + k2] = r;
                u32x4* tk = (u32x4*)(WSP(unsigned, SM_TOK) + (size_t)r * 8);
                tk[0] = (u32x4){(unsigned)x1, (unsigned)x2, k1, k2}; tk[1] = (u32x4){__builtin_bit_cast(unsigned, w1), __builtin_bit_cast(unsigned, w2), 0u, 0u}; }
        }
    }
}
__device__ __forceinline__ void router_fold(Fr& F, int l) { KA_DECL;
    const int gt = F.bid * 512 + F.tid, NGT = F.G * 512;
    const float* nw = KA->in[I_NFFN] + l * D; const float* rgw = KA->in[I_RGW] + (size_t)l * D * 4; const float* rew = KA->in[I_REW] + (size_t)l * D * 32;
    for (int e = gt; e < 5 * 1024 * 64; e += NGT) { const int cr = e >> 16, k = (e >> 6) & 1023, j = e & 63;
        const float a = nw[k] * (1.0f + WSP(const float, SM_MOD)[((size_t)l * 5 + cr) * 6144 + 4096 + k]);
        const float w = j < 32 ? rew[k * 32 + j] : (j < 36 ? rgw[k * 4 + (j - 32)] : 0.f);
        WSP(float, SM_WF)[e] = a * w; }
    const int gw = F.bid * 8 + F.wave, NGW = F.G * 8, lane = F.lane;
    for (int idx = gw; idx < 5 * 36; idx += NGW) { const int cr = idx / 36, j = idx % 36; const float* sh = WSP(const float, SM_MOD) + ((size_t)l * 5 + cr) * 6144 + 3072; float s = 0.f;
        for (int k = lane; k < 1024; k += 64) s += sh[k] * (j < 32 ? rew[k * 32 + j] : rgw[k * 4 + (j - 32)]);
        s = wave_sum(s);
        if (lane == 0) WSP(float, SM_RC)[cr * 64 + j] = s + (j < 32 ? KA->in[I_REB][l * 32 + j] : KA->in[I_RGB][l * 4 + (j - 32)]); }
}
__device__ __forceinline__ void pe1_router_mfma(Fr& F, int l) { KA_DECL;
    const int ntiles = (l == 0 ? R : NB * SEQ) / 32;
    const int gw = F.bid * 8 + F.wave, NGW = F.G * 8, lane = F.lane, ri = lane & 31, kh = lane >> 5;
    const float* nw = KA->in[I_NFFN] + l * D;
    unsigned* cnt = WSP(unsigned, WS_CTL) + CW_CNT + l * 32 * 64;
    LAS float* LG = (LAS float*)(F.lds + F.wave * 8448);
    LAS int* cntL = (LAS int*)(F.lds + 69632); LAS int* baseL = cntL + 32;
    if (F.tid < 32) cntL[F.tid] = 0;
    __syncthreads();
    const int tile = F.wave * F.G + F.bid;
    const bool has = tile < ntiles;
    int x1 = 0, x2 = 0, lr1 = 0, lr2 = 0; float w1 = 0.f, w2 = 0.f, rstd = 0.f; int row0 = 0, cr = 0;
    if (has) {
        row0 = act_row(l, tile * 32); cr = row_cr(row0);
        const float* xr = WSP(const float, WS_X) + (size_t)(row0 + ri) * D + 4 * kh;
        const float* wf = WSP(const float, SM_WF) + (size_t)cr * 65536 + (size_t)(4 * kh) * 64 + ri;
        f32x16 acc0, acc1;
#pragma unroll
        for (int q = 0; q < 16; ++q) { acc0[q] = 0.f; acc1[q] = 0.f; }
        float ss = 0.f;
        f32x4 xn_[4]; float wn0[16], wn1[16]; f32x4 xc_[4]; float wc0[16], wc1[16];
#define RT_LOAD(st) do { _Pragma("unroll") for (int u_ = 0; u_ < 4; ++u_) { const int t_ = (st) * 4 + u_; xn_[u_] = *(const f32x4*)(xr + 8 * t_); \
            _Pragma("unroll") for (int e_ = 0; e_ < 4; ++e_) { wn0[u_ * 4 + e_] = wf[(size_t)(8 * t_ + e_) * 64]; wn1[u_ * 4 + e_] = wf[(size_t)(8 * t_ + e_) * 64 + 32]; } } } while (0)
        RT_LOAD(0);
        for (int st = 0; st < (PROBE_RT == 1 ? 1 : 32); ++st) {
#pragma unroll
            for (int u_ = 0; u_ < 4; ++u_) xc_[u_] = xn_[u_];
#pragma unroll
            for (int u_ = 0; u_ < 16; ++u_) { wc0[u_] = wn0[u_]; wc1[u_] = wn1[u_]; }
            if (st < 31) RT_LOAD(st + 1);
#pragma unroll
            for (int u_ = 0; u_ < 4; ++u_) { const f32x4 xv = xc_[u_]; ss += (xv.x * xv.x + xv.y * xv.y) + (xv.z * xv.z + xv.w * xv.w);
#pragma unroll
                for (int e = 0; e < 4; ++e) { acc0 = __builtin_amdgcn_mfma_f32_32x32x2f32(xv[e], wc0[u_ * 4 + e], acc0, 0, 0, 0); acc1 = __builtin_amdgcn_mfma_f32_32x32x2f32(xv[e], wc1[u_ * 4 + e], acc1, 0, 0, 0); } }
        }
#undef RT_LOAD
        ss += __shfl_xor(ss, 32);
        rstd = 1.0f / sqrtf(ss * (1.f / D) + EPS);
        if (lane < 32) ((LAS float*)(F.lds + 131072))[F.wave * 32 + ri] = rstd;
#pragma unroll
        for (int q = 0; q < 16; ++q) { const int row = (q & 3) + 8 * (q >> 2) + 4 * kh; LG[row * 66 + ri] = acc0[q]; LG[row * 66 + 32 + ri] = acc1[q]; }
        LDS_WAIT(); asm volatile("" ::: "memory");
        if (lane < 32) {
            const float* rc = WSP(const float, SM_RC) + cr * 64; const LAS float* lg = LG + ri * 66;
            float g4[4];
#pragma unroll
            for (int j = 0; j < 4; ++j) g4[j] = lg[32 + j] * rstd + rc[32 + j];
            int gt = 0; float gm = g4[0];
#pragma unroll
            for (int j = 1; j < 4; ++j) if (g4[j] > gm) { gm = g4[j]; gt = j; }
            float gs = 0.f;
#pragma unroll
            for (int j = 0; j < 4; ++j) gs += __expf(g4[j] - gm);
            const float pg = 1.0f / gs;
            float el[8];
#pragma unroll
            for (int i = 0; i < 8; ++i) el[i] = lg[gt * 8 + i] * rstd + rc[gt * 8 + i];
            int i1 = 0; float m1 = el[0];
#pragma unroll
            for (int i = 1; i < 8; ++i) if (el[i] > m1) { m1 = el[i]; i1 = i; }
            int i2 = -1; float m2 = -3.0e38f;
#pragma unroll
            for (int i = 0; i < 8; ++i) if (i != i1 && el[i] > m2) { m2 = el[i]; i2 = i; }
            float one_ = 1.0f; asm volatile("" : "+s"(one_)); const float e2 = __expf(m2 - m1), den = __builtin_amdgcn_rcpf(one_ + e2);
            w1 = pg * den; w2 = pg * e2 * den; x1 = gt * 8 + i1; x2 = gt * 8 + i2;
            lr1 = __hip_atomic_fetch_add(cntL + x1, 1, __ATOMIC_RELAXED, __HIP_MEMORY_SCOPE_WORKGROUP); lr2 = __hip_atomic_fetch_add(cntL + x2, 1, __ATOMIC_RELAXED, __HIP_MEMORY_SCOPE_WORKGROUP);
        }
    }
    __syncthreads();
    if (F.tid < 32) { const int c = cntL[F.tid]; baseL[F.tid] = c ? (int)__hip_atomic_fetch_add(cnt + F.tid * 64, (unsigned)c, RLX_AGENT) : 0; }
    __syncthreads();
    if (has) {
        if (lane < 32) { const int r = row0 + ri; const unsigned k1 = (unsigned)(baseL[x1] + lr1), k2 = (unsigned)(baseL[x2] + lr2);
            int* lst = WSP(int, SM_LIST); lst[(size_t)x1 * R + k1] = r; lst[(size_t)x2 * R + k2] = r;
            unsigned* tk = WSP(unsigned, SM_TOK) + (size_t)r * 8;
            tk[0] = (unsigned)x1; tk[1] = (unsigned)x2; tk[2] = k1; tk[3] = k2; tk[4] = __builtin_bit_cast(unsigned, w1); tk[5] = __builtin_bit_cast(unsigned, w2);
        }
    }
    {   int w_ = F.wave; asm volatile("" : "+s"(w_));
        for (int t = 0; t * F.G + F.bid < ntiles; ++t) { const int trow0 = act_row(l, (t * F.G + F.bid) * 32), tcr = row_cr(trow0);
            const float* mod = WSP(const float, SM_MOD) + ((size_t)l * 5 + tcr) * 6144;
            f32x4 xv[4][4]; float rs[4];
#pragma unroll
            for (int i = 0; i < 4; ++i) { const int rr = w_ + 8 * i; const GAS f32x4* xq = (const GAS f32x4*)(WSP(const float, WS_X) + (size_t)(trow0 + rr) * D) + lane;
#pragma unroll
                for (int j = 0; j < 4; ++j) xv[i][j] = xq[64 * j];
                rs[i] = ((const LAS float*)(F.lds + 131072))[t * 32 + rr]; }
            f32x4 ca[4], cs[4];
#pragma unroll
            for (int j = 0; j < 4; ++j) { const int k = 4 * (lane + 64 * j); ca[j] = *(const f32x4*)(nw + k) * (*(const f32x4*)(mod + 4096 + k) + 1.0f); cs[j] = *(const f32x4*)(mod + 3072 + k); }
#pragma unroll
            for (int i = 0; i < 4; ++i) { unsigned long long* o8 = (unsigned long long*)(WSP(bf16, WS_H) + (size_t)(trow0 + w_ + 8 * i) * D) + lane;
#pragma unroll
                for (int j = 0; j < 4; ++j) { const f32x4 h = (xv[i][j] * rs[i]) * ca[j] + cs[j];
                    o8[64 * j] = (unsigned long long)pk2(h.x, h.y) | ((unsigned long long)pk2(h.z, h.w) << 32); } } }
        LDS_WAIT(); asm volatile("" ::: "memory"); }
}
__device__ __forceinline__ void pe4_combine(Fr& F, int l) { KA_DECL;
    const LAS int* ts = (const LAS int*)(F.lds + CTRL_OFF);
    LAS float* wdt = (LAS float*)F.lds;
    if (l < DEPTH - 1) { const float* win2 = KA->in[I_WIN] + (size_t)(l + 1) * D * NIN; for (int e = F.tid; e < D * 8; e += 512) wdt[e] = win2[(size_t)(e >> 3) * NIN + 3072 + (e & 7)]; __syncthreads(); }
    const int nrows = l == 0 ? R : NB * SEQ;
    const int gw = F.bid * 8 + F.wave, NGW = F.G * 8, lane = F.lane;
    const bf16* YO = WSP(const bf16, BG_YO);
    unsigned nt0 = 0, nt1 = 0, nt2 = 0, nt3 = 0, nt4 = 0, nt5 = 0;
    f32x4 px[4]; u32x2 pa[4], pb[4]; float pw1 = 0.f, pw2 = 0.f;
#pragma unroll
    for (int j = 0; j < 4; ++j) { px[j] = (f32x4){0.f, 0.f, 0.f, 0.f}; pa[j] = (u32x2){0u, 0u}; pb[j] = (u32x2){0u, 0u}; }
#define E4_REC(qq) do { const unsigned* tkp = WSP(const unsigned, SM_TOK) + (size_t)act_row(l, (qq)) * 8; nt0 = tkp[0]; nt1 = tkp[1]; nt2 = tkp[2]; nt3 = tkp[3]; nt4 = tkp[4]; nt5 = tkp[5]; } while (0)
#define E4_ROWS(qq) do { const size_t s1_ = (size_t)ts[nt0] * 256 + nt2, s2_ = (size_t)ts[nt1] * 256 + nt3; pw1 = __builtin_bit_cast(float, nt4); pw2 = __builtin_bit_cast(float, nt5); \
        const GAS f32x4* xr_ = (const GAS f32x4*)(WSP(float, WS_X) + (size_t)act_row(l, (qq)) * D) + lane; const GAS u32x2* y1_ = (const GAS u32x2*)(YO + s1_ * D) + lane; const GAS u32x2* y2_ = (const GAS u32x2*)(YO + s2_ * D) + lane; \
        _Pragma("unroll") for (int j_ = 0; j_ < 4; ++j_) { px[j_] = xr_[64 * j_]; pa[j_] = y1_[64 * j_]; pb[j_] = y2_[64 * j_]; } } while (0)
    f32x4 wl4[4];
#pragma unroll
    for (int j = 0; j < 4; ++j) wl4[j] = *(const f32x4*)((l < DEPTH - 1 ? KA->in[I_NMIX] + (l + 1) * D : KA->in[I_FNW]) + 4 * (lane + 64 * j));
    if (gw < nrows) { E4_REC(gw); E4_ROWS(gw); if (gw + NGW < nrows) E4_REC(gw + NGW); }
    for (int q = gw; q < nrows; q += NGW) { const int r = act_row(l, q);
        f32x4 cx[4]; u32x2 ca[4], cb[4]; const float w1 = pw1, w2 = pw2;
#pragma unroll
        for (int j = 0; j < 4; ++j) { cx[j] = px[j]; ca[j] = pa[j]; cb[j] = pb[j]; }
        if (q + NGW < nrows) { E4_ROWS(q + NGW); if (q + 2 * NGW < nrows) E4_REC(q + 2 * NGW); }
        const GAS float* mod = (const GAS float*)(WSP(const float, SM_MOD) + ((size_t)l * 5 + row_cr(r)) * 6144 + 5120);
        f32x4* xr = (f32x4*)(WSP(float, WS_X) + (size_t)r * D) + lane;
        f32x4 xn[4]; float ss = 0.f;
        f32x4 gg4[4], sh4[4], sc4[4];
#pragma unroll
        for (int j = 0; j < 4; ++j) { const int k = 4 * (lane + 64 * j); gg4[j] = *(const GAS f32x4*)(mod + k);
            if (l < DEPTH - 1) { const GAS float* m2 = (const GAS float*)(WSP(const float, SM_MOD) + ((size_t)(l + 1) * 5 + row_cr(r)) * 6144); sh4[j] = *(const GAS f32x4*)(m2 + k); sc4[j] = *(const GAS f32x4*)(m2 + 1024 + k); } }
#pragma unroll
        for (int j = 0; j < 4; ++j) { const f32x4 x = cx[j], gg = gg4[j]; const u32x2 a = ca[j], b = cb[j];
            const f32x4 ya = {bflo(a.x), bfhi(a.x), bflo(a.y), bfhi(a.y)}, yb = {bflo(b.x), bfhi(b.x), bflo(b.y), bfhi(b.y)};
            xn[j] = x + gg * (ya * w1 + yb * w2) * DBG_E4S; const f32x4 v = xn[j]; ss += (v.x * v.x + v.y * v.y) + (v.z * v.z + v.w * v.w); }
        if (l == DEPTH - 1) { const float rstd = 1.0f / sqrtf(wave_sum(ss) * (1.f / D) + EPS);
            const int b = r / RPB, s = r - b * RPB; f32x4* orow = (f32x4*)(KA->out + ((size_t)b * SEQ + (s - CTXL)) * D) + lane;
#pragma unroll
            for (int j = 0; j < 4; ++j) orow[64 * j] = xn[j] * rstd * wl4[j]; }
        else {
            const float rstd = 1.0f / sqrtf(wave_sum(ss) * (1.f / D) + EPS);
            unsigned long long* o8 = (unsigned long long*)(WSP(bf16, WS_H) + (size_t)r * D) + lane;
            float d8[8] = {0, 0, 0, 0, 0, 0, 0, 0};
#pragma unroll
            for (int j = 0; j < 4; ++j) { xr[64 * j] = xn[j]; const int k = 4 * (lane + 64 * j);
                const f32x4 w4 = wl4[j], sh = sh4[j], sc = sc4[j];
                const f32x4 h = (xn[j] * rstd) * w4 * (sc + 1.0f) + sh;
                o8[64 * j] = (unsigned long long)pk2(h.x, h.y) | ((unsigned long long)pk2(h.z, h.w) << 32);
#pragma unroll
                for (int e = 0; e < 4; ++e) { const f32x4 wa = *(const LAS f32x4*)(wdt + (k + e) * 8), wb = *(const LAS f32x4*)(wdt + (k + e) * 8 + 4); const float hv = h[e];
                    d8[0] += hv * wa.x; d8[1] += hv * wa.y; d8[2] += hv * wa.z; d8[3] += hv * wa.w; d8[4] += hv * wb.x; d8[5] += hv * wb.y; d8[6] += hv * wb.z; d8[7] += hv * wb.w; } }
#pragma unroll
            for (int e = 0; e < 8; ++e) d8[e] = wave_sum(d8[e]);
            if (lane == 0) { float* dt = WSP(float, SM_DT) + (size_t)r * 8; *(f32x4*)dt = (f32x4){d8[0], d8[1], d8[2], d8[3]}; *(f32x4*)(dt + 4) = (f32x4){d8[4], d8[5], d8[6], d8[7]}; } }
    }
}

constexpr int PH_PER_L = 14, N_PHASES = 2 + DEPTH * PH_PER_L;
#ifndef USE_CG
#define USE_CG 1
#endif
#ifndef PHMASK
#define PHMASK 0xFFFFFFFFu
#endif
#define PON(x) ((PHSEL < 0 && ((PHMASK >> ((x) >= 100 ? (x) - 86 : (x))) & 1u)) || PHSEL == (x))

template <bool COOP, int PHSEL>
__global__ void __launch_bounds__(512, 2) mk(Args a) {
    extern __shared__ __attribute__((aligned(16))) unsigned char lds_raw[];
    Fr F;
    F.lds = (LAS unsigned char*)lds_raw;
    {   const int t0 = threadIdx.x;
        for (int u = t0; u < (LDS_BYTES - CTRL_OFF) / 4; u += 512) ((LAS unsigned*)(F.lds + CTRL_OFF))[u] = 0u;
        __syncthreads();
        if ((t0 & 63) == 0) ((volatile LAS int*)(F.lds + MISC_OFF + 128))[(unsigned)__builtin_amdgcn_s_getreg((6 << 11) | 4) & 63u] = t0 >> 6;
        __syncthreads();
        if (COOP) { KA_DECL; (void)xcd_barrier_post(WSP(unsigned, WS_CTL) + CW_BAR, (volatile LAS unsigned*)(F.lds + MISC_OFF) + 8); } }
    for (int ph = a.ph_lo; ; ++ph) {
        { KA_DECL; if (ph >= KA->ph_hi) break; }
#define PHASE_ENTER(tag) do { int bid_ = blockIdx.x, g_ = gridDim.x; asm volatile("; enter " tag : "+s"(bid_), "+s"(g_)); \
            const unsigned hw_ = (unsigned)__builtin_amdgcn_s_getreg((6 << 11) | 4) & 63u; int wv_ = __builtin_amdgcn_readfirstlane(((volatile LAS int*)(F.lds + MISC_OFF + 128))[hw_]); \
            unsigned z_ = 0u; asm volatile("; z " tag : "+s"(z_)); int lane_ = (int)__builtin_amdgcn_mbcnt_hi(~0u, __builtin_amdgcn_mbcnt_lo(~0u, z_)) & 63; int tid_ = wv_ * 64 + lane_; asm volatile("; tid " tag : "+v"(tid_)); \
            F.tid = tid_; F.lane = tid_ & 63; F.wave = __builtin_amdgcn_readfirstlane(tid_ >> 6); F.bid = bid_; F.G = g_; } while (0)
        if (ph >= 2 + PH_PER_L && (ph - 2) % PH_PER_L == 0) continue;
        if (ph >= 2 && (ph - 2) % PH_PER_L == 5) continue;
        PHASE_ENTER("top");
        const int vc = (F.G % 8 == 0) ? (F.bid % 8) * (F.G / 8) + F.bid / 8 : F.bid;
        if (ph == 0) { if (PON(100)) { PHASE_ENTER("p100"); p0_prologue(F, -1); } }
        else if (ph == 1) { if (PON(101)) { PHASE_ENTER("p101"); p1_mod(F); } }
        else {
            const int l = (ph - 2) / PH_PER_L, p = (ph - 2) % PH_PER_L; const bool last = (l == DEPTH - 1);
            KA_DECL;
            const char* wt_in = (const char*)(WSP(bf16, WT_IN) + (size_t)l * NWIN * D);
            if (p == 0) { if (PON(0)) { PHASE_ENTER("p0"); pa_hrows(F, l); router_fold(F, l); } }
            else if (p == 1) { if (PON(1)) { PHASE_ENTER("p1");
                SchedGrid S{(const char*)WSP(bf16, WS_H), wt_in, 2048u, 2048u, 16, R / 256, NP / 256, F.G, F.bid, false};
                EpiStore E{WSP(bf16, BG_PROJ), NP};
                ge::gemm_engine<EpiStore, SchedGrid, false>(F.lds, S, E, F.tid);
            } }
            else if (p == 2) { if (PON(2)) { PHASE_ENTER("p2");
                const bool ctx_static = !last && F.G >= 48;
                if (ctx_static && F.bid >= F.G - 16) { fft_ctx(F, F.bid - (F.G - 16)); __syncthreads(); }
                for (int t = F.bid; t < NSPAN; t += F.G) span_task_mfma<0, false>(F, l, t);
                bool mat = false; const int nctx = (last || ctx_static) ? 0 : 16;
                {   KA_DECL; unsigned* wq = WSP(unsigned, WS_CTL) + CW_WQ + (l * 4 + 0) * 64;
                    dyn_tickets(F, wq, nctx + 512 + R / 64, [&](int c) {
                        if (c < nctx) fft_ctx(F, c);
                        else if (c < nctx + 512) { if (!mat) { KA_DECL; lds_load_mat<128>(F, WSP(const bf16, SM_M1B)); mat = true; } fft_stage_a(F, c - nctx); }
                        else conv_a_chunk(F, l, c - nctx - 512); }); }
            } }
            else if (p == 3 || p == 6) { if (PON(3)) { PHASE_ENTER("p3"); state_scan(F, p == 6); } }
            else if (p == 4) { if (PON(4)) { PHASE_ENTER("p4");
                if (PROBE_P4 != 1) for (int t = F.bid; t < NSPAN; t += F.G) { if (last && (t % SPB) < 4) continue; span_task_mfma<0, true>(F, l, t); }
                {   KA_DECL; unsigned* wq = WSP(unsigned, WS_CTL) + CW_WQ + (l * 4 + 1) * 64; dyn_tickets(F, wq, R / 64, [&](int c) {
                        conv_xbc_chunk(F, l, c); __builtin_amdgcn_fence(__ATOMIC_SEQ_CST, "workgroup"); __syncthreads(); span_task_mfma<1, false>(F, l, c); }); }
            } }
            else if (p == 5) { }
            else if (p == 7) { if (PON(7)) { PHASE_ENTER("p7");
                for (int t = F.bid; t < NSPAN; t += F.G) { if (last && (t % SPB) < 4) continue; span_task_mfma<1, true>(F, l, t); }
                bool mat = false;
                {   KA_DECL; unsigned* wq = WSP(unsigned, WS_CTL) + CW_WQ + (l * 4 + 2) * 64;
                    dyn_tickets(F, wq, 512, [&](int c) { if (!mat) { KA_DECL; lds_load_mat<256>(F, WSP(const bf16, SM_M2B)); mat = true; } fft_stage_b(F, c); }); }
                if (!last) ctx_y_copy(F);
            } }
            else if (p == 8) { if (PON(8)) { PHASE_ENTER("p8");
                SchedD1 S{(const char*)WSP(bf16, WS_H), (const char*)WSP(bf16, BG_PROJ), wt_in + (size_t)NP * 2048, (const char*)(WSP(bf16, WT_BR) + (size_t)l * 4 * D * 256), 128, F.G, F.bid, (512 + F.G - 1 - F.bid) / F.G, last};
                EpiD1 E{WSP(bf16, BG_MERGED), KA->ws + BG_GSCR + (size_t)F.bid * 131072, KA->ws + BG_MSCR + (size_t)F.bid * 131072, WSP(float, BG_MF)};
                ge::gemm_engine<EpiD1, SchedD1, false, false>(F.lds, S, E, F.tid);
                if (!last && F.bid < 64) ctx_tile_finish(F, l);
                if (l == 0 && DEPTH > 1) {
                    KA_DECL; unsigned* wq = WSP(unsigned, WS_CTL) + CW_WQ + 12 * 64; __syncthreads();
                    dyn_tickets(F, wq, PRO_L1_TICKETS, [&](int c) { p0_prologue(F, c); }); }
            } }
            else if (p == 9) { if (PON(9)) { PHASE_ENTER("p9");
                SchedGrid S{(const char*)WSP(bf16, BG_MERGED), (const char*)(WSP(bf16, WT_OUT) + (size_t)l * D * D), 2048u, 2048u, 16, last ? 128 : 132, 4, F.G, F.bid, last};
                EpiResid E{KA->in[I_X], KA->in[I_CTX], WSP(float, WS_X), WSP(const float, SM_MOD) + (size_t)l * 5 * 6144, l};
                ge::gemm_engine<EpiResid, SchedGrid, false>(F.lds, S, E, F.tid);
                if (!last) moe_convert_tickets(F, l, 0);
            } }
            else if (p == 10) { if (PON(10)) { PHASE_ENTER("p10"); pe1_router_mfma(F, l); moe_convert_tickets(F, l, 0); } }
            else if (p == 11) { if (PON(11)) { PHASE_ENTER("p11");
                moe_prefix(F, l);
                SchedMoE S{(const LAS int*)(F.lds + CTRL_OFF), (const LAS int*)(F.lds + CTRL_OFF + 160), 1, (const char*)WSP(bf16, WS_H), (const char*)WSP(bf16, BG_W13), WSP(const int, SM_LIST), F.G, vc};
                EpiAct E{WSP(bf16, BG_ACT)};
                ge::gemm_engine<EpiAct, SchedMoE, true>(F.lds, S, E, F.tid);
                moe_convert_tickets(F, l, 1);
            } }
            else if (p == 12) { if (PON(12)) { PHASE_ENTER("p12");
                moe_prefix(F, l);
                SchedMoE S{(const LAS int*)(F.lds + CTRL_OFF), (const LAS int*)(F.lds + CTRL_OFF + 160), 2, (const char*)WSP(bf16, BG_ACT), (const char*)WSP(bf16, BG_W2), nullptr, F.G, vc};
                EpiStore E{WSP(bf16, BG_YO), D};
                ge::gemm_engine<EpiStore, SchedMoE, false>(F.lds, S, E, F.tid);
            } }
            else { if (PON(13)) { PHASE_ENTER("p13"); moe_prefix(F, l); pe4_combine(F, l); if (l < DEPTH - 1) router_fold(F, l + 1); } }
        }
        { KA_DECL; if (ph + 1 >= KA->ph_hi) break; }
        {
            if (COOP) { if (USE_CG && ph == 0) cg::this_grid().sync(); else { KA_DECL; XcdBarrier bar; bar.bar = WSP(unsigned, WS_CTL) + CW_BAR; bar.x = xb_xcc_id(); bar.st = (volatile LAS unsigned*)(F.lds + MISC_OFF) + 8; xcd_barrier(bar, F.tid); } }
        }
    }
}

#ifndef PROFILE_P
#define PROFILE_P 2
#endif
#ifndef PROFILE_SEL
#define PROFILE_SEL 0
#endif
#ifndef PROFILE_UNIT_US
#define PROFILE_UNIT_US 20.f
#endif
#ifndef PROFILE_GROUPS
#define PROFILE_GROUPS 0
#endif
#ifndef ONE_LAUNCH
#define ONE_LAUNCH 1
#endif
#ifndef DBG_STOP
#define DBG_STOP 0
#endif
#ifndef DBG_K
#define DBG_K 30.f
#endif
__global__ void __launch_bounds__(256) dbg_gemm(const bf16* A, int lda, const bf16* Bt, int ldb, int K, const bf16* C, int ldc, int c0, float* out) {
    const int q = blockIdx.x, r = (q >> 13) * RPB + CTXL + (q & 8191);
    __shared__ float arow[1024];
    for (int k = threadIdx.x; k < K; k += 256) arow[k] = bf2f(A[(size_t)r * lda + k]);
    __syncthreads();
    for (int c = threadIdx.x; c < 1024; c += 256) { const bf16* b = Bt + (size_t)(c0 + c) * ldb; float s = 0.f;
        for (int k = 0; k < K; k += 8) { const u32x4 w = *(const u32x4*)(b + k);
            s += arow[k] * bflo(w.x) + arow[k + 1] * bfhi(w.x) + arow[k + 2] * bflo(w.y) + arow[k + 3] * bfhi(w.y) + arow[k + 4] * bflo(w.z) + arow[k + 5] * bfhi(w.z) + arow[k + 6] * bflo(w.w) + arow[k + 7] * bfhi(w.w); }
        out[(size_t)q * D + c] = DBG_K * (bf2f(C[(size_t)r * ldc + c0 + c]) - s); }
}
__global__ void __launch_bounds__(256) dbg_merged(const bf16* H, const bf16* P, const bf16* Wg, const bf16* Wb, const bf16* M, float* out) {
    const int q = blockIdx.x, r = (q >> 13) * RPB + CTXL + (q & 8191);
    __shared__ float hrow[1024]; __shared__ float yrow[1024];
    for (int k = threadIdx.x; k < 1024; k += 256) { hrow[k] = bf2f(H[(size_t)r * D + k]); const int br = k >> 8, kk = k & 255; const int colk = br == 0 ? C_AB : (br == 1 ? C_Q : (br == 2 ? C_UR : C_Z)); yrow[k] = bf2f(P[(size_t)r * NP + colk + kk]); }
    __syncthreads();
    for (int c = threadIdx.x; c < 1024; c += 256) { float tot = 0.f;
        for (int br = 0; br < 4; ++br) { if (!((BRMASK >> br) & 1)) continue; const bf16* wg = Wg + (size_t)(br * 1024 + c) * D; float g = 0.f; for (int k = 0; k < 1024; ++k) g += hrow[k] * bf2f(wg[k]);
            const bf16* wb = Wb + ((size_t)br * 1024 + c) * 256; float p = 0.f; for (int k = 0; k < 256; ++k) p += yrow[br * 256 + k] * bf2f(wb[k]);
            tot += DBG_D1 == 1 ? 1.f / (1.f + expf(-g)) : (DBG_D1 == 2 ? p : p / (1.f + expf(-g))); }
        out[(size_t)q * D + c] = DBG_K * (bf2f(M[(size_t)r * D + c]) - tot); }
}
__global__ void __launch_bounds__(256) dbg_d2(const bf16* M, const bf16* Wo, const float* X, const float* xin, const float* mod, float* out) {
    const int q = blockIdx.x, b = q >> 13, r = b * RPB + CTXL + (q & 8191);
    __shared__ float mrow[1024];
    for (int k = threadIdx.x; k < 1024; k += 256) mrow[k] = bf2f(M[(size_t)r * D + k]);
    __syncthreads();
    for (int c = threadIdx.x; c < 1024; c += 256) { const bf16* w = Wo + (size_t)c * D; float s = 0.f; for (int k = 0; k < 1024; ++k) s += mrow[k] * bf2f(w[k]);
        out[(size_t)q * D + c] = DBG_K * (X[(size_t)r * D + c] - (xin[(size_t)q * D + c] + mod[(size_t)b * 6144 + 2048 + c] * s)); }
}
__global__ void __launch_bounds__(256) dbg_moe(const bf16* F, const unsigned* TOK, const unsigned* CNT, const bf16* YO, const float* W1, const float* W3, const float* W2, float* out) {
    const int q = blockIdx.x, r = (q >> 13) * RPB + CTXL + (q & 8191), tid = threadIdx.x;
    __shared__ float frow[1024]; __shared__ float act[512]; __shared__ int ts[33];
    if (tid == 0) { int a = 0; for (int e = 0; e < 32; ++e) { ts[e] = a; a += ((int)CNT[e] + 255) >> 8; } ts[32] = a; }
    for (int k = tid; k < 1024; k += 256) frow[k] = bf2f(F[(size_t)r * D + k]);
    __syncthreads();
    const unsigned* tk = TOK + (size_t)r * 8; const int ex[2] = {(int)tk[0], (int)tk[1]}; const unsigned rk[2] = {tk[2], tk[3]}; const float ww[2] = {__builtin_bit_cast(float, tk[4]), __builtin_bit_cast(float, tk[5])};
    float y[4] = {0, 0, 0, 0}, mine[4] = {0, 0, 0, 0};
    for (int s = 0; s < 2; ++s) { const int e = ex[s];
        const float* w1 = W1 + (size_t)e * D * DFF; const float* w3 = W3 + (size_t)e * D * DFF; const float* w2 = W2 + (size_t)e * DFF * D;
        for (int j = tid; j < 512; j += 256) { float a = 0.f, b = 0.f; for (int k = 0; k < 1024; ++k) { a += frow[k] * w1[(size_t)k * DFF + j]; b += frow[k] * w3[(size_t)k * DFF + j]; } act[j] = a / (1.f + expf(-a)) * b; }
        __syncthreads();
        const size_t slot = (size_t)ts[e] * 256 + rk[s];
        for (int i = 0; i < 4; ++i) { const int c = tid + 256 * i; float o = 0.f; for (int j = 0; j < 512; ++j) o += act[j] * w2[(size_t)j * D + c]; y[i] += ww[s] * o; mine[i] += ww[s] * bf2f(YO[slot * D + c]); }
        __syncthreads(); }
    for (int i = 0; i < 4; ++i) out[(size_t)q * D + tid + 256 * i] = DBG_K * (mine[i] - y[i]);
}
__global__ void __launch_bounds__(256) dbg_router(const float* X, const float* mod, const float* nw, const float* rgw, const float* rgb, const float* rew, const float* reb, const unsigned* TOK, float* out) {
    const int q = blockIdx.x, b = q >> 13, r = b * RPB + CTXL + (q & 8191), tid = threadIdx.x;
    __shared__ float f[1024]; __shared__ float red[256]; __shared__ float lg[36];
    float ss = 0.f; for (int k = tid; k < 1024; k += 256) { const float v = X[(size_t)r * D + k]; ss += v * v; }
    red[tid] = ss; __syncthreads(); for (int s = 128; s > 0; s >>= 1) { if (tid < s) red[tid] += red[tid + s]; __syncthreads(); }
    const float rstd = 1.0f / sqrtf(red[0] / 1024.f + EPS);
    for (int k = tid; k < 1024; k += 256) f[k] = X[(size_t)r * D + k] * rstd * nw[k] * (1.f + mod[(size_t)b * 6144 + 4096 + k]) + mod[(size_t)b * 6144 + 3072 + k];
    __syncthreads();
    if (tid < 36) { float s = 0.f; if (tid < 4) { for (int k = 0; k < 1024; ++k) s += f[k] * rgw[k * 4 + tid]; s += rgb[tid]; } else { for (int k = 0; k < 1024; ++k) s += f[k] * rew[k * 32 + tid - 4]; s += reb[tid - 4]; } lg[tid] = s; }
    __syncthreads();
    for (int c = tid; c < 1024; c += 256) out[(size_t)q * D + c] = 0.f;
    __syncthreads();
    if (tid == 0) { int gt = 0; for (int j = 1; j < 4; ++j) if (lg[j] > lg[gt]) gt = j; float gs = 0.f; for (int j = 0; j < 4; ++j) gs += expf(lg[j] - lg[gt]); const float pg = 1.f / gs;
        const float* el = lg + 4 + gt * 8; int i1 = 0; for (int i = 1; i < 8; ++i) if (el[i] > el[i1]) i1 = i; int i2 = -1; for (int i = 0; i < 8; ++i) if (i != i1 && (i2 < 0 || el[i] > el[i2])) i2 = i;
        const float e2 = expf(el[i2] - el[i1]), w1 = pg / (1.f + e2), w2 = pg * e2 / (1.f + e2);
        const unsigned* tk = TOK + (size_t)r * 8;
        out[(size_t)q * D + 0] = 1000.f * ((float)tk[0] - (float)(gt * 8 + i1)); out[(size_t)q * D + 1] = 1000.f * ((float)tk[1] - (float)(gt * 8 + i2));
        out[(size_t)q * D + 2] = 1000.f * (__builtin_bit_cast(float, tk[4]) - w1); out[(size_t)q * D + 3] = 1000.f * (__builtin_bit_cast(float, tk[5]) - w2); }
}
__device__ __forceinline__ float dbg_conv_silu(const bf16* P, int r, int c, const float* cw, const float* cb) {
    bool vp, vn; nbr_valid(r, vp, vn); const bf16* row = P + (size_t)r * NP + C_XBC + c;
    const float a = vp ? bf2f(row[-NP]) : 0.f, b = bf2f(row[0]), n = vn ? bf2f(row[NP]) : 0.f; const float v = cb[c] + cw[c] * a + cw[512 + c] * b + cw[1024 + c] * n; return v / (1.f + expf(-v)); }
__global__ void __launch_bounds__(64) dbg_naive_scan(const bf16* P, const float* DT, float* XO, const float* scw, const float* scb, const float* alog, const float* dtb, const float* sd, const float* hlb, int mix) {
    const int b = blockIdx.x >> 3, h = (blockIdx.x >> 1) & 3, dir = blockIdx.x & 1, lane = threadIdx.x, g = h >> 1;
    __shared__ float Ssh[64][64];
#define S_(k) Ssh[k][lane]
    for (int k = 0; k < 64; ++k) S_(k) = 0.f;
    const float A = expf(alog[dir * 4 + h]), bias = dtb[dir * 4 + h], Dh = sd[h];
    __shared__ float lbs[64]; lbs[lane] = DBG_L ? 1.f / (1.f + expf(hlb[(dir * DEPTH + 0) * 256 + h * 64 + lane] - hlb[(dir * DEPTH + DBG_L) * 256 + h * 64 + lane])) : 0.f; __syncthreads();
    for (int p = 0; p < RPB; ++p) {
        int s; if (!dir) s = p; else s = p < CTXL ? CTXL - 1 - p : RPB - 1 - (p - CTXL);
        const int r = b * RPB + s; const bf16* row = P + (size_t)r * NP; float o = 0.f;
        if (mix == 0) { const float vv = bf2f(row[C_I + h * 64 + lane]);
            for (int k = 0; k < 64; ++k) { const float fr = bf2f(row[C_FF + dir * 256 + h * 64 + k]), qr = bf2f(row[C_Q + h * 64 + k]); const float f = lbs[k] + (1.f - lbs[k]) / (1.f + expf(-fr)), q = qr / (1.f + expf(-qr));
                S_(k) = f * S_(k) + (1.f - f) * vv; o += q * S_(k); }
            if (s >= CTXL) XO[((size_t)b * SEQ + (s - CTXL)) * D + (dir ? 0 : 256) + h * 64 + lane] = o;
        } else { const float xv = dbg_conv_silu(P, r, h * 64 + lane, scw, scb); const float dtr = DT[(size_t)r * 8 + dir * 4 + h] + bias; const float dt = dtr > 20.f ? dtr : log1pf(expf(dtr)); const float a = expf(-dt * A);
            for (int k = 0; k < 64; ++k) { const float Bv = dbg_conv_silu(P, r, 256 + g * 64 + k, scw, scb), Cv = dbg_conv_silu(P, r, 384 + g * 64 + k, scw, scb);
                S_(k) = a * S_(k) + Bv * dt * xv; o += Cv * S_(k); }
            if (s >= CTXL) XO[((size_t)b * SEQ + (s - CTXL)) * D + (dir ? 512 : 768) + h * 64 + lane] = dir ? o : o + Dh * xv;
        }
    }
}
__global__ void __launch_bounds__(256) dbg_scan_cmp(const bf16* P, const float* XO, const bf16* GZ, const float* hnw, const float* snw, float* out) {
    const int q = blockIdx.x, r = (q >> 13) * RPB + CTXL + (q & 8191), c = threadIdx.x; __shared__ float red[256];
    {   const float o = XO[(size_t)q * D + 256 + c] + XO[(size_t)q * D + c]; red[c] = o * o; __syncthreads();
        for (int s = 32; s > 0; s >>= 1) { if ((c & 63) < s) red[c] += red[c + s]; __syncthreads(); }
        const float rs = 1.f / sqrtf(red[c & ~63] / 64.f + EPS); const float gr = bf2f(P[(size_t)r * NP + C_G + c]); const float y = o * rs * hnw[c & 63] * gr / (1.f + expf(-gr));
        out[(size_t)q * D + 256 + c] = DBG_K * (bf2f(P[(size_t)r * NP + C_Q + c]) - y); __syncthreads(); }
    {   const float zr = bf2f(GZ[(size_t)r * 256 + c]); const float v = (XO[(size_t)q * D + 768 + c] + XO[(size_t)q * D + 512 + c]) * zr / (1.f + expf(-zr)); red[c] = v * v; __syncthreads();
        for (int s = 64; s > 0; s >>= 1) { if ((c & 127) < s) red[c] += red[c + s]; __syncthreads(); }
        const float rs = 1.f / sqrtf(red[c & ~127] / 128.f + EPS); const float y = v * rs * snw[c];
        out[(size_t)q * D + 768 + c] = DBG_K * (bf2f(P[(size_t)r * NP + C_Z + c]) - y); }
    out[(size_t)q * D + c] = 0.f; out[(size_t)q * D + 512 + c] = 0.f;
}
__global__ void dbg_save_gz(const bf16* P, bf16* GZ) {
    const int r = blockIdx.x, c = threadIdx.x; GZ[(size_t)r * 256 + c] = P[(size_t)r * NP + C_Z + c];
}
__global__ void __launch_bounds__(256) dbg_four(const bf16* H, const float* win, const bf16* P, float* out) {
    const int q = blockIdx.x, r = (q >> 13) * RPB + CTXL + (q & 8191), c = threadIdx.x; __shared__ float hrow[1024]; __shared__ float four[256];
    for (int k = c; k < 1024; k += 256) hrow[k] = bf2f(H[(size_t)r * D + k]);
    __syncthreads();
    { float s = 0.f; for (int k = 0; k < 1024; ++k) s += hrow[k] * win[(size_t)k * NIN + 2048 + c]; four[c] = s; }
    __syncthreads();
    const int g = c >> 6, cp = c & 63; float ur = 0.f, ui = 0.f;
    for (int i = 0; i < 64; ++i) { float sn, cs; sincospif(2.0f * (float)((i * cp) & 63) / 64.0f, &sn, &cs); ur += four[g * 64 + i] * cs; ui -= four[g * 64 + i] * sn; }
    out[(size_t)q * D + c] = DBG_K * (bf2f(P[(size_t)r * NP + C_UR + c]) - ur); out[(size_t)q * D + 256 + c] = DBG_K * (bf2f(P[(size_t)r * NP + C_UI + c]) - ui);
    out[(size_t)q * D + 512 + c] = 0.f; out[(size_t)q * D + 768 + c] = 0.f;
}
__global__ void dbg_save_u(const bf16* P, bf16* U) { const int r = blockIdx.x, c = threadIdx.x; U[(size_t)r * 512 + c] = P[(size_t)r * NP + C_UR + c]; U[(size_t)r * 512 + 256 + c] = P[(size_t)r * NP + C_UI + c]; }
__global__ void __launch_bounds__(256) dbg_dft(const bf16* U, const bf16* P, float* out) {
    const int q = blockIdx.x, b = q >> 13, tp = q & 8191, ch = threadIdx.x; __shared__ float ct[8192]; __shared__ float st[8192];
    for (int i = ch; i < 8192; i += 256) { float sn, cs; sincospif(2.0f * (float)i / 8192.0f, &sn, &cs); ct[i] = cs; st[i] = sn; }
    __syncthreads();
    float acc = 0.f; const bf16* u = U + ((size_t)b * RPB + CTXL) * 512 + ch;
    for (int t = 0; t < 8192; ++t) { const int idx = (t * tp) & 8191; acc += bf2f(u[(size_t)t * 512]) * ct[idx] + bf2f(u[(size_t)t * 512 + 256]) * st[idx]; }
    const int r = b * RPB + CTXL + tp;
    out[(size_t)q * D + 512 + ch] = DBG_K * (bf2f(P[(size_t)r * NP + C_UR + ch]) - acc * 0.001381067932f);
    out[(size_t)q * D + ch] = 0.f; out[(size_t)q * D + 256 + ch] = 0.f; out[(size_t)q * D + 768 + ch] = 0.f;
}
__global__ void dbg_mod(const float* c, const float* cctx, const float* adaw, const float* adab, float* MN) {
    const int j = blockIdx.x * 256 + threadIdx.x, cr = blockIdx.y; if (j >= 6144) return; const float* cv = cr < 4 ? c + cr * D : cctx; float s = adab[j];
    for (int k = 0; k < 1024; ++k) { const float x = cv[k]; s += x / (1.f + expf(-x)) * adaw[(size_t)k * 6144 + j]; } MN[cr * 6144 + j] = s; }
__global__ void __launch_bounds__(256) dbg_h(const float* xin, const float* MN, const float* nw, const float* win, const bf16* H, const float* DT, float* out) {
    const int q = blockIdx.x, b = q >> 13, r = b * RPB + CTXL + (q & 8191), tid = threadIdx.x; __shared__ float red[256]; __shared__ float hrow[1024];
    float ss = 0.f; for (int k = tid; k < 1024; k += 256) { const float v = xin[(size_t)q * D + k]; ss += v * v; } red[tid] = ss; __syncthreads();
    for (int s = 128; s > 0; s >>= 1) { if (tid < s) red[tid] += red[tid + s]; __syncthreads(); }
    const float rstd = 1.f / sqrtf(red[0] / 1024.f + EPS);
    for (int k = tid; k < 1024; k += 256) { const float h = xin[(size_t)q * D + k] * rstd * nw[k] * (1.f + MN[b * 6144 + 1024 + k]) + MN[b * 6144 + k]; hrow[k] = h; out[(size_t)q * D + k] = DBG_K * (bf2f(H[(size_t)r * D + k]) - h); }
    __syncthreads();
    if (tid < 8) { float s = 0.f; for (int k = 0; k < 1024; ++k) s += hrow[k] * win[(size_t)k * NIN + 3072 + tid]; out[(size_t)q * D + tid] = 100.f * DBG_K * (DT[(size_t)r * 8 + tid] - s); }
}
__global__ void __launch_bounds__(256) dbg_wt(const float* win, const float* wbr, const float* wout, const bf16* WTI, const bf16* WTB, const bf16* WTO, float* out) {
    const int q = blockIdx.x, tid = threadIdx.x;
    for (int k = tid; k < 1024; k += 256) { float d = 0.f;
        if (q < 7424) { int src = -1; if (q < 2048) src = q; else if (q >= 2560 && q < 2816) src = 2304 + (q - 2560); else if (q >= 2816 && q < 3328) src = 2560 + (q - 2816); else if (q >= 3328) src = 3080 + (q - 3328);
            if (src >= 0) d = bf2f(WTI[(size_t)q * D + k]) - win[(size_t)k * NIN + src]; }
        else if (q >= 8192 && q < 12288) { const int n = q - 8192, br = n >> 10, nn = n & 1023; if (k < 256) d = bf2f(WTB[((size_t)br * 1024 + nn) * 256 + k]) - wbr[((size_t)br * 256 + k) * D + nn]; }
        else if (q >= 12288 && q < 13312) { const int n = q - 12288; d = bf2f(WTO[(size_t)n * D + k]) - wout[(size_t)k * D + n]; }
        out[(size_t)q * D + k] = 1000.f * d; }
}
__global__ void dbg_save_a(const bf16* P, bf16* S) { const int r = blockIdx.x, c = threadIdx.x; for (int j = 0; j < 3; ++j) S[(size_t)r * 768 + j * 256 + c] = P[(size_t)r * NP + j * 256 + c]; }
__global__ void __launch_bounds__(256) dbg_conva(const bf16* S, const bf16* P, const float* cw, const float* cb, float* out) {
    const int q = blockIdx.x, r = (q >> 13) * RPB + CTXL + (q & 8191), t = q & 8191, c = threadIdx.x;
    const bf16* s0 = S + (size_t)r * 768; const float u0 = bf2f(s0[256 + c]) * bf2f(s0[512 + c]);
    const float up = t > 0 ? bf2f(s0[-768 + 256 + c]) * bf2f(s0[-768 + 512 + c]) : 0.f, un = t < 8191 ? bf2f(s0[768 + 256 + c]) * bf2f(s0[768 + 512 + c]) : 0.f;
    const float y = bf2f(s0[c]) * (cb[c] + cw[c] * up + cw[256 + c] * u0 + cw[512 + c] * un);
    out[(size_t)q * D + c] = DBG_K * (bf2f(P[(size_t)r * NP + C_AB + c]) - y); out[(size_t)q * D + 256 + c] = 0.f; out[(size_t)q * D + 512 + c] = 0.f; out[(size_t)q * D + 768 + c] = 0.f;
}
__global__ void __launch_bounds__(256) dbg_final(const float* X, const float* mod, const unsigned* TOK, const unsigned* CNT, const bf16* YO, const float* fnw, float* out) {
    const int q = blockIdx.x, b = q >> 13, r = b * RPB + CTXL + (q & 8191), tid = threadIdx.x; __shared__ int ts[33]; __shared__ float red[256];
    if (tid == 0) { int a = 0; for (int e = 0; e < 32; ++e) { ts[e] = a; a += ((int)CNT[e - (DBG_VAR == 3 ? 32 : 0)] + 255) >> 8; } ts[32] = a; }
    __syncthreads();
    const unsigned* tk = TOK + (size_t)r * 8; const size_t s1 = (size_t)ts[tk[0]] * 256 + tk[2], s2 = (size_t)ts[tk[1]] * 256 + tk[3]; float w1 = __builtin_bit_cast(float, tk[4]), w2 = __builtin_bit_cast(float, tk[5]); if (DBG_VAR == 1) { const float t_ = w1; w1 = w2; w2 = t_; } if (DBG_VAR == 2) mod -= 5 * 6144;
    float xn[4]; float ss = 0.f;
    for (int i = 0; i < 4; ++i) { const int c = tid + 256 * i; xn[i] = X[(size_t)r * D + c] + DBG_E4S * mod[(size_t)b * 6144 + 5120 + c] * (w1 * bf2f(YO[s1 * D + c]) + w2 * bf2f(YO[s2 * D + c])); ss += xn[i] * xn[i]; }
    red[tid] = ss; __syncthreads(); for (int s = 128; s > 0; s >>= 1) { if (tid < s) red[tid] += red[tid + s]; __syncthreads(); }
    const float rstd = 1.f / sqrtf(red[0] / 1024.f + EPS);
    for (int i = 0; i < 4; ++i) { const int c = tid + 256 * i; out[(size_t)q * D + c] = DBG_K * (out[(size_t)q * D + c] - xn[i] * rstd * fnw[c]) + 1e-3f; }
}
#ifndef DBG_MODE
#define DBG_MODE -6
#define DBG_C0 2304
#endif
__global__ void __launch_bounds__(512) dbg_dump(Args a) {
    const int gw = blockIdx.x * 8 + (threadIdx.x >> 6), lane = threadIdx.x & 63;
    for (int q = gw; q < NB * SEQ; q += gridDim.x * 8) { const int r = (q >> 13) * RPB + CTXL + (q & 8191);
        float* orow = a.out + (size_t)q * D;
        if (DBG_MODE == 1) {
            const f32x4* xr = (DBG_STOP <= 2 ? (const f32x4*)(a.in[I_X] + (size_t)q * D) : (const f32x4*)((const float*)(a.ws + WS_X) + (size_t)r * D)) + lane; f32x4 v[4]; float ss = 0.f;
            for (int j = 0; j < 4; ++j) { v[j] = xr[64 * j]; ss += v[j].x * v[j].x + v[j].y * v[j].y + v[j].z * v[j].z + v[j].w * v[j].w; }
            const float rstd = 1.0f / sqrtf(wave_sum(ss) * (1.f / D) + EPS);
            for (int j = 0; j < 4; ++j) ((f32x4*)orow)[lane + 64 * j] = v[j] * rstd * ((const f32x4*)a.in[I_FNW])[lane + 64 * j];
        } else if (DBG_MODE == 2) {
            const bf16* m = (const bf16*)(a.ws + BG_MERGED) + (size_t)r * D; for (int j = 0; j < 16; ++j) orow[lane + 64 * j] = bf2f(m[lane + 64 * j]);
        } else if (DBG_MODE == 3) {
            const bf16* p = (const bf16*)(a.ws + BG_PROJ) + (size_t)r * NP;
            for (int j = 0; j < 4; ++j) { orow[lane + 64 * j] = bf2f(p[C_AB + lane + 64 * j]); orow[256 + lane + 64 * j] = bf2f(p[C_Q + lane + 64 * j]); orow[512 + lane + 64 * j] = bf2f(p[C_UR + lane + 64 * j]); orow[768 + lane + 64 * j] = bf2f(p[C_Z + lane + 64 * j]); }
        } else if (DBG_MODE == 4) {
            const bf16* m = (const bf16*)(a.ws + WS_H) + (size_t)r * D; for (int j = 0; j < 16; ++j) orow[lane + 64 * j] = bf2f(m[lane + 64 * j]);
        } else {
            const bf16* p = (const bf16*)(a.ws + BG_PROJ) + (size_t)r * NP + DBG_MODE; for (int j = 0; j < 16; ++j) orow[lane + 64 * j] = bf2f(p[lane + 64 * j]);
        }
    }
}
template <int PHSEL> static void launch_phase(const Args& a, int grid, hipStream_t stream) {
    static bool attr = false;
    if (!attr) { (void)hipFuncSetAttribute((const void*)mk<false, PHSEL>, hipFuncAttributeMaxDynamicSharedMemorySize, LDS_BYTES); attr = true; }
    hipLaunchKernelGGL((mk<false, PHSEL>), dim3(grid), dim3(512), LDS_BYTES, stream, a);
}
__global__ void dbg_nop() {}
static void launch_any(const Args& a, int ph, int grid, hipStream_t stream) {
        if (ph == 0) launch_phase<100>(a, grid, stream);
        else if (ph == 1) launch_phase<101>(a, grid, stream);
        else switch ((ph - 2) % PH_PER_L) {
            case 0: launch_phase<0>(a, grid, stream); break;
            case 1: launch_phase<1>(a, grid, stream); break;
            case 2: launch_phase<2>(a, grid, stream); break;
            case 3: case 6: launch_phase<3>(a, grid, stream); break;
            case 4: launch_phase<4>(a, grid, stream); break;
            case 5: launch_phase<5>(a, grid, stream); break;
            case 7: launch_phase<7>(a, grid, stream); break;
            case 8: launch_phase<8>(a, grid, stream); break;
            case 9: launch_phase<9>(a, grid, stream); break;
            case 10: launch_phase<10>(a, grid, stream); break;
            case 11: launch_phase<11>(a, grid, stream); break;
            case 12: launch_phase<12>(a, grid, stream); break;
            default: launch_phase<13>(a, grid, stream); break;
        }
}
extern "C" void kernel_launch(void* const* d_in, const int* in_sizes, int n_in, void* d_out, int out_size, void* d_ws, size_t ws_size, hipStream_t stream) {
    static int grid = 0;
    if (grid == 0) {
        if (n_in != 29 || ws_size < WS_END || out_size != NB * SEQ * D) { fprintf(stderr, "kernel_launch: unexpected shapes (n_in %d, ws %zu, out %d)\n", n_in, ws_size, out_size); grid = -1; }
        else {
            int dev = 0, cus = 0; (void)hipGetDevice(&dev); (void)hipDeviceGetAttribute(&cus, hipDeviceAttributeMultiprocessorCount, dev);
            grid = cus;
            if (grid != 256) { fprintf(stderr, "kernel_launch: %d CUs: expected 256\n", cus); if (grid <= 0 || grid % 8) grid = -1; }
        }
    }
    if (grid < 0) { (void)hipMemsetAsync(d_out, 0, (size_t)out_size * 4, stream); return; }
    (void)hipMemsetAsync((char*)d_ws + WS_CTL, 0, 1 * MiB, stream);
    Args a{};
    for (int i = 0; i < 29; ++i) a.in[i] = (const float*)d_in[i];
    a.out = (float*)d_out; a.ws = (unsigned char*)d_ws; a.coop = 0; a.pad = 0;
#if PROFILE_GROUPS
    {
        static int extra_k = -1, extra_m = -1;
        hipStreamCaptureStatus cs = hipStreamCaptureStatusNone; (void)hipStreamIsCapturing(stream, &cs);
        if (extra_k < 0 && cs == hipStreamCaptureStatusNone) {
            hipEvent_t ev[N_PHASES + 1]; for (int i = 0; i <= N_PHASES; ++i) (void)hipEventCreate(&ev[i]);
            for (int rep = 0; rep < 2; ++rep) {
                (void)hipMemsetAsync((char*)d_ws + WS_CTL, 0, 1 * MiB, stream);
                for (int ph = 0; ph < N_PHASES; ++ph) { (void)hipEventRecord(ev[ph], stream); a.ph_lo = ph; a.ph_hi = ph + 1; launch_any(a, ph, grid, stream); }
                (void)hipEventRecord(ev[N_PHASES], stream); (void)hipStreamSynchronize(stream); }
            float g[4] = {0, 0, 0, 0};
            for (int ph = 0; ph < N_PHASES; ++ph) { float ms = 0.f; (void)hipEventElapsedTime(&ms, ev[ph], ev[ph + 1]); const int p = ph < 2 ? 100 + ph : (ph - 2) % PH_PER_L;
                const int grp = PROFILE_GROUPS == 7 ? (p == 101 ? 0 : -1) : PROFILE_GROUPS == 6 ? (p == 100 ? 0 : -1) : PROFILE_GROUPS == 5 ? (p == PROFILE_P ? 0 : -1) : PROFILE_GROUPS == 1 ? ((p == 10) ? 0 : ((p == 2 || p == 4 || p == 5 || p == 7) ? 1 : -1)) : PROFILE_GROUPS == 2 ? ((p == 1 || p == 8 || p == 9 || p == 11 || p == 12) ? 0 : ((p == 3 || p == 6 || p == 0 || p == 13) ? 1 : -1)) : PROFILE_GROUPS == 3 ? ((p == 8) ? 0 : (p == 1 ? 1 : -1)) : ((p == 11 || p == 12) ? 0 : (p >= 100 ? 1 : -1));
                if (grp >= 0) g[grp] += ms; }
            extra_k = (int)(g[PROFILE_SEL] * 1000.f / PROFILE_UNIT_US + 0.5f); extra_m = 0; if (extra_k > 33) extra_k = 33;
        }
        (void)hipMemsetAsync((char*)d_ws + WS_CTL, 0, 1 * MiB, stream);
        for (int ph = 0; ph < N_PHASES; ++ph) { a.ph_lo = ph; a.ph_hi = ph + 1; launch_any(a, ph, grid, stream); }
        for (int i = 0; i < (extra_k > 0 ? extra_k : 0); ++i) hipLaunchKernelGGL(dbg_nop, dim3(1), dim3(64), 0, stream);
        for (int i = 0; i < (extra_m > 0 ? extra_m : 0); ++i) (void)hipMemsetAsync((char*)d_ws + WS_CTL + 512 * 1024, 0, 4, stream);
        return;
    }
#endif
#if ONE_LAUNCH
    {   static bool attr = false;
        if (!attr) { (void)hipFuncSetAttribute((const void*)mk<true, -1>, hipFuncAttributeMaxDynamicSharedMemorySize, LDS_BYTES); attr = true; }
        a.ph_lo = 0; a.ph_hi = N_PHASES; a.coop = 1;
        void* args[] = {&a};
        hipError_t e = hipLaunchCooperativeKernel((const void*)mk<true, -1>, dim3(grid), dim3(512), args, LDS_BYTES, stream);
        if (e != hipSuccess) fprintf(stderr, "cooperative launch failed: %s\n", hipGetErrorString(e));
        return;
    }
#endif
    for (int ph = 0; ph < (DBG_STOP ? DBG_STOP : N_PHASES); ++ph) {
        a.ph_lo = ph; a.ph_hi = ph + 1;
        if (DBG_STOP && DBG_MODE == -8 && ph == 4) hipLaunchKernelGGL(dbg_save_u, dim3(R), dim3(256), 0, stream, (const bf16*)((char*)d_ws + BG_PROJ), (bf16*)((char*)d_ws + WS_X));
        if (DBG_STOP && DBG_MODE == -11 && ph == 4) hipLaunchKernelGGL(dbg_save_a, dim3(R), dim3(256), 0, stream, (const bf16*)((char*)d_ws + BG_PROJ), (bf16*)((char*)d_ws + WS_X));
        if (DBG_STOP && DBG_MODE == -6 && ph == 4 + DBG_L * PH_PER_L) {
            hipLaunchKernelGGL(dbg_save_gz, dim3(R), dim3(256), 0, stream, (const bf16*)((char*)d_ws + BG_PROJ), (bf16*)((char*)d_ws + BG_MIX_END));
            for (int mix = 0; mix < 2; ++mix) hipLaunchKernelGGL(dbg_naive_scan, dim3(32), dim3(64), 0, stream, (const bf16*)((char*)d_ws + BG_PROJ), (const float*)((char*)d_ws + SM_DT), (float*)d_out, (const float*)d_in[13] + DBG_L * 3 * 512, (const float*)d_in[14] + DBG_L * 512, (const float*)d_in[15] + DBG_L * 8, (const float*)d_in[16] + DBG_L * 8, (const float*)d_in[17] + DBG_L * 4, (const float*)d_in[11], mix);
        }
        launch_any(a, ph, grid, stream);
    }
    if (DBG_STOP && DBG_MODE == -1) hipLaunchKernelGGL(dbg_gemm, dim3(NB * SEQ), dim3(256), 0, stream, (const bf16*)((char*)d_ws + WS_H), D, (const bf16*)((char*)d_ws + WT_IN), D, D, (const bf16*)((char*)d_ws + BG_PROJ), NP, DBG_C0, (float*)d_out);
    else if (DBG_STOP && DBG_MODE == -2) hipLaunchKernelGGL(dbg_merged, dim3(NB * SEQ), dim3(256), 0, stream, (const bf16*)((char*)d_ws + WS_H), (const bf16*)((char*)d_ws + BG_PROJ), (const bf16*)((char*)d_ws + WT_IN) + (size_t)DBG_L * NWIN * D + (size_t)NP * D, (const bf16*)((char*)d_ws + WT_BR) + (size_t)DBG_L * 4 * D * 256, (const bf16*)((char*)d_ws + BG_MERGED), (float*)d_out);
    else if (DBG_STOP && DBG_MODE == -4) hipLaunchKernelGGL(dbg_moe, dim3(NB * SEQ), dim3(256), 0, stream, (const bf16*)((char*)d_ws + WS_H), (const unsigned*)((char*)d_ws + SM_TOK), (const unsigned*)((char*)d_ws + WS_CTL) + CW_CNT + DBG_L * 32, (const bf16*)((char*)d_ws + BG_YO), (const float*)d_in[25] + (size_t)DBG_L * NE * D * DFF, (const float*)d_in[26] + (size_t)DBG_L * NE * D * DFF, (const float*)d_in[27] + (size_t)DBG_L * NE * D * DFF, (float*)d_out);
    else if (DBG_STOP && DBG_MODE == -5) hipLaunchKernelGGL(dbg_router, dim3(NB * SEQ), dim3(256), 0, stream, (const float*)((char*)d_ws + WS_X), (const float*)((char*)d_ws + SM_MOD) + DBG_L * 5 * 6144, (const float*)d_in[7] + DBG_L * D, (const float*)d_in[21] + DBG_L * D * 4, (const float*)d_in[22] + DBG_L * 4, (const float*)d_in[23] + DBG_L * D * 32, (const float*)d_in[24] + DBG_L * 32, (const unsigned*)((char*)d_ws + SM_TOK), (float*)d_out);
    else if (DBG_STOP && DBG_MODE == -6) hipLaunchKernelGGL(dbg_scan_cmp, dim3(NB * SEQ), dim3(256), 0, stream, (const bf16*)((char*)d_ws + BG_PROJ), (const float*)d_out, (const bf16*)((char*)d_ws + BG_MIX_END), (const float*)d_in[12] + DBG_L * 64, (const float*)d_in[18] + DBG_L * 256, (float*)d_out);
    else if (DBG_STOP && DBG_MODE == -7) hipLaunchKernelGGL(dbg_four, dim3(NB * SEQ), dim3(256), 0, stream, (const bf16*)((char*)d_ws + WS_H), (const float*)d_in[8], (const bf16*)((char*)d_ws + BG_PROJ), (float*)d_out);
    else if (DBG_STOP && DBG_MODE == -8) hipLaunchKernelGGL(dbg_dft, dim3(NB * SEQ), dim3(256), 0, stream, (const bf16*)((char*)d_ws + WS_X), (const bf16*)((char*)d_ws + BG_PROJ), (float*)d_out);
    else if (DBG_STOP && DBG_MODE == -9) { float* MN = (float*)((char*)d_ws + BG_MIX_END);
        hipLaunchKernelGGL(dbg_mod, dim3(24, 5), dim3(256), 0, stream, (const float*)d_in[1], (const float*)d_in[3], (const float*)d_in[4], (const float*)d_in[5], MN);
        hipLaunchKernelGGL(dbg_h, dim3(NB * SEQ), dim3(256), 0, stream, (const float*)d_in[0], MN, (const float*)d_in[6], (const float*)d_in[8], (const bf16*)((char*)d_ws + WS_H), (const float*)((char*)d_ws + SM_DT), (float*)d_out); }
    else if (DBG_STOP && DBG_MODE == -10) hipLaunchKernelGGL(dbg_wt, dim3(NB * SEQ), dim3(256), 0, stream, (const float*)d_in[8] + (size_t)DBG_L * D * NIN, (const float*)d_in[19] + (size_t)DBG_L * 4 * 256 * D, (const float*)d_in[20] + (size_t)DBG_L * D * D,
        (const bf16*)((char*)d_ws + WT_IN) + (size_t)DBG_L * NWIN * D, (const bf16*)((char*)d_ws + WT_BR) + (size_t)DBG_L * 4 * D * 256, (const bf16*)((char*)d_ws + WT_OUT) + (size_t)DBG_L * D * D, (float*)d_out);
    else if (DBG_STOP && DBG_MODE == -11) hipLaunchKernelGGL(dbg_conva, dim3(NB * SEQ), dim3(256), 0, stream, (const bf16*)((char*)d_ws + WS_X), (const bf16*)((char*)d_ws + BG_PROJ), (const float*)d_in[9], (const float*)d_in[10], (float*)d_out);
    else if (DBG_STOP && DBG_MODE == -12) hipLaunchKernelGGL(dbg_final, dim3(NB * SEQ), dim3(256), 0, stream, (const float*)((char*)d_ws + WS_X), (const float*)((char*)d_ws + SM_MOD) + 5 * 6144, (const unsigned*)((char*)d_ws + SM_TOK), (const unsigned*)((char*)d_ws + WS_CTL) + CW_CNT + 32, (const bf16*)((char*)d_ws + BG_YO), (const float*)d_in[28], (float*)d_out);
    else if (DBG_STOP && DBG_MODE == -3) hipLaunchKernelGGL(dbg_d2, dim3(NB * SEQ), dim3(256), 0, stream, (const bf16*)((char*)d_ws + BG_MERGED), (const bf16*)((char*)d_ws + WT_OUT), (const float*)((char*)d_ws + WS_X), (const float*)d_in[0], (const float*)((char*)d_ws + SM_MOD), (float*)d_out);
    else if (DBG_STOP) hipLaunchKernelGGL(dbg_dump, dim3(256), dim3(512), 0, stream, a);
}
```
